# Optimizing an MI355X kernel written in HIP

```python
import jax, jax.numpy as jnp
from jax import lax
import numpy as np

D_MODEL = 1024
BATCH = 8
SEQ = 4096
DEPTH = 2

GRID_W = 64
WIN_H_MAX = 8
WIN_W = 16
COL_BLOCK = 16
COL_SLAB = 32
NA_HEADS = 8
NA_HEAD_DIM = 64
NA_WIDTH = NA_HEADS * NA_HEAD_DIM
GLA_HEADS = 4
GLA_DK = 64
GLA_DV = 128
GLA_QK_WIDTH = GLA_HEADS * GLA_DK
GLA_V_WIDTH = GLA_HEADS * GLA_DV
GLA_GATE_RANK = 16
GLA_TAU = 16.0
GLA_CHUNK = 64
MIX_WIDTH = NA_WIDTH + GLA_V_WIDTH
IN_SPLITS = (NA_WIDTH, NA_WIDTH, NA_WIDTH,
             GLA_QK_WIDTH, GLA_QK_WIDTH,
             GLA_V_WIDTH, GLA_V_WIDTH,
             GLA_GATE_RANK, GLA_GATE_RANK)
IN_WIDTH = sum(IN_SPLITS)
D_FF = 2816
EPS = 1e-6
NEG_INF = -1e30

kernel_name = "hybrid_na_gla_macaron_encoder"


def rmsnorm(x, g):
    xf = x.astype(jnp.float32)
    y = xf * lax.rsqrt(jnp.mean(xf * xf, axis=-1, keepdims=True) + EPS)
    return (y * g.astype(jnp.float32)).astype(x.dtype)


def swiglu(h, w_gate, w_up, w_down):
    return (jax.nn.silu(h @ w_gate) * (h @ w_up)) @ w_down


def split_heads(a, n):
    b, s, w = a.shape
    return a.reshape(b, s, n, w // n).transpose(0, 2, 1, 3)


def merge_heads(a):
    b, n, s, d = a.shape
    return a.transpose(0, 2, 1, 3).reshape(b, s, n * d)


def neighbourhood_attention(q, k, v, rpb):
    B, H, S, d = q.shape
    rows = S // GRID_W
    wh = min(WIN_H_MAX, rows)
    q = q.reshape(B, H, rows, GRID_W, d)
    k = k.reshape(B, H, rows, GRID_W, d)
    v = v.reshape(B, H, rows, GRID_W, d)
    r = np.arange(rows)
    row_start = np.clip(r - wh // 2, 0, rows - wh)
    key_rows = row_start[:, None] + np.arange(wh)[None, :]
    dr = key_rows - r[:, None] + (WIN_H_MAX - 1)
    scale = NA_HEAD_DIM ** -0.5
    outs = []
    for j in range(GRID_W // COL_BLOCK):
        qc = np.arange(j * COL_BLOCK, (j + 1) * COL_BLOCK)
        col_start = np.clip(qc - WIN_W // 2, 0, GRID_W - WIN_W)
        c0 = int(np.clip(j * COL_BLOCK - WIN_W // 2, 0, GRID_W - COL_SLAB))
        kc = c0 + np.arange(COL_SLAB)
        valid = (kc[None, :] >= col_start[:, None]) & (kc[None, :] < col_start[:, None] + WIN_W)
        dc = np.clip(kc[None, :] - qc[:, None] + (WIN_W - 1), 0, 2 * WIN_W - 2)
        qb = q[:, :, :, j * COL_BLOCK:(j + 1) * COL_BLOCK]
        kb = k[:, :, :, c0:c0 + COL_SLAB][:, :, key_rows]
        vb = v[:, :, :, c0:c0 + COL_SLAB][:, :, key_rows]
        s = jnp.einsum('bhrqd,bhrwkd->bhrqwk', qb, kb).astype(jnp.float32) * scale
        bias = rpb[:, dr[:, None, :, None], dc[None, :, None, :]]
        s = s + bias[None].astype(jnp.float32)
        s = jnp.where(valid[:, None, :], s, NEG_INF)
        p = jax.nn.softmax(s.reshape(B, H, rows, COL_BLOCK, wh * COL_SLAB), axis=-1)
        p = p.reshape(B, H, rows, COL_BLOCK, wh, COL_SLAB).astype(v.dtype)
        outs.append(jnp.einsum('bhrqwk,bhrwkd->bhrqd', p, vb))
    o = jnp.concatenate(outs, axis=3)
    return o.reshape(B, H, S, d)


def gla_chunked(q, k, v, g, include_diag):
    B, H, T, dk = q.shape
    dv = v.shape[-1]
    n = T // GLA_CHUNK

    def to_chunks(a):
        return jnp.moveaxis(a.reshape(B, H, n, GLA_CHUNK, a.shape[-1]), 2, 0)

    t = np.arange(GLA_CHUNK)
    mask = (t[:, None] >= t[None, :]) if include_diag else (t[:, None] > t[None, :])

    def step(state, inp):
        qi, ki, vi, gi = inp
        b = jnp.cumsum(gi, axis=-2)
        inter = jnp.einsum('bhtd,bhde->bhte', qi * jnp.exp(b), state)
        diff = b[:, :, :, None, :] - b[:, :, None, :, :]
        decay = jnp.exp(jnp.where(mask[:, :, None], diff, -jnp.inf))
        a = jnp.einsum('bhtd,bhsd,bhtsd->bhts', qi, ki, decay)
        intra = jnp.einsum('bhts,bhse->bhte', a, vi)
        b_last = b[:, :, -1:, :]
        state = (jnp.exp(b_last[:, :, 0, :])[..., None] * state
                 + jnp.einsum('bhsd,bhse->bhde', ki * jnp.exp(b_last - b), vi))
        return state, inter + intra

    s0 = jnp.zeros((B, H, dk, dv), jnp.float32)
    _, o = lax.scan(step, s0, (to_chunks(q), to_chunks(k), to_chunks(v), to_chunks(g)))
    return jnp.moveaxis(o, 0, 2).reshape(B, H, T, dv)


def hybrid_layer(x, ffn1_norm, ffn1_wg, ffn1_wu, ffn1_wd, mix_norm, w_in, na_rpb, na_gain,
                 w_gate_f, b_gate_f, w_gate_b, b_gate_b, gla_gain, w_out,
                 ffn2_norm, ffn2_wg, ffn2_wu, ffn2_wd):
    x = x + 0.5 * swiglu(rmsnorm(x, ffn1_norm), ffn1_wg, ffn1_wu, ffn1_wd)

    h = rmsnorm(x, mix_norm)
    proj = h @ w_in
    offsets = list(np.cumsum(IN_SPLITS)[:-1])
    na_q, na_k, na_v, g_q, g_k, g_v, g_r, gf_code, gb_code = jnp.split(proj, offsets, axis=-1)

    na_o = neighbourhood_attention(split_heads(na_q, NA_HEADS), split_heads(na_k, NA_HEADS),
                                   split_heads(na_v, NA_HEADS), na_rpb)
    na_o = rmsnorm(merge_heads(na_o), na_gain)

    f32 = jnp.float32
    qg = split_heads(g_q, GLA_HEADS).astype(f32) * (GLA_DK ** -0.5)
    kg = split_heads(g_k, GLA_HEADS).astype(f32)
    vg = split_heads(g_v, GLA_HEADS).astype(f32)
    log_gf = jax.nn.log_sigmoid((gf_code @ w_gate_f + b_gate_f).astype(f32)) / GLA_TAU
    log_gb = jax.nn.log_sigmoid((gb_code @ w_gate_b + b_gate_b).astype(f32)) / GLA_TAU
    log_gf = split_heads(log_gf, GLA_HEADS)
    log_gb = split_heads(log_gb, GLA_HEADS)
    o_fwd = gla_chunked(qg, kg, vg, log_gf, True)
    flip = lambda a: jnp.flip(a, axis=2)
    o_bwd = flip(gla_chunked(flip(qg), flip(kg), flip(vg), flip(log_gb), False))
    gla_o = rmsnorm(o_fwd + o_bwd, gla_gain).astype(x.dtype)
    gla_o = merge_heads(gla_o) * jax.nn.silu(g_r)

    x = x + jnp.concatenate([na_o, gla_o], axis=-1) @ w_out

    x = x + 0.5 * swiglu(rmsnorm(x, ffn2_norm), ffn2_wg, ffn2_wu, ffn2_wd)
    return x


def setup_inputs(seed: int = 0) -> dict:
    key = jax.random.key(seed)
    ks = iter(jax.random.split(key, 32))
    nrm = lambda shape, s: jax.random.normal(next(ks), shape, jnp.float32) * s
    gain = lambda shape: 1.0 + nrm(shape, 0.02)
    L, D = DEPTH, D_MODEL
    return {
        "x": nrm((BATCH, SEQ, D), 1.0),
        "ffn1_norm": gain((L, D)),
        "ffn1_wg": nrm((L, D, D_FF), D ** -0.5),
        "ffn1_wu": nrm((L, D, D_FF), D ** -0.5),
        "ffn1_wd": nrm((L, D_FF, D), D_FF ** -0.5),
        "mix_norm": gain((L, D)),
        "w_in": nrm((L, D, IN_WIDTH), D ** -0.5),
        "na_rpb": nrm((L, NA_HEADS, 2 * WIN_H_MAX - 1, 2 * WIN_W - 1), 0.1),
        "na_gain": gain((L, NA_WIDTH)),
        "w_gate_f": nrm((L, GLA_GATE_RANK, GLA_QK_WIDTH), GLA_GATE_RANK ** -0.5),
        "b_gate_f": nrm((L, GLA_QK_WIDTH), 0.1),
        "w_gate_b": nrm((L, GLA_GATE_RANK, GLA_QK_WIDTH), GLA_GATE_RANK ** -0.5),
        "b_gate_b": nrm((L, GLA_QK_WIDTH), 0.1),
        "gla_gain": gain((L, GLA_DV)),
        "w_out": nrm((L, MIX_WIDTH, D), MIX_WIDTH ** -0.5),
        "ffn2_norm": gain((L, D)),
        "ffn2_wg": nrm((L, D, D_FF), D ** -0.5),
        "ffn2_wu": nrm((L, D, D_FF), D ** -0.5),
        "ffn2_wd": nrm((L, D_FF, D), D_FF ** -0.5),
        "final_norm": gain((D,)),
    }


def reference(x, ffn1_norm, ffn1_wg, ffn1_wu, ffn1_wd, mix_norm, w_in, na_rpb, na_gain,
              w_gate_f, b_gate_f, w_gate_b, b_gate_b, gla_gain, w_out,
              ffn2_norm, ffn2_wg, ffn2_wu, ffn2_wd, final_norm):
    for l in range(DEPTH):
        x = hybrid_layer(x, ffn1_norm[l], ffn1_wg[l], ffn1_wu[l], ffn1_wd[l], mix_norm[l], w_in[l],
                         na_rpb[l], na_gain[l], w_gate_f[l], b_gate_f[l], w_gate_b[l], b_gate_b[l],
                         gla_gain[l], w_out[l], ffn2_norm[l], ffn2_wg[l], ffn2_wu[l], ffn2_wd[l])
    return rmsnorm(x, final_norm)
```

```cpp
#include <hip/hip_runtime.h>
#include <cstdio>
#include <cstdint>
namespace pg8 {
#define PG8_LAS __attribute__((address_space(3)))
typedef unsigned short bf16_t;
typedef short bf16x8 __attribute__((ext_vector_type(8)));
typedef float f32x4 __attribute__((ext_vector_type(4)));
typedef unsigned u32x4 __attribute__((ext_vector_type(4)));
constexpr int BM = 256, BK = 64, HALF = 128, HTB = HALF * BK * 2  , STAGE_BYTES = 8 * HTB, NXCD = 8, WGM = 8;

__host__ __device__ __forceinline__ int lds_byte(int r, int c) { const int st = (r >> 4) * 2 + (c >> 5), rr = r & 15, cc = c & 31, ob = rr * 64 + cc * 2; return st * 1024 + (ob ^ (((ob >> 9) & 1) << 5)); }
__host__ __device__ __forceinline__ void stage_rc(int b, int& R, int& C) { const int st = b / 1024, sb = b % 1024, swz = sb ^ (((sb >> 9) & 1) << 5); R = (st >> 1) * 16 + swz / 64; C = (st & 1) * 32 + (swz % 64) / 2; }
__host__ __device__ __forceinline__ int perm32(int rho) { const int n = rho >> 4, i = rho & 15; return 8 * (i >> 2) + 4 * n + (i & 3); }

struct Unit { int pm, pn; };
struct Gemm { const bf16_t* A; const bf16_t* Bt; int M, N, K; };

struct StaticOrder {
    int nM, nN, nwg, G, c;
    __host__ __device__ void init(int M, int N, int G_, int c_) { nM = M / BM; nN = N / BM; nwg = nM * nN; G = G_; c = c_; }
    __host__ __device__ bool next(int i, Unit& u) const {
        const long L = (long)i * G + c; if (L >= nwg) return false;
        int wgid = (int)L; { const int q = nwg / NXCD, r = nwg % NXCD, xcd = wgid % NXCD, off = wgid / NXCD; wgid = (xcd < r ? xcd * (q + 1) : r * (q + 1) + (xcd - r) * q) + off; }
        const int nig = WGM * nN, gid = wgid / nig, fm = gid * WGM, gsz = (nM - fm) < WGM ? (nM - fm) : WGM;
        u.pm = fm + ((wgid % nig) % gsz); u.pn = (wgid % nig) / gsz; return true;
    }
    __device__ __forceinline__ void a_ready(const Unit&) const {}
    __device__ __forceinline__ void done(const Unit&) const {}
};

__device__ __forceinline__ unsigned cvt_pk_bf16(float lo, float hi) { unsigned r; asm volatile("v_cvt_pk_bf16_f32 %0, %1, %2" : "=v"(r) : "v"(lo), "v"(hi)); return r; }
typedef float f32x2 __attribute__((ext_vector_type(2)));
template <class Epi, class Sched, bool ALIGN_EPI = false, bool SP2 = false>
__device__ __forceinline__ void gemm_phase(PG8_LAS unsigned char* lds, const Gemm g, const Sched& S, const Epi& E) {
    int tid_ = threadIdx.x; asm volatile("" : "+v"(tid_));
    const int tid = tid_, wid = __builtin_amdgcn_readfirstlane(tid >> 6), lane = tid & 63, wr = wid >> 2, wc = wid & 3, fr = lane & 15, fq = lane >> 4;
    const int K = g.K, nt = K / BK;
    unsigned voffA[2], voffB[2];
#pragma unroll
    for (int i = 0; i < 2; ++i) { int R, C; stage_rc(tid * 16 + i * 8192, R, C); const int Rb = Epi::PERM ? ((R & ~31) + perm32(R & 31)) : R;
        voffA[i] = (unsigned)(R * K + C) * 2u; voffB[i] = (unsigned)(Rb * K + C) * 2u; }
    const size_t kstep = (size_t)(BK * 2);
    const size_t hstep = (size_t)HALF * K * 2;
    const size_t tstep = 2 * hstep;
    const unsigned ldsw = (unsigned)wid * 1024u;
    const int aoff = lds_byte(wr * 64 + fr, fq * 8), boff = lds_byte(wc * 32 + fr, fq * 8);
#define PG8_SA(b, h) (((b) * 2 + (h)) * HTB)
#define PG8_SB(b, h) ((4 + (b) * 2 + (h)) * HTB)
#define PG8_STAGE(bufoff, gbase, voff) do { _Pragma("unroll") for (int _i = 0; _i < 2; ++_i) \
        __builtin_amdgcn_global_load_lds((const unsigned*)((const char*)(gbase) + (voff)[_i]), (PG8_LAS unsigned*)(lds + (bufoff) + ldsw + _i * 8192), 16, 0, 0); } while (0)
#define PG8_LDA(dst, b, h) do { _Pragma("unroll") for (int m = 0; m < 4; ++m) _Pragma("unroll") for (int k = 0; k < 2; ++k) dst[m][k] = *(const PG8_LAS bf16x8*)(lds + PG8_SA(b, h) + aoff + m * 2048 + k * 1024); } while (0)
#define PG8_LDB(dst, b, h) do { _Pragma("unroll") for (int n = 0; n < 2; ++n) _Pragma("unroll") for (int k = 0; k < 2; ++k) dst[n][k] = *(const PG8_LAS bf16x8*)(lds + PG8_SB(b, h) + boff + n * 2048 + k * 1024); } while (0)
#define PG8_MMA(ai, bj, At, Bt) do { __builtin_amdgcn_s_setprio(1); _Pragma("unroll") for (int m = 0; m < 4; ++m) _Pragma("unroll") for (int n = 0; n < 2; ++n) _Pragma("unroll") for (int k = 0; k < 2; ++k) \
        acc[ai][bj][m][n] = __builtin_amdgcn_mfma_f32_16x16x32_bf16(Bt[n][k], At[m][k], acc[ai][bj][m][n], 0, 0, 0); __builtin_amdgcn_s_setprio(0); } while (0)
#define PG8_WAIT_V(n) asm volatile("s_waitcnt vmcnt(" #n ")" ::: "memory")
#define PG8_WAIT_L(n) asm volatile("s_waitcnt lgkmcnt(" #n ")" ::: "memory")
#define PG8_BAR __builtin_amdgcn_s_barrier()
#define PG8_SCHED __builtin_amdgcn_sched_barrier(0)
    Unit cur, nxt; int ui = 0;
    if (!S.next(0, cur)) return;
    f32x4 acc[2][2][4][2];
#pragma unroll
    for (int a = 0; a < 2; ++a)
#pragma unroll
        for (int b = 0; b < 2; ++b)
#pragma unroll
            for (int m = 0; m < 4; ++m)
#pragma unroll
                for (int n = 0; n < 2; ++n) acc[a][b][m][n] = (f32x4){0.f, 0.f, 0.f, 0.f};
    bf16x8 At[4][2], B0[2][2], B1[2][2];
    const char* cA = (const char*)g.A + (size_t)cur.pm * tstep; const char* cB = (const char*)g.Bt + (size_t)cur.pn * tstep;
    S.a_ready(cur);
    if constexpr (SP2) {
        PG8_STAGE(PG8_SB(0, 0), cB, voffB); PG8_STAGE(PG8_SB(0, 1), cB + hstep, voffB); PG8_STAGE(PG8_SA(0, 0), cA, voffA); PG8_STAGE(PG8_SA(0, 1), cA + hstep, voffA);
        if (wr == 1) PG8_BAR;
        PG8_WAIT_V(2); PG8_BAR;
        PG8_STAGE(PG8_SB(1, 0), cB + kstep, voffB); PG8_STAGE(PG8_SA(1, 0), cA + kstep, voffA); PG8_STAGE(PG8_SB(1, 1), cB + hstep + kstep, voffB);
        PG8_WAIT_V(6); PG8_BAR;
    } else {
        PG8_STAGE(PG8_SB(0, 0), cB, voffB); PG8_STAGE(PG8_SA(0, 0), cA, voffA); PG8_STAGE(PG8_SB(0, 1), cB + hstep, voffB); PG8_STAGE(PG8_SA(0, 1), cA + hstep, voffA);
        if (wr == 1) PG8_BAR;
        PG8_WAIT_V(4); PG8_BAR;
        PG8_STAGE(PG8_SB(1, 0), cB + kstep, voffB); PG8_STAGE(PG8_SA(1, 0), cA + kstep, voffA); PG8_STAGE(PG8_SB(1, 1), cB + hstep + kstep, voffB);
        PG8_WAIT_V(6); PG8_BAR;
    }
    for (;;) {
        const bool has_next = S.next(ui + 1, nxt);
        const char* nA = has_next ? (const char*)g.A + (size_t)nxt.pm * tstep : cA; const char* nB = has_next ? (const char*)g.Bt + (size_t)nxt.pn * tstep : cB;
        for (int t = 0; t < nt; t += 2) {
            const bool last = (t == nt - 2);
            const char* a1 = cA + (size_t)(t + 1) * kstep;
            const char* a2 = last ? nA : cA + (size_t)(t + 2) * kstep; const char* b2 = last ? nB : cB + (size_t)(t + 2) * kstep;
            const char* a3 = a2 + kstep; const char* b3 = b2 + kstep;
            if (last && has_next) S.a_ready(nxt);
            if constexpr (SP2) {
            PG8_LDB(B0, 0, 0); PG8_LDB(B1, 0, 1); PG8_SCHED; PG8_LDA(At, 0, 0); PG8_STAGE(PG8_SA(1, 1), a1 + hstep, voffA);
            PG8_WAIT_V(8); PG8_WAIT_L(0); PG8_BAR; PG8_MMA(0, 0, At, B0); PG8_MMA(0, 1, At, B1); PG8_BAR; PG8_SCHED;
            PG8_LDA(At, 0, 1); PG8_STAGE(PG8_SB(0, 0), b2, voffB); PG8_STAGE(PG8_SB(0, 1), b2 + hstep, voffB); PG8_STAGE(PG8_SA(0, 0), a2, voffA);
            PG8_WAIT_V(8); PG8_WAIT_L(0); PG8_BAR; PG8_MMA(1, 0, At, B0); PG8_MMA(1, 1, At, B1); PG8_BAR; PG8_SCHED;
            PG8_LDB(B0, 1, 0); PG8_LDB(B1, 1, 1); PG8_SCHED; PG8_LDA(At, 1, 0); PG8_STAGE(PG8_SA(0, 1), a2 + hstep, voffA);
            PG8_WAIT_V(8); PG8_WAIT_L(0); PG8_BAR; PG8_MMA(0, 0, At, B0); PG8_MMA(0, 1, At, B1); PG8_BAR; PG8_SCHED;
            PG8_LDA(At, 1, 1); PG8_STAGE(PG8_SB(1, 0), b3, voffB); PG8_STAGE(PG8_SB(1, 1), b3 + hstep, voffB); PG8_STAGE(PG8_SA(1, 0), a3, voffA);
            PG8_WAIT_V(8); PG8_WAIT_L(0); PG8_BAR; PG8_MMA(1, 0, At, B0); PG8_MMA(1, 1, At, B1); PG8_BAR; PG8_SCHED;
            } else {
            PG8_LDB(B0, 0, 0); PG8_SCHED; PG8_LDA(At, 0, 0); PG8_STAGE(PG8_SA(1, 1), a1 + hstep, voffA);
            PG8_WAIT_L(8); PG8_BAR; PG8_WAIT_L(0); PG8_MMA(0, 0, At, B0); PG8_BAR; PG8_SCHED;
            PG8_LDB(B1, 0, 1); PG8_STAGE(PG8_SB(0, 0), b2, voffB);
            PG8_BAR; PG8_WAIT_L(0); PG8_MMA(0, 1, At, B1); PG8_BAR;
            PG8_LDA(At, 0, 1); PG8_STAGE(PG8_SA(0, 0), a2, voffA);
            PG8_BAR; PG8_WAIT_L(0); PG8_MMA(1, 0, At, B0); PG8_BAR; PG8_SCHED;
            PG8_STAGE(PG8_SB(0, 1), b2 + hstep, voffB);
            PG8_WAIT_V(6); PG8_BAR; PG8_MMA(1, 1, At, B1); PG8_BAR;
            PG8_LDB(B0, 1, 0); PG8_SCHED; PG8_LDA(At, 1, 0); PG8_STAGE(PG8_SA(0, 1), a2 + hstep, voffA);
            PG8_WAIT_L(8); PG8_BAR; PG8_WAIT_L(0); PG8_MMA(0, 0, At, B0); PG8_BAR; PG8_SCHED;
            PG8_LDB(B1, 1, 1); PG8_STAGE(PG8_SB(1, 0), b3, voffB);
            PG8_BAR; PG8_WAIT_L(0); PG8_MMA(0, 1, At, B1); PG8_BAR;
            PG8_LDA(At, 1, 1); PG8_STAGE(PG8_SA(1, 0), a3, voffA);
            PG8_BAR; PG8_WAIT_L(0); PG8_MMA(1, 0, At, B0); PG8_BAR; PG8_SCHED;
            PG8_STAGE(PG8_SB(1, 1), b3 + hstep, voffB);
            PG8_WAIT_V(6); PG8_BAR; PG8_MMA(1, 1, At, B1); PG8_BAR;
            }
        }
        if constexpr (ALIGN_EPI) { if (wr == 0) PG8_BAR; }
        if constexpr (!Epi::AFTER_DRAIN) { E(acc, cur, wr, wc, fr, fq); S.done(cur); }
        if (!has_next) break;
#pragma unroll
        for (int a = 0; a < 2; ++a)
#pragma unroll
            for (int b = 0; b < 2; ++b)
#pragma unroll
                for (int m = 0; m < 4; ++m)
#pragma unroll
                    for (int n = 0; n < 2; ++n) acc[a][b][m][n] = (f32x4){0.f, 0.f, 0.f, 0.f};
        cur = nxt; cA = nA; cB = nB; ++ui;
        if constexpr (ALIGN_EPI) { if (wr == 1) PG8_BAR; }
    }
    PG8_WAIT_V(0);
    if constexpr (!ALIGN_EPI) { if (wr == 0) PG8_BAR; }
    PG8_BAR;
    if constexpr (Epi::AFTER_DRAIN) { E.fused(acc, cur, wr, wc, fr, fq, lds, wid, lane); S.done(cur); }
#undef PG8_SA
#undef PG8_SB
#undef PG8_STAGE
#undef PG8_LDA
#undef PG8_LDB
#undef PG8_MMA
#undef PG8_WAIT_V
#undef PG8_WAIT_L
#undef PG8_BAR
#undef PG8_SCHED
}
}
#include <hip/hip_cooperative_groups.h>
namespace cg = cooperative_groups;
#define DI __device__ __forceinline__
typedef unsigned short bf16;
typedef float f32x4 __attribute__((ext_vector_type(4)));
typedef short bf16x8 __attribute__((ext_vector_type(8)));
typedef unsigned u32x4 __attribute__((ext_vector_type(4)));
typedef unsigned u32x2 __attribute__((ext_vector_type(2)));
#define LAS __attribute__((address_space(3)))

constexpr int M = 32768, DM = 1024, DFF = 2816, SEQ = 4096;
constexpr float EPS = 1e-6f;
constexpr size_t HM = 512u * 1024u;
constexpr size_t WS_W = 2 * HM, WL = 83 * HM;
constexpr size_t OW_GU1 = 0, OW_D1 = 22 * HM, OW_INA = 33 * HM, OW_INB = 42 * HM, OW_OUT = 46 * HM, OW_GU2 = 50 * HM, OW_D2 = 72 * HM;
constexpr size_t WS_XB = WS_W + 2 * WL, WS_SSQ = WS_XB + 128 * HM, WS_R = WS_SSQ + 4 * HM;
constexpr size_t R_QKNA = 0, R_VT = 128 * HM, R_GR = 256 * HM, R_GP = 320 * HM, R_SBEF = 448 * HM, R_GQK = 576 * HM, R_KT = 640 * HM, R_CODES = 704 * HM, R_DEC = 708 * HM, R_END = 710 * HM;
constexpr size_t R_MIX = 576 * HM, R_H = 0;
constexpr size_t WS_END = WS_R + R_END;
constexpr int LDS_BYTES = 147456;
constexpr int NWAVES = 8;

DI unsigned pk2(float lo, float hi) { return pg8::cvt_pk_bf16(lo, hi); }
DI float bflo(unsigned w) { return __uint_as_float(w << 16); }
DI float bfhi(unsigned w) { return __uint_as_float(w & 0xffff0000u); }
DI bf16x8 ld16(const bf16* p) { return *(const bf16x8*)p; }
DI bf16x8 ld8x2(const bf16* p0, const bf16* p1) { const u32x2 a = *(const u32x2*)p0, b = *(const u32x2*)p1; u32x4 v; v.x = a.x; v.y = a.y; v.z = b.x; v.w = b.y; return __builtin_bit_cast(bf16x8, v); }
DI f32x4 mfma16(bf16x8 a, bf16x8 b, f32x4 c) { return __builtin_amdgcn_mfma_f32_16x16x32_bf16(a, b, c, 0, 0, 0); }
DI bf16x8 pack8(f32x4 a, f32x4 b) { u32x4 v; v.x = pk2(a[0], a[1]); v.y = pk2(a[2], a[3]); v.z = pk2(b[0], b[1]); v.w = pk2(b[2], b[3]); return __builtin_bit_cast(bf16x8, v); }
DI float silu_f(float x) { return x * __builtin_amdgcn_rcpf(1.0f + __expf(-x)); }
DI float wave_sum(float v) {
#pragma unroll
    for (int o = 1; o < 64; o <<= 1) v += __shfl_xor(v, o);
    return v;
}

DI void row_rstd(const float* ssq, int row0, int fq, float (&rs)[2][4]) {
#pragma unroll
    for (int ai = 0; ai < 2; ++ai)
#pragma unroll
        for (int m = 0; m < 4; ++m) {
            const f32x4 v = *(const f32x4*)(ssq + (size_t)(row0 + ai * 128 + m * 16) * 16 + 4 * fq);
            float s = (v[0] + v[1]) + (v[2] + v[3]);
            s += __shfl_xor(s, 16); s += __shfl_xor(s, 32);
            rs[ai][m] = rsqrtf(s * (1.0f / DM) + EPS);
        }
}
struct EpiSwiGLU {
    static constexpr bool PERM = true, AFTER_DRAIN = false;
    bf16* H; const float* ssq;
    DI void operator()(const f32x4 (&acc)[2][2][4][2], const pg8::Unit& u, int wr, int wc, int fr, int fq) const {
        const int row0 = u.pm * 256 + wr * 64 + fr, col0 = u.pn * 128 + wc * 32 + 8 * fq;
        float rs[2][4]; row_rstd(ssq, row0, fq, rs);
#pragma unroll
        for (int ai = 0; ai < 2; ++ai)
#pragma unroll
            for (int m = 0; m < 4; ++m) {
                typedef float f32x2 __attribute__((ext_vector_type(2)));
                const float r = rs[ai][m]; const float r2s = r * r, rls = r * -1.44269504f; const f32x2 r2 = {r2s, r2s}, rl = {rls, rls};
                unsigned hw[4];
#pragma unroll
                for (int q = 0; q < 4; ++q) {
                    const f32x4 gq = acc[ai][0][m][q >> 1], uq = acc[ai][1][m][q >> 1];
                    const f32x2 g2 = {gq[2 * (q & 1)], gq[2 * (q & 1) + 1]}, u2 = {uq[2 * (q & 1)], uq[2 * (q & 1) + 1]};
                    const f32x2 t = g2 * rl; f32x2 e; e.x = __builtin_amdgcn_exp2f(t.x); e.y = __builtin_amdgcn_exp2f(t.y);
                    const f32x2 d = e + 1.0f; f32x2 rc; rc.x = __builtin_amdgcn_rcpf(d.x); rc.y = __builtin_amdgcn_rcpf(d.y);
                    const f32x2 hv = ((g2 * u2) * r2) * rc;
                    hw[q] = pk2(hv.x, hv.y);
                }
                u32x4 w; w.x = hw[0]; w.y = hw[1]; w.z = hw[2]; w.w = hw[3];
                *(u32x4*)(H + (size_t)(row0 + ai * 128 + m * 16) * DFF + col0) = w;
            }
    }
};
struct EpiResid {
    static constexpr bool PERM = true, AFTER_DRAIN = false;
    const float* base32; bf16* XB; float* ssq; float alpha;
    DI void operator()(const f32x4 (&acc)[2][2][4][2], const pg8::Unit& u, int wr, int wc, int fr, int fq) const {
        const int row0 = u.pm * 256 + wr * 64 + fr, col0 = u.pn * 256 + wc * 32 + 8 * fq;
#pragma unroll
        for (int ai = 0; ai < 2; ++ai)
#pragma unroll
            for (int m = 0; m < 4; ++m) {
                const int row = row0 + ai * 128 + m * 16; float ss = 0.f;
#pragma unroll
                for (int bj = 0; bj < 2; ++bj) {
                    const size_t off = (size_t)row * DM + col0 + bj * 128;
                    f32x4 b0, b1;
                    if (base32) { b0 = *(const f32x4*)(base32 + off); b1 = *(const f32x4*)(base32 + off + 4); }
                    else { const u32x4 bb = *(const u32x4*)(XB + off); b0 = (f32x4){bflo(bb.x), bfhi(bb.x), bflo(bb.y), bfhi(bb.y)}; b1 = (f32x4){bflo(bb.z), bfhi(bb.z), bflo(bb.w), bfhi(bb.w)}; }
                    const f32x4 v0 = b0 + acc[ai][bj][m][0] * alpha, v1 = b1 + acc[ai][bj][m][1] * alpha;
                    ss += ((v0[0] * v0[0] + v0[1] * v0[1]) + (v0[2] * v0[2] + v0[3] * v0[3])) + ((v1[0] * v1[0] + v1[1] * v1[1]) + (v1[2] * v1[2] + v1[3] * v1[3]));
                    u32x4 w; w.x = pk2(v0[0], v0[1]); w.y = pk2(v0[2], v0[3]); w.z = pk2(v1[0], v1[1]); w.w = pk2(v1[2], v1[3]);
                    *(u32x4*)(XB + off) = w;
                }
                ss += __shfl_xor(ss, 16); ss += __shfl_xor(ss, 32);
                if (fq == 0) ssq[(size_t)row * 16 + u.pn * 4 + wc] = ss;
                asm volatile("" ::: "memory");
            }
    }
};
struct EpiProj {
    static constexpr bool PERM = true, AFTER_DRAIN = false;
    bf16* QKNA; bf16* GQK; bf16* GR; bf16* CODES; const float* ssq;
    DI void operator()(const f32x4 (&acc)[2][2][4][2], const pg8::Unit& u, int wr, int wc, int fr, int fq) const {
        const int row0 = u.pm * 256 + wr * 64 + fr; const int pn = u.pn;
        float rs[2][4]; row_rstd(ssq, row0, fq, rs);
        bf16* dst; int ld, cb;
        if (pn < 4) { dst = QKNA; ld = 1024; cb = 256 * pn; } else if (pn < 6) { dst = GQK; ld = 512; cb = 256 * (pn - 4); } else if (pn < 8) { dst = GR; ld = 512; cb = 256 * (pn - 6); } else { dst = CODES; ld = 32; cb = 0; }
        const int col0 = cb + wc * 32 + 8 * fq;
#pragma unroll
        for (int ai = 0; ai < 2; ++ai)
#pragma unroll
            for (int m = 0; m < 4; ++m) {
                const float r = rs[ai][m];
#pragma unroll
                for (int bj = 0; bj < 2; ++bj) {
                    const f32x4 a = acc[ai][bj][m][0] * r, b = acc[ai][bj][m][1] * r;
                    u32x4 w; w.x = pk2(a[0], a[1]); w.y = pk2(a[2], a[3]); w.z = pk2(b[0], b[1]); w.w = pk2(b[2], b[3]);
                    if (pn < 8 || (bj == 0 && wc == 0)) *(u32x4*)(dst + (size_t)(row0 + ai * 128 + m * 16) * ld + col0 + bj * 128) = w;
                }
            }
    }
};
struct EpiVT {
    static constexpr bool PERM = true, AFTER_DRAIN = false;
    bf16* VT; const float* ssq;
    DI void operator()(const f32x4 (&acc)[2][2][4][2], const pg8::Unit& u, int wr, int wc, int fr, int fq) const {
        const int row0 = u.pm * 256 + wr * 64 + fr, tok0 = u.pn * 256 + wc * 32 + 8 * fq;
#pragma unroll
        for (int bj = 0; bj < 2; ++bj) {
            float rs[8];
#pragma unroll
            for (int j = 0; j < 8; ++j) {
                float s = ssq[(size_t)(tok0 + bj * 128 + j) * 16 + fr];
                s += __shfl_xor(s, 1); s += __shfl_xor(s, 2); s += __shfl_xor(s, 4); s += __shfl_xor(s, 8);
                rs[j] = rsqrtf(s * (1.0f / DM) + EPS);
            }
#pragma unroll
            for (int ai = 0; ai < 2; ++ai)
#pragma unroll
                for (int m = 0; m < 4; ++m) {
                    const f32x4 a = acc[ai][bj][m][0], b = acc[ai][bj][m][1];
                    u32x4 w; w.x = pk2(a[0] * rs[0], a[1] * rs[1]); w.y = pk2(a[2] * rs[2], a[3] * rs[3]); w.z = pk2(b[0] * rs[4], b[1] * rs[5]); w.w = pk2(b[2] * rs[6], b[3] * rs[7]);
                    *(u32x4*)(VT + ((size_t)((tok0 + bj * 128) >> 3) * 1024 + (row0 + ai * 128 + m * 16)) * 8) = w;
                }
        }
    }
};

DI void conv_item(const float* W, int K, int N, int kb, int n0, bf16* dst  , const float* gain, float* scr, int lane) {
    const int k0 = 64 * kb;
#pragma unroll
    for (int i = 0; i < 8; ++i) {
        const int kk = 8 * i + (lane >> 3), cc = 4 * (lane & 7);
        f32x4 v = *(const f32x4*)(W + (size_t)(k0 + kk) * N + n0 + cc); if (gain) v = v * gain[k0 + kk];
        scr[kk * 33 + cc] = v[0]; scr[kk * 33 + cc + 1] = v[1]; scr[kk * 33 + cc + 2] = v[2]; scr[kk * 33 + cc + 3] = v[3];
    }
    asm volatile("s_waitcnt lgkmcnt(0)" ::: "memory");
    const int c = lane & 7;
#pragma unroll
    for (int j = 0; j < 4; ++j) { const int n = (lane >> 3) + 8 * j; const float* s = scr + (8 * c) * 33 + n;
        u32x4 o; o.x = pk2(s[0 * 33], s[1 * 33]); o.y = pk2(s[2 * 33], s[3 * 33]); o.z = pk2(s[4 * 33], s[5 * 33]); o.w = pk2(s[6 * 33], s[7 * 33]);
        *(u32x4*)(dst + (size_t)n * K + k0 + 8 * c) = o; }
    asm volatile("s_waitcnt lgkmcnt(0)" ::: "memory");
}
struct Args { const float* in[20]; float* out; unsigned char* ws; };
#define INP(i) ((const float*)karg(8 * (i)))
#define WSP() ((unsigned char*)karg(168))
#define OUTP() ((float*)karg(160))
typedef const char __attribute__((address_space(4)))* kaptr_t;
DI const void* karg(int off) { asm volatile("" : "+s"(off)); kaptr_t ka = (kaptr_t)__builtin_amdgcn_kernarg_segment_ptr(); return *(const void* const __attribute__((address_space(4)))*)(ka + off); }
struct KA { DI const float* inp(int i) const { return (const float*)karg(8 * i); } };

DI void prologue(const Args& A, unsigned char* lds, int wave, int lane) {
    float* scr = (float*)(lds + wave * 16384);
    const int gw = blockIdx.x * NWAVES + wave, NGW = gridDim.x * NWAVES;
    constexpr int I_GU = 16 * 88, I_D = 44 * 32, I_IN = 16 * 97, I_OUT = 16 * 32, PER_L = 6 * I_GU + I_IN + I_OUT;
    static_assert(I_GU == I_D, "");
    for (int it = gw; it < 2 * PER_L; it += NGW) {
        const int l = it / PER_L; int r = it % PER_L;
        unsigned char* wb = WSP() + WS_W + (size_t)l * WL;
        const int seg = r < 6 * I_GU ? r / I_GU : (r < 6 * I_GU + I_IN ? 6 : 7);
        if (seg < 6) {
            r -= seg * I_GU;
            const int ffn = seg / 3, kind = seg % 3;
            if (kind < 2) {
                const float* W = INP((ffn ? 16 : 2) + kind) + (size_t)l * DM * DFF; const float* gn = INP(ffn ? 15 : 1) + l * DM;
                const int kb = r / 88, nb = r % 88, n0 = 32 * nb;
                bf16* dst = (bf16*)(wb + (ffn ? OW_GU2 : OW_GU1)) + (size_t)((n0 >> 7) * 256 + kind * 128 + (n0 & 127)) * DM;
                conv_item(W, DM, DFF, kb, n0, dst, gn, scr, lane);
            } else {
                const float* W = INP(ffn ? 18 : 4) + (size_t)l * DM * DFF;
                const int kb = r / 32, nb = r % 32, n0 = 32 * nb;
                bf16* dst = (bf16*)(wb + (ffn ? OW_D2 : OW_D1)) + (size_t)n0 * DFF;
                conv_item(W, DFF, DM, kb, n0, dst, nullptr, scr, lane);
            }
        } else if (seg == 6) {
            r -= 6 * I_GU;
            const float* W = INP(6) + (size_t)l * DM * 3104; const float* gn = INP(5) + l * DM;
            const int kb = r / 97, nb = r % 97, n0 = 32 * nb;
            bf16* wa = (bf16*)(wb + OW_INA); bf16* wv = (bf16*)(wb + OW_INB); bf16* dst;
            if (n0 < 1024) dst = wa + (size_t)n0 * DM;
            else if (n0 < 1536) dst = wv + (size_t)(n0 - 1024) * DM;
            else if (n0 < 2048) dst = wa + (size_t)(n0 - 512) * DM;
            else if (n0 < 2560) dst = wv + (size_t)(n0 - 1536) * DM;
            else if (n0 < 3072) dst = wa + (size_t)(n0 - 1024) * DM;
            else dst = wa + (size_t)2048 * DM;
            conv_item(W, DM, 3104, kb, n0, dst, gn, scr, lane);
        } else {
            r -= 6 * I_GU + I_IN;
            const float* W = INP(14) + (size_t)l * DM * DM;
            const int kb = r / 32, nb = r % 32, n0 = 32 * nb;
            conv_item(W, DM, DM, kb, n0, (bf16*)(wb + OW_OUT) + (size_t)n0 * DM, nullptr, scr, lane);
        }
    }
    const float* x = INP(0); bf16* XB = (bf16*)(WSP() + WS_XB); float* ssq = (float*)(WSP() + WS_SSQ);
    for (int m = gw; m < M; m += NGW) {
        const f32x4* xr = (const f32x4*)(x + (size_t)m * DM) + lane; f32x4 v[4]; float s = 0.f;
#pragma unroll
        for (int j = 0; j < 4; ++j) { v[j] = xr[64 * j]; s += (v[j][0] * v[j][0] + v[j][1] * v[j][1]) + (v[j][2] * v[j][2] + v[j][3] * v[j][3]); }
        s = wave_sum(s);
        u32x2* o = (u32x2*)(XB + (size_t)m * DM) + lane;
#pragma unroll
        for (int j = 0; j < 4; ++j) { u32x2 w; w.x = pk2(v[j][0], v[j][1]); w.y = pk2(v[j][2], v[j][3]); o[64 * j] = w; }
        if (lane < 16) ssq[(size_t)m * 16 + lane] = lane == 0 ? s : 0.f;
    }
}
#define SCHED_FENCE() __builtin_amdgcn_sched_barrier(0)
DI float log_sigmoid_f(float z) { return fminf(z, 0.f) - __logf(1.0f + __expf(-fabsf(z))); }
DI void gla_prep_item(const Args& A, int l, unsigned char* ldsb, int item, int tid, bool stage) {
    float* gl = (float*)ldsb; float* tot = gl + 2 * 64 * 65; float* wg = tot + 512; float* bg = wg + 2048; bf16* T = (bf16*)(bg + 128);
    unsigned char* R = WSP() + WS_R;
    const bf16* CODES = (const bf16*)(R + R_CODES); const bf16* GQK = (const bf16*)(R + R_GQK);
    bf16* GP = (bf16*)(R + R_GP); bf16* KT = (bf16*)(R + R_KT); float* DEC = (float*)(R + R_DEC);
    const int c = item & 63, bh = item >> 6, h = bh & 3, b = bh >> 2;
    const size_t tok0 = (size_t)b * SEQ + c * 64;
    const int t = tid >> 3, dg = tid & 7;
    const u32x4* cp = (const u32x4*)(CODES + (tok0 + t) * 32);
    const u32x4 cq0 = cp[0], cq1 = cp[1], cq2 = cp[2], cq3 = cp[3];
    const u32x4 qv = *(const u32x4*)(GQK + (tok0 + t) * 512 + h * 64 + 8 * dg), kv = *(const u32x4*)(GQK + (tok0 + t) * 512 + 256 + h * 64 + 8 * dg);
    if (stage) {
        const int idx = tid * 4, dir = idx >> 10, r = (idx >> 6) & 15, d = idx & 63;
        const float* w = (dir ? INP(11) : INP(9)) + (size_t)l * 16 * 256 + r * 256 + h * 64 + d;
        *(f32x4*)(wg + idx) = *(const f32x4*)w;
        if (tid < 128) { const int dr = tid >> 6, dd = tid & 63; bg[tid] = (dr ? INP(12) : INP(10))[l * 256 + h * 64 + dd]; }
        __syncthreads();
    }
    {
        float cf[32];
#pragma unroll
        for (int j = 0; j < 4; ++j) { const u32x4 v = j == 0 ? cq0 : (j == 1 ? cq1 : (j == 2 ? cq2 : cq3)); cf[8 * j + 0] = bflo(v.x); cf[8 * j + 1] = bfhi(v.x); cf[8 * j + 2] = bflo(v.y); cf[8 * j + 3] = bfhi(v.y); cf[8 * j + 4] = bflo(v.z); cf[8 * j + 5] = bfhi(v.z); cf[8 * j + 6] = bflo(v.w); cf[8 * j + 7] = bfhi(v.w); }
#pragma unroll
        for (int dir = 0; dir < 2; ++dir) {
            float z[8];
#pragma unroll
            for (int dd = 0; dd < 8; ++dd) z[dd] = bg[dir * 64 + 8 * dg + dd];
#pragma unroll
            for (int r = 0; r < 16; ++r) {
                const f32x4 w0 = *(const f32x4*)(wg + dir * 1024 + r * 64 + 8 * dg), w1 = *(const f32x4*)(wg + dir * 1024 + r * 64 + 8 * dg + 4);
                const float cv = cf[dir * 16 + r];
                z[0] += cv * w0[0]; z[1] += cv * w0[1]; z[2] += cv * w0[2]; z[3] += cv * w0[3]; z[4] += cv * w1[0]; z[5] += cv * w1[1]; z[6] += cv * w1[2]; z[7] += cv * w1[3];
            }
#pragma unroll
            for (int dd = 0; dd < 8; ++dd) gl[(dir * 64 + t) * 65 + 8 * dg + dd] = log_sigmoid_f(z[dd]) * (1.0f / 16.0f);
        }
    }
    __syncthreads();
    {
        const int dir = tid >> 8, seg = (tid >> 6) & 3, d = tid & 63;
        float* gp = gl + (dir * 64 + 16 * seg) * 65 + d; float v[16];
#pragma unroll
        for (int tt = 0; tt < 16; ++tt) v[tt] = gp[tt * 65];
        if (dir == 0) {
#pragma unroll
            for (int tt = 1; tt < 16; ++tt) v[tt] += v[tt - 1];
        } else {
#pragma unroll
            for (int tt = 14; tt >= 0; --tt) v[tt] += v[tt + 1];
        }
        tot[(dir * 4 + seg) * 64 + d] = dir == 0 ? v[15] : v[0];
        __syncthreads();
        float off = 0.f;
        if (dir == 0) { for (int s2 = 0; s2 < 4; ++s2) if (s2 < seg) off += tot[s2 * 64 + d]; }
        else { for (int s2 = 0; s2 < 4; ++s2) if (s2 > seg) off += tot[(4 + s2) * 64 + d]; }
#pragma unroll
        for (int tt = 0; tt < 16; ++tt) gp[tt * 65] = v[tt] + off;
    }
    __syncthreads();
    {
        float q[8], k[8];
        q[0] = bflo(qv.x); q[1] = bfhi(qv.x); q[2] = bflo(qv.y); q[3] = bfhi(qv.y); q[4] = bflo(qv.z); q[5] = bfhi(qv.z); q[6] = bflo(qv.w); q[7] = bfhi(qv.w);
        k[0] = bflo(kv.x); k[1] = bfhi(kv.x); k[2] = bflo(kv.y); k[3] = bfhi(kv.y); k[4] = bflo(kv.z); k[5] = bfhi(kv.z); k[6] = bflo(kv.w); k[7] = bfhi(kv.w);
        float qf[8], kf[8], qb[8], kb[8];
#pragma unroll
        for (int dd = 0; dd < 8; ++dd) {
            const int d = 8 * dg + dd;
            const float bf = gl[t * 65 + d], bb = gl[(64 + t) * 65 + d], bfl = gl[63 * 65 + d], bb0 = gl[64 * 65 + d];
            qf[dd] = q[dd] * 0.125f * __expf(bf); kf[dd] = k[dd] * __expf(-bf);
            qb[dd] = q[dd] * 0.125f * __expf(bb); kb[dd] = k[dd] * __expf(-bb);
            T[d * 72 + t] = (bf16)(pk2(k[dd] * __expf(bfl - bf), 0.f) & 0xffffu);
            T[(64 + d) * 72 + t] = (bf16)(pk2(k[dd] * __expf(bb0 - bb), 0.f) & 0xffffu);
        }
        const size_t go = (tok0 + t) * 256 + h * 64 + 8 * dg; const size_t AS = (size_t)M * 256;
        u32x4 w;
        w.x = pk2(qf[0], qf[1]); w.y = pk2(qf[2], qf[3]); w.z = pk2(qf[4], qf[5]); w.w = pk2(qf[6], qf[7]); *(u32x4*)(GP + go) = w;
        w.x = pk2(kf[0], kf[1]); w.y = pk2(kf[2], kf[3]); w.z = pk2(kf[4], kf[5]); w.w = pk2(kf[6], kf[7]); *(u32x4*)(GP + AS + go) = w;
        w.x = pk2(qb[0], qb[1]); w.y = pk2(qb[2], qb[3]); w.z = pk2(qb[4], qb[5]); w.w = pk2(qb[6], qb[7]); *(u32x4*)(GP + 2 * AS + go) = w;
        w.x = pk2(kb[0], kb[1]); w.y = pk2(kb[2], kb[3]); w.z = pk2(kb[4], kb[5]); w.w = pk2(kb[6], kb[7]); *(u32x4*)(GP + 3 * AS + go) = w;
        if (tid < 128) { const int dir = tid >> 6, d = tid & 63; DEC[((size_t)(dir * 32 + bh) * 64 + c) * 64 + d] = __expf(dir ? gl[64 * 65 + d] : gl[63 * 65 + d]); }
    }
    __syncthreads();
#pragma unroll
    for (int i = 0; i < 2; ++i) {
        const int u = tid + 512 * i, dir = u >> 9, d = (u >> 3) & 63, j = u & 7;
        *(u32x4*)(KT + ((size_t)((tok0 >> 3) + j) * 512 + dir * 256 + h * 64 + d) * 8) = *(const u32x4*)(T + (dir * 64 + d) * 72 + 8 * j);
    }
    __syncthreads();
}

DI void gla_scan_item(const Args& A, int item, int wave, int lane) {
    unsigned char* R = WSP() + WS_R;
    const bf16* VT = (const bf16*)(R + R_VT); const bf16* KT = (const bf16*)(R + R_KT); const float* DEC = (const float*)(R + R_DEC); bf16* SBEF = (bf16*)(R + R_SBEF);
    const int es = item & 3, chain = item >> 2, dir = chain >> 5, bh = chain & 31, h = bh & 3, b = bh >> 2;
    const int c = lane & 15, g = lane >> 4, ebl = wave >> 2, db = wave & 3, e0 = 32 * es + 16 * ebl;
    const bf16* kp = KT + ((size_t)(b * 512 + g) * 512 + dir * 256 + h * 64 + 16 * db + c) * 8;
    const bf16* vp = VT + ((size_t)(b * 512 + g) * 1024 + 512 + h * 128 + e0 + c) * 8;
    const float* dp = DEC + (size_t)chain * 64 * 64 + 16 * db + 4 * g;
    bf16* sp = SBEF + ((size_t)chain * 64 * 128 + e0 + c) * 64 + 16 * db + 4 * g;
    f32x4 S = {0.f, 0.f, 0.f, 0.f};
#define SC_CH(n) (dir ? 63 - (n) : (n))
#define SC_LOAD(k, n) do { const int c_ = SC_CH((n) < 63 ? (n) : 63); a0##k = ld16(kp + (size_t)c_ * 32768); a1##k = ld16(kp + (size_t)c_ * 32768 + 16384); b0##k = ld16(vp + (size_t)c_ * 65536); b1##k = ld16(vp + (size_t)c_ * 65536 + 32768); dc##k = *(const f32x4*)(dp + c_ * 64); } while (0)
#define SC_STEP(k, n) do { u32x2 w_; w_.x = pk2(S[0], S[1]); w_.y = pk2(S[2], S[3]); *(u32x2*)(sp + (size_t)SC_CH(n) * 128 * 64) = w_; S = S * dc##k; S = mfma16(a0##k, b0##k, S); S = mfma16(a1##k, b1##k, S); } while (0)
    bf16x8 a00, a10, b00, b10, a01, a11, b01, b11, a02, a12, b02, b12, a03, a13, b03, b13; f32x4 dc0, dc1, dc2, dc3;
    SC_LOAD(0, 0); SC_LOAD(1, 1); SC_LOAD(2, 2); SC_LOAD(3, 3);
#pragma unroll 1
    for (int n = 0; n < 64; n += 4) {
        SC_STEP(0, n); SC_LOAD(0, n + 4);
        SC_STEP(1, n + 1); SC_LOAD(1, n + 5);
        SC_STEP(2, n + 2); SC_LOAD(2, n + 6);
        SC_STEP(3, n + 3); SC_LOAD(3, n + 7);
    }
#undef SC_CH
#undef SC_LOAD
#undef SC_STEP
}

DI void gla_out_item(const Args& A, int l, int item, int tb, int lane) {
    unsigned char* R = WSP() + WS_R;
    const bf16* VT = (const bf16*)(R + R_VT); const bf16* GP = (const bf16*)(R + R_GP); const bf16* SBEF = (const bf16*)(R + R_SBEF); const bf16* GR = (const bf16*)(R + R_GR); bf16* MIX = (bf16*)(R + R_MIX);
    const size_t AS = (size_t)M * 256;
    const int ck = item & 63, bh = item >> 6, h = bh & 3, b = bh >> 2, c = lane & 15, g = lane >> 4;
    const size_t tok0 = (size_t)b * SEQ + ck * 64;
    const size_t qo = (tok0 + 16 * tb + c) * 256 + h * 64 + 8 * g;
    const bf16x8 qf0 = ld16(GP + qo), qf1 = ld16(GP + qo + 32), qb0 = ld16(GP + 2 * AS + qo), qb1 = ld16(GP + 2 * AS + qo + 32);
    bf16x8 kfr[8], kbr[8];
#pragma unroll
    for (int i = 0; i < 8; ++i) {
        const size_t ko = (tok0 + 16 * (i >> 1) + c) * 256 + h * 64 + 8 * g + 32 * (i & 1);
        kfr[i] = ld16(GP + AS + ko); kbr[i] = ld16(GP + 3 * AS + ko);
    }
    const bf16* sf = SBEF + ((size_t)(bh * 64 + ck) * 128 + c) * 64 + 8 * g;
    const bf16* sbk = SBEF + ((size_t)((32 + bh) * 64 + ck) * 128 + c) * 64 + 8 * g;
    const bf16* vt = VT + ((size_t)((tok0 >> 3) + (g >> 1)) * 1024 + 512 + h * 128 + c) * 8 + 4 * (g & 1);
    u32x2 vv[2][8]; bf16x8 sv[2][8];
#define GO_LOAD(buf, eb0) do { _Pragma("unroll") for (int e_ = 0; e_ < 2; ++e_) { const bf16* v_ = vt + 128 * ((eb0) + e_); \
        vv[buf][4 * e_ + 0] = *(const u32x2*)(v_); vv[buf][4 * e_ + 1] = *(const u32x2*)(v_ + 16384); vv[buf][4 * e_ + 2] = *(const u32x2*)(v_ + 32768); vv[buf][4 * e_ + 3] = *(const u32x2*)(v_ + 49152); \
        sv[buf][4 * e_ + 0] = ld16(sf + ((eb0) + e_) * 1024); sv[buf][4 * e_ + 1] = ld16(sf + ((eb0) + e_) * 1024 + 32); sv[buf][4 * e_ + 2] = ld16(sbk + ((eb0) + e_) * 1024); sv[buf][4 * e_ + 3] = ld16(sbk + ((eb0) + e_) * 1024 + 32); } } while (0)
    GO_LOAD(0, 0);
    SCHED_FENCE();
    f32x4 at[4];
#pragma unroll
    for (int sb = 0; sb < 4; ++sb) {
        f32x4 f = {0.f, 0.f, 0.f, 0.f}, bk = {0.f, 0.f, 0.f, 0.f};
        f = mfma16(kfr[2 * sb], qf0, f); f = mfma16(kfr[2 * sb + 1], qf1, f);
        bk = mfma16(kbr[2 * sb], qb0, bk); bk = mfma16(kbr[2 * sb + 1], qb1, bk);
#pragma unroll
        for (int i = 0; i < 4; ++i) at[sb][i] = (16 * sb + 4 * g + i <= 16 * tb + c) ? f[i] : bk[i];
    }
    const bf16x8 p0 = pack8(at[0], at[1]), p1 = pack8(at[2], at[3]);
    SCHED_FENCE();
    f32x4 o[8]; float ss = 0.f;
#pragma unroll
    for (int bp = 0; bp < 4; ++bp) {
        if (bp < 3) GO_LOAD((bp + 1) & 1, 2 * bp + 2);
        SCHED_FENCE();
#pragma unroll
        for (int e = 0; e < 2; ++e) {
            f32x4 acc = {0.f, 0.f, 0.f, 0.f};
            const u32x2 v0 = vv[bp & 1][4 * e], v1 = vv[bp & 1][4 * e + 1], v2 = vv[bp & 1][4 * e + 2], v3 = vv[bp & 1][4 * e + 3];
            u32x4 a0; a0.x = v0.x; a0.y = v0.y; a0.z = v1.x; a0.w = v1.y; u32x4 a1; a1.x = v2.x; a1.y = v2.y; a1.z = v3.x; a1.w = v3.y;
            acc = mfma16(__builtin_bit_cast(bf16x8, a0), p0, acc); acc = mfma16(__builtin_bit_cast(bf16x8, a1), p1, acc);
            acc = mfma16(sv[bp & 1][4 * e], qf0, acc); acc = mfma16(sv[bp & 1][4 * e + 1], qf1, acc);
            acc = mfma16(sv[bp & 1][4 * e + 2], qb0, acc); acc = mfma16(sv[bp & 1][4 * e + 3], qb1, acc);
            o[2 * bp + e] = acc; ss += (acc[0] * acc[0] + acc[1] * acc[1]) + (acc[2] * acc[2] + acc[3] * acc[3]);
        }
        SCHED_FENCE();
    }
#undef GO_LOAD
    ss += __shfl_xor(ss, 16); ss += __shfl_xor(ss, 32);
    const float rstd = rsqrtf(ss * (1.0f / 128.0f) + EPS);
    const float* gain = INP(13) + l * 128 + 4 * g;
    const size_t tok = tok0 + 16 * tb + c;
#pragma unroll
    for (int eb = 0; eb < 8; ++eb) {
        const f32x4 gn = *(const f32x4*)(gain + 16 * eb);
        const u32x2 gr = *(const u32x2*)(GR + tok * 512 + h * 128 + 16 * eb + 4 * g);
        const float r0 = bflo(gr.x), r1 = bfhi(gr.x), r2 = bflo(gr.y), r3 = bfhi(gr.y);
        u32x2 w; w.x = pk2(o[eb][0] * rstd * gn[0] * silu_f(r0), o[eb][1] * rstd * gn[1] * silu_f(r1)); w.y = pk2(o[eb][2] * rstd * gn[2] * silu_f(r2), o[eb][3] * rstd * gn[3] * silu_f(r3));
        *(u32x2*)(MIX + tok * 1024 + 512 + h * 128 + 16 * eb + 4 * g) = w;
    }
}

DI void na_stage_rpb(int l, float* rpbs, int tid) {
    const float* rpb = INP(7) + (size_t)l * 8 * 465;
    for (int i = tid; i < 8 * 465; i += NWAVES * 64) rpbs[i] = rpb[i];
    __syncthreads();
}
DI void na_item(const Args& A, int l, float* nss, const float* rpbs, int item, int h, int lane) {
    unsigned char* R = WSP() + WS_R;
    const bf16* QK = (const bf16*)(R + R_QKNA); const bf16* VT = (const bf16*)(R + R_VT); bf16* MIX = (bf16*)(R + R_MIX);
    const float* rpb = rpbs + h * 465;
    const int c = lane & 15, g = lane >> 4;
    const int j = item & 3, r = (item >> 2) & 63, b = item >> 8;
    const int rs = min(max(r - 4, 0), 56), c0 = min(max(16 * j - 8, 0), 32);
    const size_t tokq = (size_t)b * SEQ + r * 64 + 16 * j + c;
    const bf16x8 q0 = ld16(QK + tokq * 1024 + h * 64 + 8 * g), q1 = ld16(QK + tokq * 1024 + h * 64 + 32 + 8 * g);
    const bf16* kbase = QK + ((size_t)b * SEQ + rs * 64 + c0 + c) * 1024 + 512 + h * 64 + 8 * g;
    const bf16* vbase = VT + ((size_t)((b * SEQ + rs * 64 + c0 + 4 * g) >> 3) * 1024 + h * 64 + c) * 8 + 4 * (g & 1);
    f32x4 st[8][2];
    bf16x8 kf[2][16];
#pragma unroll
    for (int bb = 0; bb < 2; ++bb)
#pragma unroll
        for (int i = 0; i < 16; ++i) kf[bb][i] = ld16(kbase + (size_t)(4 * bb + (i >> 2)) * 65536 + ((i >> 1) & 1) * 16384 + (i & 1) * 32);
    SCHED_FENCE();
    u32x2 vf[2][16];
#pragma unroll
    for (int bb = 0; bb < 2; ++bb) {
#pragma unroll
        for (int t = 0; t < 8; ++t) {
            f32x4 s = {0.f, 0.f, 0.f, 0.f}; s = mfma16(kf[bb][2 * t], q0, s); s = mfma16(kf[bb][2 * t + 1], q1, s); st[4 * bb + (t >> 1)][t & 1] = s;
        }
        SCHED_FENCE();
        if (bb == 0) {
#pragma unroll
            for (int i = 0; i < 16; ++i) vf[0][i] = *(const u32x2*)(vbase + (size_t)(i >> 3) * 65536 + 128 * ((i >> 1) & 3) + (i & 1) * 16384);
            SCHED_FENCE();
        }
    }
    const int qc = 16 * j + c, cs = min(max(qc - 8, 0), 48);
    float mx = -3.0e38f;
#pragma unroll
    for (int w = 0; w < 8; ++w) {
        const float* rp = rpb + (rs + w - r + 7) * 31;
#pragma unroll
        for (int hf = 0; hf < 2; ++hf)
#pragma unroll
            for (int i = 0; i < 4; ++i) {
                const int kc = c0 + 16 * hf + 4 * g + i; const bool valid = (kc >= cs) && (kc < cs + 16);
                const int dc = min(max(kc - qc + 15, 0), 30);
                const float bv = rp[dc];
                const float s = valid ? st[w][hf][i] * 0.125f + bv : -1.0e30f;
                st[w][hf][i] = s; mx = fmaxf(mx, s);
            }
    }
    mx = fmaxf(mx, __shfl_xor(mx, 16)); mx = fmaxf(mx, __shfl_xor(mx, 32));
    float sum = 0.f;
#pragma unroll
    for (int w = 0; w < 8; ++w)
#pragma unroll
        for (int hf = 0; hf < 2; ++hf)
#pragma unroll
            for (int i = 0; i < 4; ++i) { const float p = __expf(st[w][hf][i] - mx); st[w][hf][i] = p; sum += p; }
    sum += __shfl_xor(sum, 16); sum += __shfl_xor(sum, 32);
    f32x4 o[4];
#pragma unroll
    for (int db = 0; db < 4; ++db) o[db] = (f32x4){0.f, 0.f, 0.f, 0.f};
#pragma unroll
    for (int wp = 0; wp < 4; ++wp) {
        if (wp < 3) {
#pragma unroll
            for (int i = 0; i < 16; ++i) vf[(wp + 1) & 1][i] = *(const u32x2*)(vbase + (size_t)(2 * wp + 2 + (i >> 3)) * 65536 + 128 * ((i >> 1) & 3) + (i & 1) * 16384);
        }
        SCHED_FENCE();
#pragma unroll
        for (int ww = 0; ww < 2; ++ww) {
            const bf16x8 p = pack8(st[2 * wp + ww][0], st[2 * wp + ww][1]);
#pragma unroll
            for (int db = 0; db < 4; ++db) {
                const u32x2 lo = vf[wp & 1][8 * ww + 2 * db], hi = vf[wp & 1][8 * ww + 2 * db + 1];
                u32x4 v; v.x = lo.x; v.y = lo.y; v.z = hi.x; v.w = hi.y;
                o[db] = mfma16(__builtin_bit_cast(bf16x8, v), p, o[db]);
            }
        }
        SCHED_FENCE();
    }
    const float inv = 1.0f / sum; float ss = 0.f;
#pragma unroll
    for (int db = 0; db < 4; ++db) { o[db] = o[db] * inv; ss += (o[db][0] * o[db][0] + o[db][1] * o[db][1]) + (o[db][2] * o[db][2] + o[db][3] * o[db][3]); }
    ss += __shfl_xor(ss, 16); ss += __shfl_xor(ss, 32);
    if (g == 0) nss[h * 16 + c] = ss;
    __syncthreads();
    float tot = 0.f;
#pragma unroll
    for (int hh = 0; hh < 8; ++hh) tot += nss[hh * 16 + c];
    const float rstd = rsqrtf(tot * (1.0f / 512.0f) + EPS);
    const float* gain = INP(8) + l * 512 + h * 64 + 4 * g;
#pragma unroll
    for (int db = 0; db < 4; ++db) {
        const f32x4 gn = *(const f32x4*)(gain + 16 * db);
        u32x2 w; w.x = pk2(o[db][0] * rstd * gn[0], o[db][1] * rstd * gn[1]); w.y = pk2(o[db][2] * rstd * gn[2], o[db][3] * rstd * gn[3]);
        *(u32x2*)(MIX + tokq * 1024 + h * 64 + 16 * db + 4 * g) = w;
    }
    __syncthreads();
}

struct NaKV { bf16x8 k[4]; u32x2 v[8]; };
DI NaKV na_load_kv(const bf16* kbase, const bf16* vbase, int krel) {
    NaKV f;
#pragma unroll
    for (int i = 0; i < 4; ++i) f.k[i] = ld16(kbase + (size_t)krel * 65536 + (i >> 1) * 16384 + (i & 1) * 32);
#pragma unroll
    for (int i = 0; i < 8; ++i) f.v[i] = *(const u32x2*)(vbase + (size_t)krel * 65536 + 128 * (i >> 1) + (i & 1) * 16384);
    return f;
}
DI void na_pair(const NaKV& f, bf16x8 q0, bf16x8 q1, const float* rp  , const int (&dcv)[8], unsigned vmask, float& m, float& l, f32x4 (&o)[4]) {
    f32x4 s0 = {0.f, 0.f, 0.f, 0.f}, s1 = {0.f, 0.f, 0.f, 0.f};
    s0 = mfma16(f.k[0], q0, s0); s0 = mfma16(f.k[1], q1, s0);
    s1 = mfma16(f.k[2], q0, s1); s1 = mfma16(f.k[3], q1, s1);
    float sv[8]; float mx = -1.0e30f;
#pragma unroll
    for (int e = 0; e < 8; ++e) {
        const float raw = e < 4 ? s0[e] : s1[e - 4];
        const float bv = rp[dcv[e]];
        sv[e] = ((vmask >> e) & 1u) ? raw * 0.125f + bv : -1.0e30f;
        mx = fmaxf(mx, sv[e]);
    }
    mx = fmaxf(mx, __shfl_xor(mx, 16)); mx = fmaxf(mx, __shfl_xor(mx, 32));
    const float mn = fmaxf(m, mx), alpha = __expf(m - mn); m = mn;
    float ps = 0.f; f32x4 p0, p1;
#pragma unroll
    for (int e = 0; e < 4; ++e) { p0[e] = __expf(sv[e] - mn); p1[e] = __expf(sv[4 + e] - mn); ps += p0[e] + p1[e]; }
    l = l * alpha + ps;
    const bf16x8 p = pack8(p0, p1);
#pragma unroll
    for (int db = 0; db < 4; ++db) {
        u32x4 v; v.x = f.v[2 * db].x; v.y = f.v[2 * db].y; v.z = f.v[2 * db + 1].x; v.w = f.v[2 * db + 1].y;
        o[db] = mfma16(__builtin_bit_cast(bf16x8, v), p, o[db] * alpha);
    }
}
DI void na_strip(const Args& A, int l, float* nss, const float* rpbs, int item, int h, int lane) {
    unsigned char* R = WSP() + WS_R;
    const bf16* QK = (const bf16*)(R + R_QKNA); const bf16* VT = (const bf16*)(R + R_VT); bf16* MIX = (bf16*)(R + R_MIX);
    const float* rpb = rpbs + h * 465;
    const int c = lane & 15, g = lane >> 4;
    const int j = item & 3, r0 = ((item >> 2) & 15) * 4, b = item >> 6;
    const int c0 = min(max(16 * j - 8, 0), 32);
    const int kmin = min(max(r0 - 4, 0), 56), kmax = min(max(r0 + 3 - 4, 0), 56) + 7, nrows = kmax - kmin + 1;
    const int qc = 16 * j + c, cs = min(max(qc - 8, 0), 48);
    int dcv[8]; unsigned vmask = 0u;
#pragma unroll
    for (int e = 0; e < 8; ++e) { const int kc = c0 + 16 * (e >> 2) + 4 * g + (e & 3); if (kc >= cs && kc < cs + 16) vmask |= 1u << e; dcv[e] = min(max(kc - qc + 15, 0), 30); }
    bf16x8 q0[4], q1[4];
#pragma unroll
    for (int i = 0; i < 4; ++i) { const bf16* qp = QK + ((size_t)b * SEQ + (r0 + i) * 64 + 16 * j + c) * 1024 + h * 64 + 8 * g; q0[i] = ld16(qp); q1[i] = ld16(qp + 32); }
    const bf16* kbase = QK + ((size_t)b * SEQ + kmin * 64 + c0 + c) * 1024 + 512 + h * 64 + 8 * g;
    const bf16* vbase = VT + ((size_t)((b * SEQ + kmin * 64 + c0 + 4 * g) >> 3) * 1024 + h * 64 + c) * 8 + 4 * (g & 1);
    float m[4], ls[4]; f32x4 o[4][4];
#pragma unroll
    for (int i = 0; i < 4; ++i) { m[i] = -1.0e30f; ls[i] = 0.f;
#pragma unroll
        for (int db = 0; db < 4; ++db) o[i][db] = (f32x4){0.f, 0.f, 0.f, 0.f}; }
    int rs[4];
#pragma unroll
    for (int i = 0; i < 4; ++i) rs[i] = min(max(r0 + i - 4, 0), 56);
#define NA_ROW(F, KR) do { _Pragma("unroll") for (int i_ = 0; i_ < 4; ++i_) { if ((KR) >= rs[i_] && (KR) <= rs[i_] + 7) na_pair(F, q0[i_], q1[i_], rpb + ((KR) - (r0 + i_) + 7) * 31, dcv, vmask, m[i_], ls[i_], o[i_]); } } while (0)
    NaKV fa = na_load_kv(kbase, vbase, 0), fb;
#pragma unroll 1
    for (int t = 0; t < nrows; t += 2) {
        fb = na_load_kv(kbase, vbase, min(t + 1, nrows - 1));
        SCHED_FENCE();
        NA_ROW(fa, kmin + t);
        SCHED_FENCE();
        fa = na_load_kv(kbase, vbase, min(t + 2, nrows - 1));
        SCHED_FENCE();
        if (t + 1 < nrows) NA_ROW(fb, kmin + t + 1);
        SCHED_FENCE();
    }
#undef NA_ROW
    float ssv[4];
#pragma unroll
    for (int i = 0; i < 4; ++i) {
        float lt = ls[i]; lt += __shfl_xor(lt, 16); lt += __shfl_xor(lt, 32);
        const float inv = 1.0f / lt; float ss = 0.f;
#pragma unroll
        for (int db = 0; db < 4; ++db) { o[i][db] = o[i][db] * inv; ss += (o[i][db][0] * o[i][db][0] + o[i][db][1] * o[i][db][1]) + (o[i][db][2] * o[i][db][2] + o[i][db][3] * o[i][db][3]); }
        ss += __shfl_xor(ss, 16); ss += __shfl_xor(ss, 32);
        ssv[i] = ss;
        if (g == 0) nss[(i * 8 + h) * 16 + c] = ss;
    }
    __syncthreads();
    const float* gain = INP(8) + l * 512 + h * 64 + 4 * g;
#pragma unroll
    for (int i = 0; i < 4; ++i) {
        float tot = 0.f;
#pragma unroll
        for (int hh = 0; hh < 8; ++hh) tot += nss[(i * 8 + hh) * 16 + c];
        const float rstd = rsqrtf(tot * (1.0f / 512.0f) + EPS);
        const size_t tokq = (size_t)b * SEQ + (r0 + i) * 64 + 16 * j + c;
#pragma unroll
        for (int db = 0; db < 4; ++db) {
            const f32x4 gn = *(const f32x4*)(gain + 16 * db);
            u32x2 w; w.x = pk2(o[i][db][0] * rstd * gn[0], o[i][db][1] * rstd * gn[1]); w.y = pk2(o[i][db][2] * rstd * gn[2], o[i][db][3] * rstd * gn[3]);
            *(u32x2*)(MIX + tokq * 1024 + h * 64 + 16 * db + 4 * g) = w;
        }
    }
    (void)ssv;
    __syncthreads();
}

#define XB_TMO      128
#define XB_XCNT(j)  (256  + 64 * (j))
#define XB_XSUB(j)  (1280 + 64 * (j))
#define XB_XGEN(j)  (2304 + 64 * (j))
#define XB_TOP      3328
#define XB_TOPGEN   3392
#define XCD_BAR_WORDS 3456
#define XB_SPIN_CAP (1u << 18)

__device__ __forceinline__ unsigned xb_ld(unsigned* p)              { return __hip_atomic_load(p, __ATOMIC_RELAXED, __HIP_MEMORY_SCOPE_AGENT); }
__device__ __forceinline__ unsigned xb_add(unsigned* p, unsigned v) { return __hip_atomic_fetch_add(p, v, __ATOMIC_RELAXED, __HIP_MEMORY_SCOPE_AGENT); }
__device__ __forceinline__ unsigned xb_xcc_id() { return (unsigned)__builtin_amdgcn_s_getreg((3 << 11) | 20) & 0xFu; }
#define XB_SPIN(cond, bar) do { unsigned _sp = 0; while (cond) { __builtin_amdgcn_s_sleep(1); \
    if ((++_sp & 255u) == 0u) { if (xb_ld(&(bar)[XB_TMO])) break; if (_sp > XB_SPIN_CAP) { atomicAdd(&(bar)[XB_TMO], 1u); break; } } } } while (0)

struct XcdBarrier {
    unsigned* bar; unsigned x;
    volatile LAS unsigned* st;
};

__device__ __forceinline__ XcdBarrier xcd_barrier_post(unsigned* bar, volatile LAS unsigned* st) {
    XcdBarrier b; b.bar = bar; b.x = xb_xcc_id(); b.st = st;
    if (threadIdx.x == 0) (void)xb_add(&bar[XB_XCNT(b.x)], 1u);
    return b;
}
__device__ __forceinline__ void xcd_barrier_complete(unsigned* bar, unsigned x, unsigned& nloc, unsigned& nx) {
    const unsigned G = gridDim.x * gridDim.y * gridDim.z;
    unsigned sum, cnt, mine, sp = 0u;
    for (;;) {
        sum = 0u; cnt = 0u; mine = 0u;
#pragma unroll
        for (unsigned j = 0; j < 16; ++j) { const unsigned c = xb_ld(&bar[XB_XCNT(j)]); sum += c; cnt += (c > 0u) ? 1u : 0u; mine = (j == x) ? c : mine; }
        if (sum == G) break;
        __builtin_amdgcn_s_sleep(1);
        if ((++sp & 255u) == 0u) { if (xb_ld(&bar[XB_TMO])) break; if (sp > XB_SPIN_CAP) { atomicAdd(&bar[XB_TMO], 1u); break; } }
    }
    nloc = mine > 0u ? mine : 1u; nx = cnt > 0u ? cnt : 1u;
}

__device__ __forceinline__ void xcd_barrier(const XcdBarrier& b) {
    asm volatile("s_waitcnt vmcnt(0)" ::: "memory");
    __syncthreads();
    if (threadIdx.x == 0) {
        unsigned* bar = b.bar;
        __builtin_amdgcn_s_waitcnt(0);
        unsigned nloc = b.st[0], nx = b.st[1];
        if (nloc == 0u) { xcd_barrier_complete(bar, b.x, nloc, nx); b.st[0] = nloc; b.st[1] = nx; }
        const unsigned old = xb_add(&bar[XB_XSUB(b.x)], 1u);
        const unsigned gen = old / nloc;
        if (old + 1u == (gen + 1u) * nloc) {
            __builtin_amdgcn_fence(__ATOMIC_RELEASE, "agent");
            asm volatile("s_waitcnt vmcnt(0)" ::: "memory");
            const unsigned og = xb_add(&bar[XB_TOP], 1u);
            const unsigned tg = og / nx;
            if (og + 1u == (tg + 1u) * nx) xb_add(&bar[XB_TOPGEN], 1u);
            else XB_SPIN(xb_ld(&bar[XB_TOPGEN]) == tg, bar);
            __builtin_amdgcn_fence(__ATOMIC_ACQUIRE, "agent");
            xb_add(&bar[XB_XGEN(b.x)], 1u);
            asm volatile("s_waitcnt vmcnt(0)" ::: "memory");
        } else {
            XB_SPIN(xb_ld(&bar[XB_XGEN(b.x)]) == gen, bar);
            __builtin_amdgcn_fence(__ATOMIC_ACQUIRE, "agent");
            asm volatile("s_waitcnt vmcnt(0)" ::: "memory");
        }
    }
    __syncthreads();
}

#ifndef REP_PRO
#define REP_PRO 1
#define REP_SYNC 1
#define REP_GEMM 1
#define REP_PREP 1
#define REP_SCAN 1
#define REP_OUT 1
#define REP_NA 1
#endif
#define LAUNDER_TID int t_ = threadIdx.x; asm volatile("" : "+v"(t_)); const int tid = t_, lane = t_ & 63, wave = __builtin_amdgcn_readfirstlane(t_ >> 6); (void)tid; (void)lane; (void)wave;
#define GSYNC() do { for (int r_ = 0; r_ < REP_SYNC; ++r_) xcd_barrier(xbar); } while (0)
__global__ void __launch_bounds__(NWAVES * 64, 2) fwd_megakernel(Args A) {
    extern __shared__ __attribute__((aligned(16))) unsigned char lds[];
    cg::grid_group grid = cg::this_grid();
    const int G = gridDim.x, bx = blockIdx.x;
    LAS unsigned char* ldsg = (LAS unsigned char*)lds;
    unsigned char* ws = WSP(); unsigned char* R = ws + WS_R;
    bf16* XB = (bf16*)(ws + WS_XB); float* SSQ = (float*)(ws + WS_SSQ); float* X = OUTP();
    bf16* H = (bf16*)(R + R_H); bf16* MIX = (bf16*)(R + R_MIX);

    if (threadIdx.x < 16) ((volatile LAS unsigned*)(ldsg + 131072 + 64))[threadIdx.x] = 0u;
    __syncthreads();
    volatile LAS unsigned* ldsw = (volatile LAS unsigned*)(ldsg + 131072 + 64);
    XcdBarrier xbar; xbar.bar = (unsigned*)ws; xbar.x = xb_xcc_id(); xbar.st = ldsw;
    if (threadIdx.x == 0) ldsw[4] = xb_add(&xbar.bar[XB_XCNT(xbar.x)], 1u);
    for (int rep = 0; rep < REP_PRO; ++rep) { LAUNDER_TID prologue(A, lds, wave, lane); }
    if (G > (1 << 20)) grid.sync();
    xcd_barrier(xbar);
    if (threadIdx.x == 0) {
        bool ok = (G % 8 == 0);
        for (unsigned j = 0; j < 16; ++j) { const unsigned cn = xb_ld(&xbar.bar[XB_XCNT(j)]); ok = ok && (cn == (j < 8 ? (unsigned)(G / 8) : 0u)); }
        ldsw[5] = ok ? (xbar.x + 8u * ldsw[4]) : (unsigned)bx;
    }
    __syncthreads();
    const int vcu = __builtin_amdgcn_readfirstlane((int)ldsw[5]);

#pragma unroll 1
    for (int l = 0; l < 2; ++l) {
        unsigned char* wb = ws + WS_W + (size_t)l * WL;
        for (int rep = 0; rep < REP_GEMM; ++rep) {
            pg8::Gemm gm{XB, (const bf16*)(wb + OW_GU1), M, 2 * DFF, DM}; pg8::StaticOrder S; S.init(M, 2 * DFF, G, vcu);
            EpiSwiGLU E{H, SSQ};
            pg8::gemm_phase<EpiSwiGLU, pg8::StaticOrder, true, true>(ldsg, gm, S, E);
        }
        GSYNC();
        for (int rep = 0; rep < REP_GEMM; ++rep) {
            pg8::Gemm gm{H, (const bf16*)(wb + OW_D1), M, DM, DFF}; pg8::StaticOrder S; S.init(M, DM, G, vcu);
            EpiResid E{(l == 0 && rep == 0) ? INP(0) : (const float*)nullptr, XB, SSQ, rep == 0 ? 0.5f : 0.f};
            pg8::gemm_phase<EpiResid, pg8::StaticOrder, true, true>(ldsg, gm, S, E);
        }
        GSYNC();
        for (int rep = 0; rep < REP_GEMM; ++rep) {
            pg8::Gemm gm{XB, (const bf16*)(wb + OW_INA), M, 2304, DM}; pg8::StaticOrder S; S.init(M, 2304, G, vcu);
            EpiProj E{(bf16*)(R + R_QKNA), (bf16*)(R + R_GQK), (bf16*)(R + R_GR), (bf16*)(R + R_CODES), SSQ};
            pg8::gemm_phase<EpiProj, pg8::StaticOrder, true, true>(ldsg, gm, S, E);
            pg8::Gemm gv{(const bf16*)(wb + OW_INB), XB, 1024, M, DM}; pg8::StaticOrder S2; S2.init(1024, M, G, vcu);
            EpiVT E2{(bf16*)(R + R_VT), SSQ};
            pg8::gemm_phase<EpiVT, pg8::StaticOrder, true, true>(ldsg, gv, S2, E2);
        }
        GSYNC();
        for (int rep = 0; rep < REP_PREP; ++rep) { LAUNDER_TID int ph_ = -1; for (int it = vcu; it < 2048; it += G) { const int h_ = (it >> 6) & 3; gla_prep_item(A, l, lds, it, tid, h_ != ph_); ph_ = h_; } }
        GSYNC();
        for (int rep = 0; rep < REP_SCAN; ++rep) { LAUNDER_TID for (int it = vcu; it < 256; it += G) gla_scan_item(A, G == 256 ? (((it >> 5) * 8 + (it & 7)) * 4 + ((it >> 3) & 3)) : it, wave, lane); }
        GSYNC();
        for (int rep = 0; rep < REP_OUT; ++rep) { LAUNDER_TID for (int it = vcu; it < 1024; it += G) gla_out_item(A, l, 2 * it + (wave >> 2), wave & 3, lane); }
        for (int rep = 0; rep < REP_NA; ++rep) { LAUNDER_TID na_stage_rpb(l, (float*)lds + 512, tid); if (G % 8 == 0) { for (int li = vcu >> 3; li < 64; li += (G >> 3)) na_strip(A, l, (float*)lds, (const float*)lds + 512, ((vcu & 7) << 6) | li, wave, lane); } else { for (int it = vcu; it < 512; it += G) na_strip(A, l, (float*)lds, (const float*)lds + 512, it, wave, lane); } }
        GSYNC();
        for (int rep = 0; rep < REP_GEMM; ++rep) {
            pg8::Gemm gm{MIX, (const bf16*)(wb + OW_OUT), M, DM, DM}; pg8::StaticOrder S; S.init(M, DM, G, vcu);
            EpiResid E{nullptr, XB, SSQ, rep == 0 ? 1.0f : 0.f};
            pg8::gemm_phase<EpiResid, pg8::StaticOrder, true, true>(ldsg, gm, S, E);
        }
        GSYNC();
        for (int rep = 0; rep < REP_GEMM; ++rep) {
            pg8::Gemm gm{XB, (const bf16*)(wb + OW_GU2), M, 2 * DFF, DM}; pg8::StaticOrder S; S.init(M, 2 * DFF, G, vcu);
            EpiSwiGLU E{H, SSQ};
            pg8::gemm_phase<EpiSwiGLU, pg8::StaticOrder, true, true>(ldsg, gm, S, E);
        }
        GSYNC();
        for (int rep = 0; rep < REP_GEMM; ++rep) {
            pg8::Gemm gm{H, (const bf16*)(wb + OW_D2), M, DM, DFF}; pg8::StaticOrder S; S.init(M, DM, G, vcu);
            EpiResid E{nullptr, XB, SSQ, rep == 0 ? 0.5f : 0.f};
            pg8::gemm_phase<EpiResid, pg8::StaticOrder, true, true>(ldsg, gm, S, E);
        }
        GSYNC();
    }
    {
        LAUNDER_TID
        const float* gn = INP(19);
        const int gw = vcu * NWAVES + wave, NGW = G * NWAVES;
        for (int m = gw; m < M; m += NGW) {
            float s = lane < 16 ? SSQ[(size_t)m * 16 + lane] : 0.f; s = wave_sum(s);
            const float rstd = rsqrtf(s * (1.0f / DM) + EPS);
            f32x4* xr = (f32x4*)(X + (size_t)m * DM) + lane; const f32x4* gr = (const f32x4*)gn + lane; const u32x2* xb = (const u32x2*)(XB + (size_t)m * DM) + lane;
#pragma unroll
            for (int j = 0; j < 4; ++j) { const u32x2 bb = xb[64 * j]; const f32x4 v = {bflo(bb.x), bfhi(bb.x), bflo(bb.y), bfhi(bb.y)}; xr[64 * j] = v * rstd * gr[64 * j]; }
        }
    }
}

extern "C" void kernel_launch(void* const* d_in, const int* in_sizes, int n_in, void* d_out, int out_size, void* d_ws, size_t ws_size, hipStream_t stream) {
    static int grid = 0;
    if (grid == 0) {
        if (n_in != 20 || out_size != M * DM || ws_size < WS_END) { fprintf(stderr, "kernel_launch: unexpected shapes / workspace (n_in %d out %d ws %zu need %zu)\n", n_in, out_size, ws_size, (size_t)WS_END); grid = -1; return; }
        int dev = 0, cus = 0, per_cu = 0;
        hipGetDevice(&dev); hipDeviceGetAttribute(&cus, hipDeviceAttributeMultiprocessorCount, dev);
        hipFuncSetAttribute((const void*)fwd_megakernel, hipFuncAttributeMaxDynamicSharedMemorySize, LDS_BYTES);
        hipOccupancyMaxActiveBlocksPerMultiprocessor(&per_cu, (const void*)fwd_megakernel, NWAVES * 64, LDS_BYTES);
        if (per_cu < 1) per_cu = 1;
        grid = cus * per_cu;
        (void)hipGetLastError();
    }
    if (grid < 0) return;
    Args a{};
    for (int i = 0; i < 20; ++i) a.in[i] = (const float*)d_in[i];
    a.out = (float*)d_out; a.ws = (unsigned char*)d_ws;
    if (hipMemsetAsync(d_ws, 0, 16384, stream) != hipSuccess) { fprintf(stderr, "memset failed\n"); return; }
    void* args[] = {&a};
    hipError_t e = hipLaunchCooperativeKernel((const void*)fwd_megakernel, dim3(grid), dim3(NWAVES * 64), args, LDS_BYTES, stream);
    if (e != hipSuccess) fprintf(stderr, "cooperative launch failed: %s (grid %d)\n", hipGetErrorString(e), grid);
}
```

```cpp
#include <hip/hip_runtime.h>
#include <cstdio>
#include <cstdint>
namespace pg8 {
#define PG8_LAS __attribute__((address_space(3)))
typedef unsigned short bf16_t;
typedef short bf16x8 __attribute__((ext_vector_type(8)));
typedef float f32x4 __attribute__((ext_vector_type(4)));
typedef unsigned u32x4 __attribute__((ext_vector_type(4)));
constexpr int BM = 256, BK = 64, HALF = 128, HTB = HALF * BK * 2  , STAGE_BYTES = 8 * HTB, NXCD = 8, WGM = 8;

__host__ __device__ __forceinline__ int lds_byte(int r, int c) { const int st = (r >> 4) * 2 + (c >> 5), rr = r & 15, cc = c & 31, ob = rr * 64 + cc * 2; return st * 1024 + (ob ^ (((ob >> 9) & 1) << 5)); }
__host__ __device__ __forceinline__ void stage_rc(int b, int& R, int& C) { const int st = b / 1024, sb = b % 1024, swz = sb ^ (((sb >> 9) & 1) << 5); R = (st >> 1) * 16 + swz / 64; C = (st & 1) * 32 + (swz % 64) / 2; }
__host__ __device__ __forceinline__ int perm32(int rho) { const int n = rho >> 4, i = rho & 15; return 8 * (i >> 2) + 4 * n + (i & 3); }

struct Unit { int pm, pn; };
struct Gemm { const bf16_t* A; const bf16_t* Bt; int M, N, K; };

struct StaticOrder {
    int nM, nN, nwg, G, c;
    __host__ __device__ void init(int M, int N, int G_, int c_) { nM = M / BM; nN = N / BM; nwg = nM * nN; G = G_; c = c_; }
    __host__ __device__ bool next(int i, Unit& u) const {
        const long L = (long)i * G + c; if (L >= nwg) return false;
        int wgid = (int)L; { const int q = nwg / NXCD, r = nwg % NXCD, xcd = wgid % NXCD, off = wgid / NXCD; wgid = (xcd < r ? xcd * (q + 1) : r * (q + 1) + (xcd - r) * q) + off; }
        const int nig = WGM * nN, gid = wgid / nig, fm = gid * WGM, gsz = (nM - fm) < WGM ? (nM - fm) : WGM;
        u.pm = fm + ((wgid % nig) % gsz); u.pn = (wgid % nig) / gsz; return true;
    }
    __device__ __forceinline__ void a_ready(const Unit&) const {}
    __device__ __forceinline__ void done(const Unit&) const {}
};

__device__ __forceinline__ unsigned cvt_pk_bf16(float lo, float hi) { unsigned r; asm volatile("v_cvt_pk_bf16_f32 %0, %1, %2" : "=v"(r) : "v"(lo), "v"(hi)); return r; }
typedef float f32x2 __attribute__((ext_vector_type(2)));
template <class Epi, class Sched, bool ALIGN_EPI = false, bool SP2 = false>
__device__ __forceinline__ void gemm_phase(PG8_LAS unsigned char* lds, const Gemm g, const Sched& S, const Epi& E) {
    int tid_ = threadIdx.x; asm volatile("" : "+v"(tid_));
    const int tid = tid_, wid = __builtin_amdgcn_readfirstlane(tid >> 6), lane = tid & 63, wr = wid >> 2, wc = wid & 3, fr = lane & 15, fq = lane >> 4;
    const int K = g.K, nt = K / BK;
    unsigned voffA[2], voffB[2];
#pragma unroll
    for (int i = 0; i < 2; ++i) { int R, C; stage_rc(tid * 16 + i * 8192, R, C); const int Rb = Epi::PERM ? ((R & ~31) + perm32(R & 31)) : R;
        voffA[i] = (unsigned)(R * K + C) * 2u; voffB[i] = (unsigned)(Rb * K + C) * 2u; }
    const size_t kstep = (size_t)(BK * 2);
    const size_t hstep = (size_t)HALF * K * 2;
    const size_t tstep = 2 * hstep;
    const unsigned ldsw = (unsigned)wid * 1024u;
    const int aoff = lds_byte(wr * 64 + fr, fq * 8), boff = lds_byte(wc * 32 + fr, fq * 8);
#define PG8_SA(b, h) (((b) * 2 + (h)) * HTB)
#define PG8_SB(b, h) ((4 + (b) * 2 + (h)) * HTB)
#define PG8_STAGE(bufoff, gbase, voff) do { _Pragma("unroll") for (int _i = 0; _i < 2; ++_i) \
        __builtin_amdgcn_global_load_lds((const unsigned*)((const char*)(gbase) + (voff)[_i]), (PG8_LAS unsigned*)(lds + (bufoff) + ldsw + _i * 8192), 16, 0, 0); } while (0)
#define PG8_LDA(dst, b, h) do { _Pragma("unroll") for (int m = 0; m < 4; ++m) _Pragma("unroll") for (int k = 0; k < 2; ++k) dst[m][k] = *(const PG8_LAS bf16x8*)(lds + PG8_SA(b, h) + aoff + m * 2048 + k * 1024); } while (0)
#define PG8_LDB(dst, b, h) do { _Pragma("unroll") for (int n = 0; n < 2; ++n) _Pragma("unroll") for (int k = 0; k < 2; ++k) dst[n][k] = *(const PG8_LAS bf16x8*)(lds + PG8_SB(b, h) + boff + n * 2048 + k * 1024); } while (0)
#define PG8_MMA(ai, bj, At, Bt) do { __builtin_amdgcn_s_setprio(1); _Pragma("unroll") for (int m = 0; m < 4; ++m) _Pragma("unroll") for (int n = 0; n < 2; ++n) _Pragma("unroll") for (int k = 0; k < 2; ++k) \
        acc[ai][bj][m][n] = __builtin_amdgcn_mfma_f32_16x16x32_bf16(Bt[n][k], At[m][k], acc[ai][bj][m][n], 0, 0, 0); __builtin_amdgcn_s_setprio(0); } while (0)
#define PG8_WAIT_V(n) asm volatile("s_waitcnt vmcnt(" #n ")" ::: "memory")
#define PG8_WAIT_L(n) asm volatile("s_waitcnt lgkmcnt(" #n ")" ::: "memory")
#define PG8_BAR __builtin_amdgcn_s_barrier()
#define PG8_SCHED __builtin_amdgcn_sched_barrier(0)
    Unit cur, nxt; int ui = 0;
    if (!S.next(0, cur)) return;
    f32x4 acc[2][2][4][2];
#pragma unroll
    for (int a = 0; a < 2; ++a)
#pragma unroll
        for (int b = 0; b < 2; ++b)
#pragma unroll
            for (int m = 0; m < 4; ++m)
#pragma unroll
                for (int n = 0; n < 2; ++n) acc[a][b][m][n] = (f32x4){0.f, 0.f, 0.f, 0.f};
    bf16x8 At[4][2], B0[2][2], B1[2][2];
    const char* cA = (const char*)g.A + (size_t)cur.pm * tstep; const char* cB = (const char*)g.Bt + (size_t)cur.pn * tstep;
    S.a_ready(cur);
    if constexpr (SP2) {
        PG8_STAGE(PG8_SB(0, 0), cB, voffB); PG8_STAGE(PG8_SB(0, 1), cB + hstep, voffB); PG8_STAGE(PG8_SA(0, 0), cA, voffA); PG8_STAGE(PG8_SA(0, 1), cA + hstep, voffA);
        if (wr == 1) PG8_BAR;
        PG8_WAIT_V(2); PG8_BAR;
        PG8_STAGE(PG8_SB(1, 0), cB + kstep, voffB); PG8_STAGE(PG8_SA(1, 0), cA + kstep, voffA); PG8_STAGE(PG8_SB(1, 1), cB + hstep + kstep, voffB);
        PG8_WAIT_V(6); PG8_BAR;
    } else {
        PG8_STAGE(PG8_SB(0, 0), cB, voffB); PG8_STAGE(PG8_SA(0, 0), cA, voffA); PG8_STAGE(PG8_SB(0, 1), cB + hstep, voffB); PG8_STAGE(PG8_SA(0, 1), cA + hstep, voffA);
        if (wr == 1) PG8_BAR;
        PG8_WAIT_V(4); PG8_BAR;
        PG8_STAGE(PG8_SB(1, 0), cB + kstep, voffB); PG8_STAGE(PG8_SA(1, 0), cA + kstep, voffA); PG8_STAGE(PG8_SB(1, 1), cB + hstep + kstep, voffB);
        PG8_WAIT_V(6); PG8_BAR;
    }
    for (;;) {
        const bool has_next = S.next(ui + 1, nxt);
        const char* nA = has_next ? (const char*)g.A + (size_t)nxt.pm * tstep : cA; const char* nB = has_next ? (const char*)g.Bt + (size_t)nxt.pn * tstep : cB;
        for (int t = 0; t < nt; t += 2) {
            const bool last = (t == nt - 2);
            const char* a1 = cA + (size_t)(t + 1) * kstep;
            const char* a2 = last ? nA : cA + (size_t)(t + 2) * kstep; const char* b2 = last ? nB : cB + (size_t)(t + 2) * kstep;
            const char* a3 = a2 + kstep; const char* b3 = b2 + kstep;
            if (last && has_next) S.a_ready(nxt);
            if constexpr (SP2) {
            PG8_LDB(B0, 0, 0); PG8_LDB(B1, 0, 1); PG8_SCHED; PG8_LDA(At, 0, 0); PG8_STAGE(PG8_SA(1, 1), a1 + hstep, voffA);
            PG8_WAIT_V(8); PG8_WAIT_L(0); PG8_BAR; PG8_MMA(0, 0, At, B0); PG8_MMA(0, 1, At, B1); PG8_BAR; PG8_SCHED;
            PG8_LDA(At, 0, 1); PG8_STAGE(PG8_SB(0, 0), b2, voffB); PG8_STAGE(PG8_SB(0, 1), b2 + hstep, voffB); PG8_STAGE(PG8_SA(0, 0), a2, voffA);
            PG8_WAIT_V(8); PG8_WAIT_L(0); PG8_BAR; PG8_MMA(1, 0, At, B0); PG8_MMA(1, 1, At, B1); PG8_BAR; PG8_SCHED;
            PG8_LDB(B0, 1, 0); PG8_LDB(B1, 1, 1); PG8_SCHED; PG8_LDA(At, 1, 0); PG8_STAGE(PG8_SA(0, 1), a2 + hstep, voffA);
            PG8_WAIT_V(8); PG8_WAIT_L(0); PG8_BAR; PG8_MMA(0, 0, At, B0); PG8_MMA(0, 1, At, B1); PG8_BAR; PG8_SCHED;
            PG8_LDA(At, 1, 1); PG8_STAGE(PG8_SB(1, 0), b3, voffB); PG8_STAGE(PG8_SB(1, 1), b3 + hstep, voffB); PG8_STAGE(PG8_SA(1, 0), a3, voffA);
            PG8_WAIT_V(8); PG8_WAIT_L(0); PG8_BAR; PG8_MMA(1, 0, At, B0); PG8_MMA(1, 1, At, B1); PG8_BAR; PG8_SCHED;
            } else {
            PG8_LDB(B0, 0, 0); PG8_SCHED; PG8_LDA(At, 0, 0); PG8_STAGE(PG8_SA(1, 1), a1 + hstep, voffA);
            PG8_WAIT_L(8); PG8_BAR; PG8_WAIT_L(0); PG8_MMA(0, 0, At, B0); PG8_BAR; PG8_SCHED;
            PG8_LDB(B1, 0, 1); PG8_STAGE(PG8_SB(0, 0), b2, voffB);
            PG8_BAR; PG8_WAIT_L(0); PG8_MMA(0, 1, At, B1); PG8_BAR;
            PG8_LDA(At, 0, 1); PG8_STAGE(PG8_SA(0, 0), a2, voffA);
            PG8_BAR; PG8_WAIT_L(0); PG8_MMA(1, 0, At, B0); PG8_BAR; PG8_SCHED;
            PG8_STAGE(PG8_SB(0, 1), b2 + hstep, voffB);
            PG8_WAIT_V(6); PG8_BAR; PG8_MMA(1, 1, At, B1); PG8_BAR;
            PG8_LDB(B0, 1, 0); PG8_SCHED; PG8_LDA(At, 1, 0); PG8_STAGE(PG8_SA(0, 1), a2 + hstep, voffA);
            PG8_WAIT_L(8); PG8_BAR; PG8_WAIT_L(0); PG8_MMA(0, 0, At, B0); PG8_BAR; PG8_SCHED;
            PG8_LDB(B1, 1, 1); PG8_STAGE(PG8_SB(1, 0), b3, voffB);
            PG8_BAR; PG8_WAIT_L(0); PG8_MMA(0, 1, At, B1); PG8_BAR;
            PG8_LDA(At, 1, 1); PG8_STAGE(PG8_SA(1, 0), a3, voffA);
            PG8_BAR; PG8_WAIT_L(0); PG8_MMA(1, 0, At, B0); PG8_BAR; PG8_SCHED;
            PG8_STAGE(PG8_SB(1, 1), b3 + hstep, voffB);
            PG8_WAIT_V(6); PG8_BAR; PG8_MMA(1, 1, At, B1); PG8_BAR;
            }
        }
        if constexpr (ALIGN_EPI) { if (wr == 0) PG8_BAR; }
        if constexpr (!Epi::AFTER_DRAIN) { E(acc, cur, wr, wc, fr, fq); S.done(cur); }
        if (!has_next) break;
#pragma unroll
        for (int a = 0; a < 2; ++a)
#pragma unroll
            for (int b = 0; b < 2; ++b)
#pragma unroll
                for (int m = 0; m < 4; ++m)
#pragma unroll
                    for (int n = 0; n < 2; ++n) acc[a][b][m][n] = (f32x4){0.f, 0.f, 0.f, 0.f};
        cur = nxt; cA = nA; cB = nB; ++ui;
        if constexpr (ALIGN_EPI) { if (wr == 1) PG8_BAR; }
    }
    PG8_WAIT_V(0);
    if constexpr (!ALIGN_EPI) { if (wr == 0) PG8_BAR; }
    PG8_BAR;
    if constexpr (Epi::AFTER_DRAIN) { E.fused(acc, cur, wr, wc, fr, fq, lds, wid, lane); S.done(cur); }
#undef PG8_SA
#undef PG8_SB
#undef PG8_STAGE
#undef PG8_LDA
#undef PG8_LDB
#undef PG8_MMA
#undef PG8_WAIT_V
#undef PG8_WAIT_L
#undef PG8_BAR
#undef PG8_SCHED
}
}
#include <hip/hip_cooperative_groups.h>
namespace cg = cooperative_groups;
#define DI __device__ __forceinline__
typedef unsigned short bf16;
typedef float f32x4 __attribute__((ext_vector_type(4)));
typedef short bf16x8 __attribute__((ext_vector_type(8)));
typedef unsigned u32x4 __attribute__((ext_vector_type(4)));
typedef unsigned u32x2 __attribute__((ext_vector_type(2)));
#define LAS __attribute__((address_space(3)))

constexpr int M = 32768, DM = 1024, DFF = 2816, SEQ = 4096;
constexpr float EPS = 1e-6f;
constexpr size_t HM = 512u * 1024u;
constexpr size_t WS_W = 2 * HM, WL = 83 * HM;
constexpr size_t OW_GU1 = 0, OW_D1 = 22 * HM, OW_INA = 33 * HM, OW_INB = 42 * HM, OW_OUT = 46 * HM, OW_GU2 = 50 * HM, OW_D2 = 72 * HM;
constexpr size_t WS_XB = WS_W + 2 * WL, WS_SSQ = WS_XB + 128 * HM, WS_R = WS_SSQ + 4 * HM;
constexpr size_t R_QKNA = 0, R_VT = 128 * HM, R_GR = 256 * HM, R_GP = 320 * HM, R_SBEF = 448 * HM, R_GQK = 576 * HM, R_KT = 640 * HM, R_CODES = 704 * HM, R_DEC = 708 * HM, R_END = 710 * HM;
constexpr size_t R_MIX = 576 * HM, R_H = 0;
constexpr size_t WS_END = WS_R + R_END;
constexpr int LDS_BYTES = 147456;
constexpr int NWAVES = 8;

DI unsigned pk2(float lo, float hi) { return pg8::cvt_pk_bf16(lo, hi); }
DI float bflo(unsigned w) { return __uint_as_float(w << 16); }
DI float bfhi(unsigned w) { return __uint_as_float(w & 0xffff0000u); }
DI bf16x8 ld16(const bf16* p) { return *(const bf16x8*)p; }
DI bf16x8 ld8x2(const bf16* p0, const bf16* p1) { const u32x2 a = *(const u32x2*)p0, b = *(const u32x2*)p1; u32x4 v; v.x = a.x; v.y = a.y; v.z = b.x; v.w = b.y; return __builtin_bit_cast(bf16x8, v); }
DI f32x4 mfma16(bf16x8 a, bf16x8 b, f32x4 c) { return __builtin_amdgcn_mfma_f32_16x16x32_bf16(a, b, c, 0, 0, 0); }
DI bf16x8 pack8(f32x4 a, f32x4 b) { u32x4 v; v.x = pk2(a[0], a[1]); v.y = pk2(a[2], a[3]); v.z = pk2(b[0], b[1]); v.w = pk2(b[2], b[3]); return __builtin_bit_cast(bf16x8, v); }
DI float silu_f(float x) { return x * __builtin_amdgcn_rcpf(1.0f + __expf(-x)); }
DI float wave_sum(float v) {
#pragma unroll
    for (int o = 1; o < 64; o <<= 1) v += __shfl_xor(v, o);
    return v;
}

DI void row_rstd(const float* ssq, int row0, int fq, float (&rs)[2][4]) {
#pragma unroll
    for (int ai = 0; ai < 2; ++ai)
#pragma unroll
        for (int m = 0; m < 4; ++m) {
            const f32x4 v = *(const f32x4*)(ssq + (size_t)(row0 + ai * 128 + m * 16) * 16 + 4 * fq);
            float s = (v[0] + v[1]) + (v[2] + v[3]);
            s += __shfl_xor(s, 16); s += __shfl_xor(s, 32);
            rs[ai][m] = rsqrtf(s * (1.0f / DM) + EPS);
        }
}
struct EpiSwiGLU {
    static constexpr bool PERM = true, AFTER_DRAIN = false;
    bf16* H; const float* ssq;
    DI void operator()(const f32x4 (&acc)[2][2][4][2], const pg8::Unit& u, int wr, int wc, int fr, int fq) const {
        const int row0 = u.pm * 256 + wr * 64 + fr, col0 = u.pn * 128 + wc * 32 + 8 * fq;
        float rs[2][4]; row_rstd(ssq, row0, fq, rs);
#pragma unroll
        for (int ai = 0; ai < 2; ++ai)
#pragma unroll
            for (int m = 0; m < 4; ++m) {
                typedef float f32x2 __attribute__((ext_vector_type(2)));
                const float r = rs[ai][m]; const float r2s = r * r, rls = r * -1.44269504f; const f32x2 r2 = {r2s, r2s}, rl = {rls, rls};
                unsigned hw[4];
#pragma unroll
                for (int q = 0; q < 4; ++q) {
                    const f32x4 gq = acc[ai][0][m][q >> 1], uq = acc[ai][1][m][q >> 1];
                    const f32x2 g2 = {gq[2 * (q & 1)], gq[2 * (q & 1) + 1]}, u2 = {uq[2 * (q & 1)], uq[2 * (q & 1) + 1]};
                    const f32x2 t = g2 * rl; f32x2 e; e.x = __builtin_amdgcn_exp2f(t.x); e.y = __builtin_amdgcn_exp2f(t.y);
                    const f32x2 d = e + 1.0f; f32x2 rc; rc.x = __builtin_amdgcn_rcpf(d.x); rc.y = __builtin_amdgcn_rcpf(d.y);
                    const f32x2 hv = ((g2 * u2) * r2) * rc;
                    hw[q] = pk2(hv.x, hv.y);
                }
                u32x4 w; w.x = hw[0]; w.y = hw[1]; w.z = hw[2]; w.w = hw[3];
                *(u32x4*)(H + (size_t)(row0 + ai * 128 + m * 16) * DFF + col0) = w;
            }
    }
};
struct EpiResid {
    static constexpr bool PERM = true, AFTER_DRAIN = false;
    const float* base32; bf16* XB; float* ssq; float alpha;
    DI void operator()(const f32x4 (&acc)[2][2][4][2], const pg8::Unit& u, int wr, int wc, int fr, int fq) const {
        const int row0 = u.pm * 256 + wr * 64 + fr, col0 = u.pn * 256 + wc * 32 + 8 * fq;
#pragma unroll
        for (int ai = 0; ai < 2; ++ai)
#pragma unroll
            for (int m = 0; m < 4; ++m) {
                const int row = row0 + ai * 128 + m * 16; float ss = 0.f;
#pragma unroll
                for (int bj = 0; bj < 2; ++bj) {
                    const size_t off = (size_t)row * DM + col0 + bj * 128;
                    f32x4 b0, b1;
                    if (base32) { b0 = *(const f32x4*)(base32 + off); b1 = *(const f32x4*)(base32 + off + 4); }
                    else { const u32x4 bb = *(const u32x4*)(XB + off); b0 = (f32x4){bflo(bb.x), bfhi(bb.x), bflo(bb.y), bfhi(bb.y)}; b1 = (f32x4){bflo(bb.z), bfhi(bb.z), bflo(bb.w), bfhi(bb.w)}; }
                    const f32x4 v0 = b0 + acc[ai][bj][m][0] * alpha, v1 = b1 + acc[ai][bj][m][1] * alpha;
                    ss += ((v0[0] * v0[0] + v0[1] * v0[1]) + (v0[2] * v0[2] + v0[3] * v0[3])) + ((v1[0] * v1[0] + v1[1] * v1[1]) + (v1[2] * v1[2] + v1[3] * v1[3]));
                    u32x4 w; w.x = pk2(v0[0], v0[1]); w.y = pk2(v0[2], v0[3]); w.z = pk2(v1[0], v1[1]); w.w = pk2(v1[2], v1[3]);
                    *(u32x4*)(XB + off) = w;
                }
                ss += __shfl_xor(ss, 16); ss += __shfl_xor(ss, 32);
                if (fq == 0) ssq[(size_t)row * 16 + u.pn * 4 + wc] = ss;
                asm volatile("" ::: "memory");
            }
    }
};
struct EpiProj {
    static constexpr bool PERM = true, AFTER_DRAIN = false;
    bf16* QKNA; bf16* GQK; bf16* GR; bf16* CODES; const float* ssq;
    DI void operator()(const f32x4 (&acc)[2][2][4][2], const pg8::Unit& u, int wr, int wc, int fr, int fq) const {
        const int row0 = u.pm * 256 + wr * 64 + fr; const int pn = u.pn;
        float rs[2][4]; row_rstd(ssq, row0, fq, rs);
        bf16* dst; int ld, cb;
        if (pn < 4) { dst = QKNA; ld = 1024; cb = 256 * pn; } else if (pn < 6) { dst = GQK; ld = 512; cb = 256 * (pn - 4); } else if (pn < 8) { dst = GR; ld = 512; cb = 256 * (pn - 6); } else { dst = CODES; ld = 32; cb = 0; }
        const int col0 = cb + wc * 32 + 8 * fq;
#pragma unroll
        for (int ai = 0; ai < 2; ++ai)
#pragma unroll
            for (int m = 0; m < 4; ++m) {
                const float r = rs[ai][m];
#pragma unroll
                for (int bj = 0; bj < 2; ++bj) {
                    const f32x4 a = acc[ai][bj][m][0] * r, b = acc[ai][bj][m][1] * r;
                    u32x4 w; w.x = pk2(a[0], a[1]); w.y = pk2(a[2], a[3]); w.z = pk2(b[0], b[1]); w.w = pk2(b[2], b[3]);
                    if (pn < 8 || (bj == 0 && wc == 0)) *(u32x4*)(dst + (size_t)(row0 + ai * 128 + m * 16) * ld + col0 + bj * 128) = w;
                }
            }
    }
};
struct EpiVT {
    static constexpr bool PERM = true, AFTER_DRAIN = false;
    bf16* VT; const float* ssq;
    DI void operator()(const f32x4 (&acc)[2][2][4][2], const pg8::Unit& u, int wr, int wc, int fr, int fq) const {
        const int row0 = u.pm * 256 + wr * 64 + fr, tok0 = u.pn * 256 + wc * 32 + 8 * fq;
#pragma unroll
        for (int bj = 0; bj < 2; ++bj) {
            float rs[8];
#pragma unroll
            for (int j = 0; j < 8; ++j) {
                float s = ssq[(size_t)(tok0 + bj * 128 + j) * 16 + fr];
                s += __shfl_xor(s, 1); s += __shfl_xor(s, 2); s += __shfl_xor(s, 4); s += __shfl_xor(s, 8);
                rs[j] = rsqrtf(s * (1.0f / DM) + EPS);
            }
#pragma unroll
            for (int ai = 0; ai < 2; ++ai)
#pragma unroll
                for (int m = 0; m < 4; ++m) {
                    const f32x4 a = acc[ai][bj][m][0], b = acc[ai][bj][m][1];
                    u32x4 w; w.x = pk2(a[0] * rs[0], a[1] * rs[1]); w.y = pk2(a[2] * rs[2], a[3] * rs[3]); w.z = pk2(b[0] * rs[4], b[1] * rs[5]); w.w = pk2(b[2] * rs[6], b[3] * rs[7]);
                    *(u32x4*)(VT + ((size_t)((tok0 + bj * 128) >> 3) * 1024 + (row0 + ai * 128 + m * 16)) * 8) = w;
                }
        }
    }
};

DI void conv_item(const float* W, int K, int N, int kb, int n0, bf16* dst  , const float* gain, float* scr, int lane) {
    const int k0 = 64 * kb;
#pragma unroll
    for (int i = 0; i < 8; ++i) {
        const int kk = 8 * i + (lane >> 3), cc = 4 * (lane & 7);
        f32x4 v = *(const f32x4*)(W + (size_t)(k0 + kk) * N + n0 + cc); if (gain) v = v * gain[k0 + kk];
        scr[kk * 33 + cc] = v[0]; scr[kk * 33 + cc + 1] = v[1]; scr[kk * 33 + cc + 2] = v[2]; scr[kk * 33 + cc + 3] = v[3];
    }
    asm volatile("s_waitcnt lgkmcnt(0)" ::: "memory");
    const int c = lane & 7;
#pragma unroll
    for (int j = 0; j < 4; ++j) { const int n = (lane >> 3) + 8 * j; const float* s = scr + (8 * c) * 33 + n;
        u32x4 o; o.x = pk2(s[0 * 33], s[1 * 33]); o.y = pk2(s[2 * 33], s[3 * 33]); o.z = pk2(s[4 * 33], s[5 * 33]); o.w = pk2(s[6 * 33], s[7 * 33]);
        *(u32x4*)(dst + (size_t)n * K + k0 + 8 * c) = o; }
    asm volatile("s_waitcnt lgkmcnt(0)" ::: "memory");
}
struct Args { const float* in[20]; float* out; unsigned char* ws; };
#define INP(i) ((const float*)karg(8 * (i)))
#define WSP() ((unsigned char*)karg(168))
#define OUTP() ((float*)karg(160))
typedef const char __attribute__((address_space(4)))* kaptr_t;
DI const void* karg(int off) { asm volatile("" : "+s"(off)); kaptr_t ka = (kaptr_t)__builtin_amdgcn_kernarg_segment_ptr(); return *(const void* const __attribute__((address_space(4)))*)(ka + off); }
struct KA { DI const float* inp(int i) const { return (const float*)karg(8 * i); } };

DI void prologue(const Args& A, unsigned char* lds, int wave, int lane) {
    float* scr = (float*)(lds + wave * 16384);
    const int gw = blockIdx.x * NWAVES + wave, NGW = gridDim.x * NWAVES;
    constexpr int I_GU = 16 * 88, I_D = 44 * 32, I_IN = 16 * 97, I_OUT = 16 * 32, PER_L = 6 * I_GU + I_IN + I_OUT;
    static_assert(I_GU == I_D, "");
    for (int it = gw; it < 2 * PER_L; it += NGW) {
        const int l = it / PER_L; int r = it % PER_L;
        unsigned char* wb = WSP() + WS_W + (size_t)l * WL;
        const int seg = r < 6 * I_GU ? r / I_GU : (r < 6 * I_GU + I_IN ? 6 : 7);
        if (seg < 6) {
            r -= seg * I_GU;
            const int ffn = seg / 3, kind = seg % 3;
            if (kind < 2) {
                const float* W = INP((ffn ? 16 : 2) + kind) + (size_t)l * DM * DFF; const float* gn = INP(ffn ? 15 : 1) + l * DM;
                const int kb = r / 88, nb = r % 88, n0 = 32 * nb;
                bf16* dst = (bf16*)(wb + (ffn ? OW_GU2 : OW_GU1)) + (size_t)((n0 >> 7) * 256 + kind * 128 + (n0 & 127)) * DM;
                conv_item(W, DM, DFF, kb, n0, dst, gn, scr, lane);
            } else {
                const float* W = INP(ffn ? 18 : 4) + (size_t)l * DM * DFF;
                const int kb = r / 32, nb = r % 32, n0 = 32 * nb;
                bf16* dst = (bf16*)(wb + (ffn ? OW_D2 : OW_D1)) + (size_t)n0 * DFF;
                conv_item(W, DFF, DM, kb, n0, dst, nullptr, scr, lane);
            }
        } else if (seg == 6) {
            r -= 6 * I_GU;
            const float* W = INP(6) + (size_t)l * DM * 3104; const float* gn = INP(5) + l * DM;
            const int kb = r / 97, nb = r % 97, n0 = 32 * nb;
            bf16* wa = (bf16*)(wb + OW_INA); bf16* wv = (bf16*)(wb + OW_INB); bf16* dst;
            if (n0 < 1024) dst = wa + (size_t)n0 * DM;
            else if (n0 < 1536) dst = wv + (size_t)(n0 - 1024) * DM;
            else if (n0 < 2048) dst = wa + (size_t)(n0 - 512) * DM;
            else if (n0 < 2560) dst = wv + (size_t)(n0 - 1536) * DM;
            else if (n0 < 3072) dst = wa + (size_t)(n0 - 1024) * DM;
            else dst = wa + (size_t)2048 * DM;
            conv_item(W, DM, 3104, kb, n0, dst, gn, scr, lane);
        } else {
            r -= 6 * I_GU + I_IN;
            const float* W = INP(14) + (size_t)l * DM * DM;
            const int kb = r / 32, nb = r % 32, n0 = 32 * nb;
            conv_item(W, DM, DM, kb, n0, (bf16*)(wb + OW_OUT) + (size_t)n0 * DM, nullptr, scr, lane);
        }
    }
    const float* x = INP(0); bf16* XB = (bf16*)(WSP() + WS_XB); float* ssq = (float*)(WSP() + WS_SSQ);
    for (int m = gw; m < M; m += NGW) {
        const f32x4* xr = (const f32x4*)(x + (size_t)m * DM) + lane; f32x4 v[4]; float s = 0.f;
#pragma unroll
        for (int j = 0; j < 4; ++j) { v[j] = xr[64 * j]; s += (v[j][0] * v[j][0] + v[j][1] * v[j][1]) + (v[j][2] * v[j][2] + v[j][3] * v[j][3]); }
        s = wave_sum(s);
        u32x2* o = (u32x2*)(XB + (size_t)m * DM) + lane;
#pragma unroll
        for (int j = 0; j < 4; ++j) { u32x2 w; w.x = pk2(v[j][0], v[j][1]); w.y = pk2(v[j][2], v[j][3]); o[64 * j] = w; }
        if (lane < 16) ssq[(size_t)m * 16 + lane] = lane == 0 ? s : 0.f;
    }
}
#define SCHED_FENCE() __builtin_amdgcn_sched_barrier(0)
DI float log_sigmoid_f(float z) { return fminf(z, 0.f) - __logf(1.0f + __expf(-fabsf(z))); }
DI void gla_prep_item(const Args& A, int l, unsigned char* ldsb, int item, int tid, bool stage) {
    float* gl = (float*)ldsb; float* tot = gl + 2 * 64 * 65; float* wg = tot + 512; float* bg = wg + 2048; bf16* T = (bf16*)(bg + 128);
    unsigned char* R = WSP() + WS_R;
    const bf16* CODES = (const bf16*)(R + R_CODES); const bf16* GQK = (const bf16*)(R + R_GQK);
    bf16* GP = (bf16*)(R + R_GP); bf16* KT = (bf16*)(R + R_KT); float* DEC = (float*)(R + R_DEC);
    const int c = item & 63, bh = item >> 6, h = bh & 3, b = bh >> 2;
    const size_t tok0 = (size_t)b * SEQ + c * 64;
    const int t = tid >> 3, dg = tid & 7;
    const u32x4* cp = (const u32x4*)(CODES + (tok0 + t) * 32);
    const u32x4 cq0 = cp[0], cq1 = cp[1], cq2 = cp[2], cq3 = cp[3];
    const u32x4 qv = *(const u32x4*)(GQK + (tok0 + t) * 512 + h * 64 + 8 * dg), kv = *(const u32x4*)(GQK + (tok0 + t) * 512 + 256 + h * 64 + 8 * dg);
    if (stage) {
        const int idx = tid * 4, dir = idx >> 10, r = (idx >> 6) & 15, d = idx & 63;
        const float* w = (dir ? INP(11) : INP(9)) + (size_t)l * 16 * 256 + r * 256 + h * 64 + d;
        *(f32x4*)(wg + idx) = *(const f32x4*)w;
        if (tid < 128) { const int dr = tid >> 6, dd = tid & 63; bg[tid] = (dr ? INP(12) : INP(10))[l * 256 + h * 64 + dd]; }
        __syncthreads();
    }
    {
        float cf[32];
#pragma unroll
        for (int j = 0; j < 4; ++j) { const u32x4 v = j == 0 ? cq0 : (j == 1 ? cq1 : (j == 2 ? cq2 : cq3)); cf[8 * j + 0] = bflo(v.x); cf[8 * j + 1] = bfhi(v.x); cf[8 * j + 2] = bflo(v.y); cf[8 * j + 3] = bfhi(v.y); cf[8 * j + 4] = bflo(v.z); cf[8 * j + 5] = bfhi(v.z); cf[8 * j + 6] = bflo(v.w); cf[8 * j + 7] = bfhi(v.w); }
#pragma unroll
        for (int dir = 0; dir < 2; ++dir) {
            float z[8];
#pragma unroll
            for (int dd = 0; dd < 8; ++dd) z[dd] = bg[dir * 64 + 8 * dg + dd];
#pragma unroll
            for (int r = 0; r < 16; ++r) {
                const f32x4 w0 = *(const f32x4*)(wg + dir * 1024 + r * 64 + 8 * dg), w1 = *(const f32x4*)(wg + dir * 1024 + r * 64 + 8 * dg + 4);
                const float cv = cf[dir * 16 + r];
                z[0] += cv * w0[0]; z[1] += cv * w0[1]; z[2] += cv * w0[2]; z[3] += cv * w0[3]; z[4] += cv * w1[0]; z[5] += cv * w1[1]; z[6] += cv * w1[2]; z[7] += cv * w1[3];
            }
#pragma unroll
            for (int dd = 0; dd < 8; ++dd) gl[(dir * 64 + t) * 65 + 8 * dg + dd] = log_sigmoid_f(z[dd]) * (1.0f / 16.0f);
        }
    }
    __syncthreads();
    {
        const int dir = tid >> 8, seg = (tid >> 6) & 3, d = tid & 63;
        float* gp = gl + (dir * 64 + 16 * seg) * 65 + d; float v[16];
#pragma unroll
        for (int tt = 0; tt < 16; ++tt) v[tt] = gp[tt * 65];
        if (dir == 0) {
#pragma unroll
            for (int tt = 1; tt < 16; ++tt) v[tt] += v[tt - 1];
        } else {
#pragma unroll
            for (int tt = 14; tt >= 0; --tt) v[tt] += v[tt + 1];
        }
        tot[(dir * 4 + seg) * 64 + d] = dir == 0 ? v[15] : v[0];
        __syncthreads();
        float off = 0.f;
        if (dir == 0) { for (int s2 = 0; s2 < 4; ++s2) if (s2 < seg) off += tot[s2 * 64 + d]; }
        else { for (int s2 = 0; s2 < 4; ++s2) if (s2 > seg) off += tot[(4 + s2) * 64 + d]; }
#pragma unroll
        for (int tt = 0; tt < 16; ++tt) gp[tt * 65] = v[tt] + off;
    }
    __syncthreads();
    {
        float q[8], k[8];
        q[0] = bflo(qv.x); q[1] = bfhi(qv.x); q[2] = bflo(qv.y); q[3] = bfhi(qv.y); q[4] = bflo(qv.z); q[5] = bfhi(qv.z); q[6] = bflo(qv.w); q[7] = bfhi(qv.w);
        k[0] = bflo(kv.x); k[1] = bfhi(kv.x); k[2] = bflo(kv.y); k[3] = bfhi(kv.y); k[4] = bflo(kv.z); k[5] = bfhi(kv.z); k[6] = bflo(kv.w); k[7] = bfhi(kv.w);
        float qf[8], kf[8], qb[8], kb[8];
#pragma unroll
        for (int dd = 0; dd < 8; ++dd) {
            const int d = 8 * dg + dd;
            const float bf = gl[t * 65 + d], bb = gl[(64 + t) * 65 + d], bfl = gl[63 * 65 + d], bb0 = gl[64 * 65 + d];
            qf[dd] = q[dd] * 0.125f * __expf(bf); kf[dd] = k[dd] * __expf(-bf);
            qb[dd] = q[dd] * 0.125f * __expf(bb); kb[dd] = k[dd] * __expf(-bb);
            T[d * 72 + t] = (bf16)(pk2(k[dd] * __expf(bfl - bf), 0.f) & 0xffffu);
            T[(64 + d) * 72 + t] = (bf16)(pk2(k[dd] * __expf(bb0 - bb), 0.f) & 0xffffu);
        }
        const size_t go = (tok0 + t) * 256 + h * 64 + 8 * dg; const size_t AS = (size_t)M * 256;
        u32x4 w;
        w.x = pk2(qf[0], qf[1]); w.y = pk2(qf[2], qf[3]); w.z = pk2(qf[4], qf[5]); w.w = pk2(qf[6], qf[7]); *(u32x4*)(GP + go) = w;
        w.x = pk2(kf[0], kf[1]); w.y = pk2(kf[2], kf[3]); w.z = pk2(kf[4], kf[5]); w.w = pk2(kf[6], kf[7]); *(u32x4*)(GP + AS + go) = w;
        w.x = pk2(qb[0], qb[1]); w.y = pk2(qb[2], qb[3]); w.z = pk2(qb[4], qb[5]); w.w = pk2(qb[6], qb[7]); *(u32x4*)(GP + 2 * AS + go) = w;
        w.x = pk2(kb[0], kb[1]); w.y = pk2(kb[2], kb[3]); w.z = pk2(kb[4], kb[5]); w.w = pk2(kb[6], kb[7]); *(u32x4*)(GP + 3 * AS + go) = w;
        if (tid < 128) { const int dir = tid >> 6, d = tid & 63; DEC[((size_t)(dir * 32 + bh) * 64 + c) * 64 + d] = __expf(dir ? gl[64 * 65 + d] : gl[63 * 65 + d]); }
    }
    __syncthreads();
#pragma unroll
    for (int i = 0; i < 2; ++i) {
        const int u = tid + 512 * i, dir = u >> 9, d = (u >> 3) & 63, j = u & 7;
        *(u32x4*)(KT + ((size_t)((tok0 >> 3) + j) * 512 + dir * 256 + h * 64 + d) * 8) = *(const u32x4*)(T + (dir * 64 + d) * 72 + 8 * j);
    }
    __syncthreads();
}

DI void gla_scan_item(const Args& A, int item, int wave, int lane) {
    unsigned char* R = WSP() + WS_R;
    const bf16* VT = (const bf16*)(R + R_VT); const bf16* KT = (const bf16*)(R + R_KT); const float* DEC = (const float*)(R + R_DEC); bf16* SBEF = (bf16*)(R + R_SBEF);
    const int es = item & 3, chain = item >> 2, dir = chain >> 5, bh = chain & 31, h = bh & 3, b = bh >> 2;
    const int c = lane & 15, g = lane >> 4, ebl = wave >> 2, db = wave & 3, e0 = 32 * es + 16 * ebl;
    const bf16* kp = KT + ((size_t)(b * 512 + g) * 512 + dir * 256 + h * 64 + 16 * db + c) * 8;
    const bf16* vp = VT + ((size_t)(b * 512 + g) * 1024 + 512 + h * 128 + e0 + c) * 8;
    const float* dp = DEC + (size_t)chain * 64 * 64 + 16 * db + 4 * g;
    bf16* sp = SBEF + ((size_t)chain * 64 * 128 + e0 + c) * 64 + 16 * db + 4 * g;
    f32x4 S = {0.f, 0.f, 0.f, 0.f};
#define SC_CH(n) (dir ? 63 - (n) : (n))
#define SC_LOAD(k, n) do { const int c_ = SC_CH((n) < 63 ? (n) : 63); a0##k = ld16(kp + (size_t)c_ * 32768); a1##k = ld16(kp + (size_t)c_ * 32768 + 16384); b0##k = ld16(vp + (size_t)c_ * 65536); b1##k = ld16(vp + (size_t)c_ * 65536 + 32768); dc##k = *(const f32x4*)(dp + c_ * 64); } while (0)
#define SC_STEP(k, n) do { u32x2 w_; w_.x = pk2(S[0], S[1]); w_.y = pk2(S[2], S[3]); *(u32x2*)(sp + (size_t)SC_CH(n) * 128 * 64) = w_; S = S * dc##k; S = mfma16(a0##k, b0##k, S); S = mfma16(a1##k, b1##k, S); } while (0)
    bf16x8 a00, a10, b00, b10, a01, a11, b01, b11, a02, a12, b02, b12, a03, a13, b03, b13; f32x4 dc0, dc1, dc2, dc3;
    SC_LOAD(0, 0); SC_LOAD(1, 1); SC_LOAD(2, 2); SC_LOAD(3, 3);
#pragma unroll 1
    for (int n = 0; n < 64; n += 4) {
        SC_STEP(0, n); SC_LOAD(0, n + 4);
        SC_STEP(1, n + 1); SC_LOAD(1, n + 5);
        SC_STEP(2, n + 2); SC_LOAD(2, n + 6);
        SC_STEP(3, n + 3); SC_LOAD(3, n + 7);
    }
#undef SC_CH
#undef SC_LOAD
#undef SC_STEP
}

DI void gla_out_item(const Args& A, int l, int item, int tb, int lane) {
    unsigned char* R = WSP() + WS_R;
    const bf16* VT = (const bf16*)(R + R_VT); const bf16* GP = (const bf16*)(R + R_GP); const bf16* SBEF = (const bf16*)(R + R_SBEF); const bf16* GR = (const bf16*)(R + R_GR); bf16* MIX = (bf16*)(R + R_MIX);
    const size_t AS = (size_t)M * 256;
    const int ck = item & 63, bh = item >> 6, h = bh & 3, b = bh >> 2, c = lane & 15, g = lane >> 4;
    const size_t tok0 = (size_t)b * SEQ + ck * 64;
    const size_t qo = (tok0 + 16 * tb + c) * 256 + h * 64 + 8 * g;
    const bf16x8 qf0 = ld16(GP + qo), qf1 = ld16(GP + qo + 32), qb0 = ld16(GP + 2 * AS + qo), qb1 = ld16(GP + 2 * AS + qo + 32);
    bf16x8 kfr[8], kbr[8];
#pragma unroll
    for (int i = 0; i < 8; ++i) {
        const size_t ko = (tok0 + 16 * (i >> 1) + c) * 256 + h * 64 + 8 * g + 32 * (i & 1);
        kfr[i] = ld16(GP + AS + ko); kbr[i] = ld16(GP + 3 * AS + ko);
    }
    const bf16* sf = SBEF + ((size_t)(bh * 64 + ck) * 128 + c) * 64 + 8 * g;
    const bf16* sbk = SBEF + ((size_t)((32 + bh) * 64 + ck) * 128 + c) * 64 + 8 * g;
    const bf16* vt = VT + ((size_t)((tok0 >> 3) + (g >> 1)) * 1024 + 512 + h * 128 + c) * 8 + 4 * (g & 1);
    u32x2 vv[2][8]; bf16x8 sv[2][8];
#define GO_LOAD(buf, eb0) do { _Pragma("unroll") for (int e_ = 0; e_ < 2; ++e_) { const bf16* v_ = vt + 128 * ((eb0) + e_); \
        vv[buf][4 * e_ + 0] = *(const u32x2*)(v_); vv[buf][4 * e_ + 1] = *(const u32x2*)(v_ + 16384); vv[buf][4 * e_ + 2] = *(const u32x2*)(v_ + 32768); vv[buf][4 * e_ + 3] = *(const u32x2*)(v_ + 49152); \
        sv[buf][4 * e_ + 0] = ld16(sf + ((eb0) + e_) * 1024); sv[buf][4 * e_ + 1] = ld16(sf + ((eb0) + e_) * 1024 + 32); sv[buf][4 * e_ + 2] = ld16(sbk + ((eb0) + e_) * 1024); sv[buf][4 * e_ + 3] = ld16(sbk + ((eb0) + e_) * 1024 + 32); } } while (0)
    GO_LOAD(0, 0);
    SCHED_FENCE();
    f32x4 at[4];
#pragma unroll
    for (int sb = 0; sb < 4; ++sb) {
        f32x4 f = {0.f, 0.f, 0.f, 0.f}, bk = {0.f, 0.f, 0.f, 0.f};
        f = mfma16(kfr[2 * sb], qf0, f); f = mfma16(kfr[2 * sb + 1], qf1, f);
        bk = mfma16(kbr[2 * sb], qb0, bk); bk = mfma16(kbr[2 * sb + 1], qb1, bk);
#pragma unroll
        for (int i = 0; i < 4; ++i) at[sb][i] = (16 * sb + 4 * g + i <= 16 * tb + c) ? f[i] : bk[i];
    }
    const bf16x8 p0 = pack8(at[0], at[1]), p1 = pack8(at[2], at[3]);
    SCHED_FENCE();
    f32x4 o[8]; float ss = 0.f;
#pragma unroll
    for (int bp = 0; bp < 4; ++bp) {
        if (bp < 3) GO_LOAD((bp + 1) & 1, 2 * bp + 2);
        SCHED_FENCE();
#pragma unroll
        for (int e = 0; e < 2; ++e) {
            f32x4 acc = {0.f, 0.f, 0.f, 0.f};
            const u32x2 v0 = vv[bp & 1][4 * e], v1 = vv[bp & 1][4 * e + 1], v2 = vv[bp & 1][4 * e + 2], v3 = vv[bp & 1][4 * e + 3];
            u32x4 a0; a0.x = v0.x; a0.y = v0.y; a0.z = v1.x; a0.w = v1.y; u32x4 a1; a1.x = v2.x; a1.y = v2.y; a1.z = v3.x; a1.w = v3.y;
            acc = mfma16(__builtin_bit_cast(bf16x8, a0), p0, acc); acc = mfma16(__builtin_bit_cast(bf16x8, a1), p1, acc);
            acc = mfma16(sv[bp & 1][4 * e], qf0, acc); acc = mfma16(sv[bp & 1][4 * e + 1], qf1, acc);
            acc = mfma16(sv[bp & 1][4 * e + 2], qb0, acc); acc = mfma16(sv[bp & 1][4 * e + 3], qb1, acc);
            o[2 * bp + e] = acc; ss += (acc[0] * acc[0] + acc[1] * acc[1]) + (acc[2] * acc[2] + acc[3] * acc[3]);
        }
        SCHED_FENCE();
    }
#undef GO_LOAD
    ss += __shfl_xor(ss, 16); ss += __shfl_xor(ss, 32);
    const float rstd = rsqrtf(ss * (1.0f / 128.0f) + EPS);
    const float* gain = INP(13) + l * 128 + 4 * g;
    const size_t tok = tok0 + 16 * tb + c;
#pragma unroll
    for (int eb = 0; eb < 8; ++eb) {
        const f32x4 gn = *(const f32x4*)(gain + 16 * eb);
        const u32x2 gr = *(const u32x2*)(GR + tok * 512 + h * 128 + 16 * eb + 4 * g);
        const float r0 = bflo(gr.x), r1 = bfhi(gr.x), r2 = bflo(gr.y), r3 = bfhi(gr.y);
        u32x2 w; w.x = pk2(o[eb][0] * rstd * gn[0] * silu_f(r0), o[eb][1] * rstd * gn[1] * silu_f(r1)); w.y = pk2(o[eb][2] * rstd * gn[2] * silu_f(r2), o[eb][3] * rstd * gn[3] * silu_f(r3));
        *(u32x2*)(MIX + tok * 1024 + 512 + h * 128 + 16 * eb + 4 * g) = w;
    }
}

DI void na_stage_rpb(int l, float* rpbs, int tid) {
    const float* rpb = INP(7) + (size_t)l * 8 * 465;
    for (int i = tid; i < 8 * 465; i += NWAVES * 64) rpbs[i] = rpb[i];
    __syncthreads();
}
DI void na_item(const Args& A, int l, float* nss, const float* rpbs, int item, int h, int lane) {
    unsigned char* R = WSP() + WS_R;
    const bf16* QK = (const bf16*)(R + R_QKNA); const bf16* VT = (const bf16*)(R + R_VT); bf16* MIX = (bf16*)(R + R_MIX);
    const float* rpb = rpbs + h * 465;
    const int c = lane & 15, g = lane >> 4;
    const int j = item & 3, r = (item >> 2) & 63, b = item >> 8;
    const int rs = min(max(r - 4, 0), 56), c0 = min(max(16 * j - 8, 0), 32);
    const size_t tokq = (size_t)b * SEQ + r * 64 + 16 * j + c;
    const bf16x8 q0 = ld16(QK + tokq * 1024 + h * 64 + 8 * g), q1 = ld16(QK + tokq * 1024 + h * 64 + 32 + 8 * g);
    const bf16* kbase = QK + ((size_t)b * SEQ + rs * 64 + c0 + c) * 1024 + 512 + h * 64 + 8 * g;
    const bf16* vbase = VT + ((size_t)((b * SEQ + rs * 64 + c0 + 4 * g) >> 3) * 1024 + h * 64 + c) * 8 + 4 * (g & 1);
    f32x4 st[8][2];
    bf16x8 kf[2][16];
#pragma unroll
    for (int bb = 0; bb < 2; ++bb)
#pragma unroll
        for (int i = 0; i < 16; ++i) kf[bb][i] = ld16(kbase + (size_t)(4 * bb + (i >> 2)) * 65536 + ((i >> 1) & 1) * 16384 + (i & 1) * 32);
    SCHED_FENCE();
    u32x2 vf[2][16];
#pragma unroll
    for (int bb = 0; bb < 2; ++bb) {
#pragma unroll
        for (int t = 0; t < 8; ++t) {
            f32x4 s = {0.f, 0.f, 0.f, 0.f}; s = mfma16(kf[bb][2 * t], q0, s); s = mfma16(kf[bb][2 * t + 1], q1, s); st[4 * bb + (t >> 1)][t & 1] = s;
        }
        SCHED_FENCE();
        if (bb == 0) {
#pragma unroll
            for (int i = 0; i < 16; ++i) vf[0][i] = *(const u32x2*)(vbase + (size_t)(i >> 3) * 65536 + 128 * ((i >> 1) & 3) + (i & 1) * 16384);
            SCHED_FENCE();
        }
    }
    const int qc = 16 * j + c, cs = min(max(qc - 8, 0), 48);
    float mx = -3.0e38f;
#pragma unroll
    for (int w = 0; w < 8; ++w) {
        const float* rp = rpb + (rs + w - r + 7) * 31;
#pragma unroll
        for (int hf = 0; hf < 2; ++hf)
#pragma unroll
            for (int i = 0; i < 4; ++i) {
                const int kc = c0 + 16 * hf + 4 * g + i; const bool valid = (kc >= cs) && (kc < cs + 16);
                const int dc = min(max(kc - qc + 15, 0), 30);
                const float bv = rp[dc];
                const float s = valid ? st[w][hf][i] * 0.125f + bv : -1.0e30f;
                st[w][hf][i] = s; mx = fmaxf(mx, s);
            }
    }
    mx = fmaxf(mx, __shfl_xor(mx, 16)); mx = fmaxf(mx, __shfl_xor(mx, 32));
    float sum = 0.f;
#pragma unroll
    for (int w = 0; w < 8; ++w)
#pragma unroll
        for (int hf = 0; hf < 2; ++hf)
#pragma unroll
            for (int i = 0; i < 4; ++i) { const float p = __expf(st[w][hf][i] - mx); st[w][hf][i] = p; sum += p; }
    sum += __shfl_xor(sum, 16); sum += __shfl_xor(sum, 32);
    f32x4 o[4];
#pragma unroll
    for (int db = 0; db < 4; ++db) o[db] = (f32x4){0.f, 0.f, 0.f, 0.f};
#pragma unroll
    for (int wp = 0; wp < 4; ++wp) {
        if (wp < 3) {
#pragma unroll
            for (int i = 0; i < 16; ++i) vf[(wp + 1) & 1][i] = *(const u32x2*)(vbase + (size_t)(2 * wp + 2 + (i >> 3)) * 65536 + 128 * ((i >> 1) & 3) + (i & 1) * 16384);
        }
        SCHED_FENCE();
#pragma unroll
        for (int ww = 0; ww < 2; ++ww) {
            const bf16x8 p = pack8(st[2 * wp + ww][0], st[2 * wp + ww][1]);
#pragma unroll
            for (int db = 0; db < 4; ++db) {
                const u32x2 lo = vf[wp & 1][8 * ww + 2 * db], hi = vf[wp & 1][8 * ww + 2 * db + 1];
                u32x4 v; v.x = lo.x; v.y = lo.y; v.z = hi.x; v.w = hi.y;
                o[db] = mfma16(__builtin_bit_cast(bf16x8, v), p, o[db]);
            }
        }
        SCHED_FENCE();
    }
    const float inv = 1.0f / sum; float ss = 0.f;
#pragma unroll
    for (int db = 0; db < 4; ++db) { o[db] = o[db] * inv; ss += (o[db][0] * o[db][0] + o[db][1] * o[db][1]) + (o[db][2] * o[db][2] + o[db][3] * o[db][3]); }
    ss += __shfl_xor(ss, 16); ss += __shfl_xor(ss, 32);
    if (g == 0) nss[h * 16 + c] = ss;
    __syncthreads();
    float tot = 0.f;
#pragma unroll
    for (int hh = 0; hh < 8; ++hh) tot += nss[hh * 16 + c];
    const float rstd = rsqrtf(tot * (1.0f / 512.0f) + EPS);
    const float* gain = INP(8) + l * 512 + h * 64 + 4 * g;
#pragma unroll
    for (int db = 0; db < 4; ++db) {
        const f32x4 gn = *(const f32x4*)(gain + 16 * db);
        u32x2 w; w.x = pk2(o[db][0] * rstd * gn[0], o[db][1] * rstd * gn[1]); w.y = pk2(o[db][2] * rstd * gn[2], o[db][3] * rstd * gn[3]);
        *(u32x2*)(MIX + tokq * 1024 + h * 64 + 16 * db + 4 * g) = w;
    }
    __syncthreads();
}

struct NaKV { bf16x8 k[4]; u32x2 v[8]; };
DI NaKV na_load_kv(const bf16* kbase, const bf16* vbase, int krel) {
    NaKV f;
#pragma unroll
    for (int i = 0; i < 4; ++i) f.k[i] = ld16(kbase + (size_t)krel * 65536 + (i >> 1) * 16384 + (i & 1) * 32);
#pragma unroll
    for (int i = 0; i < 8; ++i) f.v[i] = *(const u32x2*)(vbase + (size_t)krel * 65536 + 128 * (i >> 1) + (i & 1) * 16384);
    return f;
}
DI void na_pair(const NaKV& f, bf16x8 q0, bf16x8 q1, const float* rp  , const int (&dcv)[8], unsigned vmask, float& m, float& l, f32x4 (&o)[4]) {
    f32x4 s0 = {0.f, 0.f, 0.f, 0.f}, s1 = {0.f, 0.f, 0.f, 0.f};
    s0 = mfma16(f.k[0], q0, s0); s0 = mfma16(f.k[1], q1, s0);
    s1 = mfma16(f.k[2], q0, s1); s1 = mfma16(f.k[3], q1, s1);
    float sv[8]; float mx = -1.0e30f;
#pragma unroll
    for (int e = 0; e < 8; ++e) {
        const float raw = e < 4 ? s0[e] : s1[e - 4];
        const float bv = rp[dcv[e]];
        sv[e] = ((vmask >> e) & 1u) ? raw * 0.125f + bv : -1.0e30f;
        mx = fmaxf(mx, sv[e]);
    }
    mx = fmaxf(mx, __shfl_xor(mx, 16)); mx = fmaxf(mx, __shfl_xor(mx, 32));
    const float mn = fmaxf(m, mx), alpha = __expf(m - mn); m = mn;
    float ps = 0.f; f32x4 p0, p1;
#pragma unroll
    for (int e = 0; e < 4; ++e) { p0[e] = __expf(sv[e] - mn); p1[e] = __expf(sv[4 + e] - mn); ps += p0[e] + p1[e]; }
    l = l * alpha + ps;
    const bf16x8 p = pack8(p0, p1);
#pragma unroll
    for (int db = 0; db < 4; ++db) {
        u32x4 v; v.x = f.v[2 * db].x; v.y = f.v[2 * db].y; v.z = f.v[2 * db + 1].x; v.w = f.v[2 * db + 1].y;
        o[db] = mfma16(__builtin_bit_cast(bf16x8, v), p, o[db] * alpha);
    }
}
DI void na_strip(const Args& A, int l, float* nss, const float* rpbs, int item, int h, int lane) {
    unsigned char* R = WSP() + WS_R;
    const bf16* QK = (const bf16*)(R + R_QKNA); const bf16* VT = (const bf16*)(R + R_VT); bf16* MIX = (bf16*)(R + R_MIX);
    const float* rpb = rpbs + h * 465;
    const int c = lane & 15, g = lane >> 4;
    const int j = item & 3, r0 = ((item >> 2) & 15) * 4, b = item >> 6;
    const int c0 = min(max(16 * j - 8, 0), 32);
    const int kmin = min(max(r0 - 4, 0), 56), kmax = min(max(r0 + 3 - 4, 0), 56) + 7, nrows = kmax - kmin + 1;
    const int qc = 16 * j + c, cs = min(max(qc - 8, 0), 48);
    int dcv[8]; unsigned vmask = 0u;
#pragma unroll
    for (int e = 0; e < 8; ++e) { const int kc = c0 + 16 * (e >> 2) + 4 * g + (e & 3); if (kc >= cs && kc < cs + 16) vmask |= 1u << e; dcv[e] = min(max(kc - qc + 15, 0), 30); }
    bf16x8 q0[4], q1[4];
#pragma unroll
    for (int i = 0; i < 4; ++i) { const bf16* qp = QK + ((size_t)b * SEQ + (r0 + i) * 64 + 16 * j + c) * 1024 + h * 64 + 8 * g; q0[i] = ld16(qp); q1[i] = ld16(qp + 32); }
    const bf16* kbase = QK + ((size_t)b * SEQ + kmin * 64 + c0 + c) * 1024 + 512 + h * 64 + 8 * g;
    const bf16* vbase = VT + ((size_t)((b * SEQ + kmin * 64 + c0 + 4 * g) >> 3) * 1024 + h * 64 + c) * 8 + 4 * (g & 1);
    float m[4], ls[4]; f32x4 o[4][4];
#pragma unroll
    for (int i = 0; i < 4; ++i) { m[i] = -1.0e30f; ls[i] = 0.f;
#pragma unroll
        for (int db = 0; db < 4; ++db) o[i][db] = (f32x4){0.f, 0.f, 0.f, 0.f}; }
    int rs[4];
#pragma unroll
    for (int i = 0; i < 4; ++i) rs[i] = min(max(r0 + i - 4, 0), 56);
#define NA_ROW(F, KR) do { _Pragma("unroll") for (int i_ = 0; i_ < 4; ++i_) { if ((KR) >= rs[i_] && (KR) <= rs[i_] + 7) na_pair(F, q0[i_], q1[i_], rpb + ((KR) - (r0 + i_) + 7) * 31, dcv, vmask, m[i_], ls[i_], o[i_]); } } while (0)
    NaKV fa = na_load_kv(kbase, vbase, 0), fb;
#pragma unroll 1
    for (int t = 0; t < nrows; t += 2) {
        fb = na_load_kv(kbase, vbase, min(t + 1, nrows - 1));
        SCHED_FENCE();
        NA_ROW(fa, kmin + t);
        SCHED_FENCE();
        fa = na_load_kv(kbase, vbase, min(t + 2, nrows - 1));
        SCHED_FENCE();
        if (t + 1 < nrows) NA_ROW(fb, kmin + t + 1);
        SCHED_FENCE();
    }
#undef NA_ROW
    float ssv[4];
#pragma unroll
    for (int i = 0; i < 4; ++i) {
        float lt = ls[i]; lt += __shfl_xor(lt, 16); lt += __shfl_xor(lt, 32);
        const float inv = 1.0f / lt; float ss = 0.f;
#pragma unroll
        for (int db = 0; db < 4; ++db) { o[i][db] = o[i][db] * inv; ss += (o[i][db][0] * o[i][db][0] + o[i][db][1] * o[i][db][1]) + (o[i][db][2] * o[i][db][2] + o[i][db][3] * o[i][db][3]); }
        ss += __shfl_xor(ss, 16); ss += __shfl_xor(ss, 32);
        ssv[i] = ss;
        if (g == 0) nss[(i * 8 + h) * 16 + c] = ss;
    }
    __syncthreads();
    const float* gain = INP(8) + l * 512 + h * 64 + 4 * g;
#pragma unroll
    for (int i = 0; i < 4; ++i) {
        float tot = 0.f;
#pragma unroll
        for (int hh = 0; hh < 8; ++hh) tot += nss[(i * 8 + hh) * 16 + c];
        const float rstd = rsqrtf(tot * (1.0f / 512.0f) + EPS);
        const size_t tokq = (size_t)b * SEQ + (r0 + i) * 64 + 16 * j + c;
#pragma unroll
        for (int db = 0; db < 4; ++db) {
            const f32x4 gn = *(const f32x4*)(gain + 16 * db);
            u32x2 w; w.x = pk2(o[i][db][0] * rstd * gn[0], o[i][db][1] * rstd * gn[1]); w.y = pk2(o[i][db][2] * rstd * gn[2], o[i][db][3] * rstd * gn[3]);
            *(u32x2*)(MIX + tokq * 1024 + h * 64 + 16 * db + 4 * g) = w;
        }
    }
    (void)ssv;
    __syncthreads();
}

#define XB_TMO      128
#define XB_XCNT(j)  (256  + 64 * (j))
#define XB_XSUB(j)  (1280 + 64 * (j))
#define XB_XGEN(j)  (2304 + 64 * (j))
#define XB_TOP      3328
#define XB_TOPGEN   3392
#define XCD_BAR_WORDS 3456
#define XB_SPIN_CAP (1u << 18)

__device__ __forceinline__ unsigned xb_ld(unsigned* p)              { return __hip_atomic_load(p, __ATOMIC_RELAXED, __HIP_MEMORY_SCOPE_AGENT); }
__device__ __forceinline__ unsigned xb_add(unsigned* p, unsigned v) { return __hip_atomic_fetch_add(p, v, __ATOMIC_RELAXED, __HIP_MEMORY_SCOPE_AGENT); }
__device__ __forceinline__ unsigned xb_xcc_id() { return (unsigned)__builtin_amdgcn_s_getreg((3 << 11) | 20) & 0xFu; }
#define XB_SPIN(cond, bar) do { unsigned _sp = 0; while (cond) { __builtin_amdgcn_s_sleep(1); \
    if ((++_sp & 255u) == 0u) { if (xb_ld(&(bar)[XB_TMO])) break; if (_sp > XB_SPIN_CAP) { atomicAdd(&(bar)[XB_TMO], 1u); break; } } } } while (0)

struct XcdBarrier {
    unsigned* bar; unsigned x;
    volatile LAS unsigned* st;
};

__device__ __forceinline__ XcdBarrier xcd_barrier_post(unsigned* bar, volatile LAS unsigned* st) {
    XcdBarrier b; b.bar = bar; b.x = xb_xcc_id(); b.st = st;
    if (threadIdx.x == 0) (void)xb_add(&bar[XB_XCNT(b.x)], 1u);
    return b;
}
__device__ __forceinline__ void xcd_barrier_complete(unsigned* bar, unsigned x, unsigned& nloc, unsigned& nx) {
    const unsigned G = gridDim.x * gridDim.y * gridDim.z;
    unsigned sum, cnt, mine, sp = 0u;
    for (;;) {
        sum = 0u; cnt = 0u; mine = 0u;
#pragma unroll
        for (unsigned j = 0; j < 16; ++j) { const unsigned c = xb_ld(&bar[XB_XCNT(j)]); sum += c; cnt += (c > 0u) ? 1u : 0u; mine = (j == x) ? c : mine; }
        if (sum == G) break;
        __builtin_amdgcn_s_sleep(1);
        if ((++sp & 255u) == 0u) { if (xb_ld(&bar[XB_TMO])) break; if (sp > XB_SPIN_CAP) { atomicAdd(&bar[XB_TMO], 1u); break; } }
    }
    nloc = mine > 0u ? mine : 1u; nx = cnt > 0u ? cnt : 1u;
}

__device__ __forceinline__ void xcd_barrier(const XcdBarrier& b) {
    asm volatile("s_waitcnt vmcnt(0)" ::: "memory");
    __syncthreads();
    if (threadIdx.x == 0) {
        unsigned* bar = b.bar;
        __builtin_amdgcn_s_waitcnt(0);
        unsigned nloc = b.st[0], nx = b.st[1];
        if (nloc == 0u) { xcd_barrier_complete(bar, b.x, nloc, nx); b.st[0] = nloc; b.st[1] = nx; }
        const unsigned old = xb_add(&bar[XB_XSUB(b.x)], 1u);
        const unsigned gen = old / nloc;
        if (old + 1u == (gen + 1u) * nloc) {
            __builtin_amdgcn_fence(__ATOMIC_RELEASE, "agent");
            asm volatile("s_waitcnt vmcnt(0)" ::: "memory");
            const unsigned og = xb_add(&bar[XB_TOP], 1u);
            const unsigned tg = og / nx;
            if (og + 1u == (tg + 1u) * nx) xb_add(&bar[XB_TOPGEN], 1u);
            else XB_SPIN(xb_ld(&bar[XB_TOPGEN]) == tg, bar);
            __builtin_amdgcn_fence(__ATOMIC_ACQUIRE, "agent");
            xb_add(&bar[XB_XGEN(b.x)], 1u);
            asm volatile("s_waitcnt vmcnt(0)" ::: "memory");
        } else {
            XB_SPIN(xb_ld(&bar[XB_XGEN(b.x)]) == gen, bar);
            __builtin_amdgcn_fence(__ATOMIC_ACQUIRE, "agent");
            asm volatile("s_waitcnt vmcnt(0)" ::: "memory");
        }
    }
    __syncthreads();
}

#define XL_SUB(j) (3456 + 64 * (j))
#define XL_GEN(j) (4480 + 64 * (j))
__device__ __forceinline__ void xcd_local_barrier(unsigned* bar, unsigned x, unsigned nloc) {
    asm volatile("s_waitcnt vmcnt(0)" ::: "memory");
    __syncthreads();
    if (threadIdx.x == 0) {
        const unsigned old = xb_add(&bar[XL_SUB(x)], 1u); const unsigned gen = old / nloc;
        if (old + 1u == (gen + 1u) * nloc) xb_add(&bar[XL_GEN(x)], 1u);
        else XB_SPIN(xb_ld(&bar[XL_GEN(x)]) == gen, bar);
        __builtin_amdgcn_fence(__ATOMIC_ACQUIRE, "agent");
        asm volatile("s_waitcnt vmcnt(0)" ::: "memory");
    }
    __syncthreads();
}
#ifndef REP_PRO
#define REP_PRO 1
#define REP_SYNC 1
#define REP_GEMM 1
#define REP_PREP 1
#define REP_SCAN 1
#define REP_OUT 1
#define REP_NA 1
#endif
#define LAUNDER_TID int t_ = threadIdx.x; asm volatile("" : "+v"(t_)); const int tid = t_, lane = t_ & 63, wave = __builtin_amdgcn_readfirstlane(t_ >> 6); (void)tid; (void)lane; (void)wave;
#define GSYNC() do { for (int r_ = 0; r_ < REP_SYNC; ++r_) xcd_barrier(xbar); } while (0)
#define LSYNC() do { for (int r_ = 0; r_ < REP_SYNC; ++r_) { if (xl) xcd_local_barrier(xbar.bar, xbar.x, (unsigned)(G >> 3)); else xcd_barrier(xbar); } } while (0)
__global__ void __launch_bounds__(NWAVES * 64, 2) fwd_megakernel(Args A) {
    extern __shared__ __attribute__((aligned(16))) unsigned char lds[];
    cg::grid_group grid = cg::this_grid();
    const int G = gridDim.x, bx = blockIdx.x;
    LAS unsigned char* ldsg = (LAS unsigned char*)lds;
    unsigned char* ws = WSP(); unsigned char* R = ws + WS_R;
    bf16* XB = (bf16*)(ws + WS_XB); float* SSQ = (float*)(ws + WS_SSQ); float* X = OUTP();
    bf16* H = (bf16*)(R + R_H); bf16* MIX = (bf16*)(R + R_MIX);

    if (threadIdx.x < 16) ((volatile LAS unsigned*)(ldsg + 131072 + 64))[threadIdx.x] = 0u;
    __syncthreads();
    volatile LAS unsigned* ldsw = (volatile LAS unsigned*)(ldsg + 131072 + 64);
    XcdBarrier xbar; xbar.bar = (unsigned*)ws; xbar.x = xb_xcc_id(); xbar.st = ldsw;
    if (threadIdx.x == 0) ldsw[4] = xb_add(&xbar.bar[XB_XCNT(xbar.x)], 1u);
    for (int rep = 0; rep < REP_PRO; ++rep) { LAUNDER_TID prologue(A, lds, wave, lane); }
    if (G > (1 << 20)) grid.sync();
    xcd_barrier(xbar);
    if (threadIdx.x == 0) {
        bool ok = (G % 8 == 0);
        for (unsigned j = 0; j < 16; ++j) { const unsigned cn = xb_ld(&xbar.bar[XB_XCNT(j)]); ok = ok && (cn == (j < 8 ? (unsigned)(G / 8) : 0u)); }
        ldsw[5] = ok ? (xbar.x + 8u * ldsw[4]) : (unsigned)bx; ldsw[6] = ok ? 1u : 0u;
    }
    __syncthreads();
    const int vcu = __builtin_amdgcn_readfirstlane((int)ldsw[5]);
    const bool xl = __builtin_amdgcn_readfirstlane((int)ldsw[6]) != 0;
    const int xq = vcu & 7, rk = vcu >> 3, nl = G >> 3;

#pragma unroll 1
    for (int l = 0; l < 2; ++l) {
        unsigned char* wb = ws + WS_W + (size_t)l * WL;
        for (int rep = 0; rep < REP_GEMM; ++rep) {
            pg8::Gemm gm{XB, (const bf16*)(wb + OW_GU1), M, 2 * DFF, DM}; pg8::StaticOrder S; S.init(M, 2 * DFF, G, vcu);
            EpiSwiGLU E{H, SSQ};
            pg8::gemm_phase<EpiSwiGLU, pg8::StaticOrder, true, true>(ldsg, gm, S, E);
        }
        LSYNC();
        for (int rep = 0; rep < REP_GEMM; ++rep) {
            pg8::Gemm gm{H, (const bf16*)(wb + OW_D1), M, DM, DFF}; pg8::StaticOrder S; S.init(M, DM, G, vcu);
            EpiResid E{(l == 0 && rep == 0) ? INP(0) : (const float*)nullptr, XB, SSQ, rep == 0 ? 0.5f : 0.f};
            pg8::gemm_phase<EpiResid, pg8::StaticOrder, true, true>(ldsg, gm, S, E);
        }
        GSYNC();
        for (int rep = 0; rep < REP_GEMM; ++rep) {
            pg8::Gemm gm{XB, (const bf16*)(wb + OW_INA), M, 2304, DM}; pg8::StaticOrder S; S.init(M, 2304, G, vcu);
            EpiProj E{(bf16*)(R + R_QKNA), (bf16*)(R + R_GQK), (bf16*)(R + R_GR), (bf16*)(R + R_CODES), SSQ};
            pg8::gemm_phase<EpiProj, pg8::StaticOrder, true, true>(ldsg, gm, S, E);
            pg8::Gemm gv{(const bf16*)(wb + OW_INB), XB, 1024, M, DM}; pg8::StaticOrder S2; S2.init(1024, M, G, vcu);
            EpiVT E2{(bf16*)(R + R_VT), SSQ};
            pg8::gemm_phase<EpiVT, pg8::StaticOrder, true, true>(ldsg, gv, S2, E2);
        }
        LSYNC();
        for (int rep = 0; rep < REP_PREP; ++rep) { LAUNDER_TID int ph_ = -1; for (int k = xl ? rk : vcu; k < (xl ? 256 : 2048); k += (xl ? nl : G)) { const int it = xl ? ((((xq << 2) | (k >> 6)) << 6) | (k & 63)) : k; const int h_ = (it >> 6) & 3; gla_prep_item(A, l, lds, it, tid, h_ != ph_); ph_ = h_; } }
        LSYNC();
        for (int rep = 0; rep < REP_SCAN; ++rep) { LAUNDER_TID for (int k = xl ? rk : vcu; k < (xl ? 32 : 256); k += (xl ? nl : G)) gla_scan_item(A, xl ? ((((k >> 4) * 32 + xq * 4 + ((k >> 2) & 3)) << 2) | (k & 3)) : k, wave, lane); }
        GSYNC();
        for (int rep = 0; rep < REP_OUT; ++rep) { LAUNDER_TID for (int k = xl ? rk : vcu; k < (xl ? 128 : 1024); k += (xl ? nl : G)) { const int idx = 2 * k + (wave >> 2); gla_out_item(A, l, xl ? ((((xq << 2) | (idx >> 6)) << 6) | (idx & 63)) : idx, wave & 3, lane); } }
        for (int rep = 0; rep < REP_NA; ++rep) { LAUNDER_TID na_stage_rpb(l, (float*)lds + 512, tid); if (G % 8 == 0) { for (int li = vcu >> 3; li < 64; li += (G >> 3)) na_strip(A, l, (float*)lds, (const float*)lds + 512, ((vcu & 7) << 6) | li, wave, lane); } else { for (int it = vcu; it < 512; it += G) na_strip(A, l, (float*)lds, (const float*)lds + 512, it, wave, lane); } }
        GSYNC();
        for (int rep = 0; rep < REP_GEMM; ++rep) {
            pg8::Gemm gm{MIX, (const bf16*)(wb + OW_OUT), M, DM, DM}; pg8::StaticOrder S; S.init(M, DM, G, vcu);
            EpiResid E{nullptr, XB, SSQ, rep == 0 ? 1.0f : 0.f};
            pg8::gemm_phase<EpiResid, pg8::StaticOrder, true, true>(ldsg, gm, S, E);
        }
        LSYNC();
        for (int rep = 0; rep < REP_GEMM; ++rep) {
            pg8::Gemm gm{XB, (const bf16*)(wb + OW_GU2), M, 2 * DFF, DM}; pg8::StaticOrder S; S.init(M, 2 * DFF, G, vcu);
            EpiSwiGLU E{H, SSQ};
            pg8::gemm_phase<EpiSwiGLU, pg8::StaticOrder, true, true>(ldsg, gm, S, E);
        }
        LSYNC();
        for (int rep = 0; rep < REP_GEMM; ++rep) {
            pg8::Gemm gm{H, (const bf16*)(wb + OW_D2), M, DM, DFF}; pg8::StaticOrder S; S.init(M, DM, G, vcu);
            EpiResid E{nullptr, XB, SSQ, rep == 0 ? 0.5f : 0.f};
            pg8::gemm_phase<EpiResid, pg8::StaticOrder, true, true>(ldsg, gm, S, E);
        }
        LSYNC();
    }
    {
        LAUNDER_TID
        const float* gn = INP(19);
        const int gw = vcu * NWAVES + wave, NGW = G * NWAVES;
        for (int m = xl ? xq * 4096 + rk * NWAVES + wave : gw; m < (xl ? (xq + 1) * 4096 : M); m += (xl ? nl * NWAVES : NGW)) {
            float s = lane < 16 ? SSQ[(size_t)m * 16 + lane] : 0.f; s = wave_sum(s);
            const float rstd = rsqrtf(s * (1.0f / DM) + EPS);
            f32x4* xr = (f32x4*)(X + (size_t)m * DM) + lane; const f32x4* gr = (const f32x4*)gn + lane; const u32x2* xb = (const u32x2*)(XB + (size_t)m * DM) + lane;
#pragma unroll
            for (int j = 0; j < 4; ++j) { const u32x2 bb = xb[64 * j]; const f32x4 v = {bflo(bb.x), bfhi(bb.x), bflo(bb.y), bfhi(bb.y)}; xr[64 * j] = v * rstd * gr[64 * j]; }
        }
    }
}

extern "C" void kernel_launch(void* const* d_in, const int* in_sizes, int n_in, void* d_out, int out_size, void* d_ws, size_t ws_size, hipStream_t stream) {
    static int grid = 0;
    if (grid == 0) {
        if (n_in != 20 || out_size != M * DM || ws_size < WS_END) { fprintf(stderr, "kernel_launch: unexpected shapes / workspace (n_in %d out %d ws %zu need %zu)\n", n_in, out_size, ws_size, (size_t)WS_END); grid = -1; return; }
        int dev = 0, cus = 0, per_cu = 0;
        hipGetDevice(&dev); hipDeviceGetAttribute(&cus, hipDeviceAttributeMultiprocessorCount, dev);
        hipFuncSetAttribute((const void*)fwd_megakernel, hipFuncAttributeMaxDynamicSharedMemorySize, LDS_BYTES);
        hipOccupancyMaxActiveBlocksPerMultiprocessor(&per_cu, (const void*)fwd_megakernel, NWAVES * 64, LDS_BYTES);
        if (per_cu < 1) per_cu = 1;
        grid = cus * per_cu;
        (void)hipGetLastError();
    }
    if (grid < 0) return;
    Args a{};
    for (int i = 0; i < 20; ++i) a.in[i] = (const float*)d_in[i];
    a.out = (float*)d_out; a.ws = (unsigned char*)d_ws;
    if (hipMemsetAsync(d_ws, 0, 32768, stream) != hipSuccess) { fprintf(stderr, "memset failed\n"); return; }
    void* args[] = {&a};
    hipError_t e = hipLaunchCooperativeKernel((const void*)fwd_megakernel, dim3(grid), dim3(NWAVES * 64), args, LDS_BYTES, stream);
    if (e != hipSuccess) fprintf(stderr, "cooperative launch failed: %s (grid %d)\n", hipGetErrorString(e), grid);
}
```

```cpp
#include <hip/hip_runtime.h>
#include <cstdio>
#include <cstdint>
namespace pg8 {
#define PG8_LAS __attribute__((address_space(3)))
typedef unsigned short bf16_t;
typedef short bf16x8 __attribute__((ext_vector_type(8)));
typedef float f32x4 __attribute__((ext_vector_type(4)));
typedef unsigned u32x4 __attribute__((ext_vector_type(4)));
constexpr int BM = 256, BK = 64, HALF = 128, HTB = HALF * BK * 2  , STAGE_BYTES = 8 * HTB, NXCD = 8, WGM = 8;

__host__ __device__ __forceinline__ int lds_byte(int r, int c) { const int st = (r >> 4) * 2 + (c >> 5), rr = r & 15, cc = c & 31, ob = rr * 64 + cc * 2; return st * 1024 + (ob ^ (((ob >> 9) & 1) << 5)); }
__host__ __device__ __forceinline__ void stage_rc(int b, int& R, int& C) { const int st = b / 1024, sb = b % 1024, swz = sb ^ (((sb >> 9) & 1) << 5); R = (st >> 1) * 16 + swz / 64; C = (st & 1) * 32 + (swz % 64) / 2; }
__host__ __device__ __forceinline__ int perm32(int rho) { const int n = rho >> 4, i = rho & 15; return 8 * (i >> 2) + 4 * n + (i & 3); }

struct Unit { int pm, pn; };
struct Gemm { const bf16_t* A; const bf16_t* Bt; int M, N, K; };

struct StaticOrder {
    int nM, nN, nwg, G, c;
    __host__ __device__ void init(int M, int N, int G_, int c_) { nM = M / BM; nN = N / BM; nwg = nM * nN; G = G_; c = c_; }
    __host__ __device__ bool next(int i, Unit& u) const {
        const long L = (long)i * G + c; if (L >= nwg) return false;
        int wgid = (int)L; { const int q = nwg / NXCD, r = nwg % NXCD, xcd = wgid % NXCD, off = wgid / NXCD; wgid = (xcd < r ? xcd * (q + 1) : r * (q + 1) + (xcd - r) * q) + off; }
        const int nig = WGM * nN, gid = wgid / nig, fm = gid * WGM, gsz = (nM - fm) < WGM ? (nM - fm) : WGM;
        u.pm = fm + ((wgid % nig) % gsz); u.pn = (wgid % nig) / gsz; return true;
    }
    __device__ __forceinline__ void a_ready(const Unit&) const {}
    __device__ __forceinline__ void done(const Unit&) const {}
};

__device__ __forceinline__ unsigned cvt_pk_bf16(float lo, float hi) { unsigned r; asm volatile("v_cvt_pk_bf16_f32 %0, %1, %2" : "=v"(r) : "v"(lo), "v"(hi)); return r; }
typedef float f32x2 __attribute__((ext_vector_type(2)));
template <class Epi, class Sched, bool ALIGN_EPI = false, bool SP2 = false>
__device__ __forceinline__ void gemm_phase(PG8_LAS unsigned char* lds, const Gemm g, const Sched& S, const Epi& E) {
    int tid_ = threadIdx.x; asm volatile("" : "+v"(tid_));
    const int tid = tid_, wid = __builtin_amdgcn_readfirstlane(tid >> 6), lane = tid & 63, wr = wid >> 2, wc = wid & 3, fr = lane & 15, fq = lane >> 4;
    const int K = g.K, nt = K / BK;
    unsigned voffA[2], voffB[2];
#pragma unroll
    for (int i = 0; i < 2; ++i) { int R, C; stage_rc(tid * 16 + i * 8192, R, C); const int Rb = Epi::PERM ? ((R & ~31) + perm32(R & 31)) : R;
        voffA[i] = (unsigned)(R * K + C) * 2u; voffB[i] = (unsigned)(Rb * K + C) * 2u; }
    const size_t kstep = (size_t)(BK * 2);
    const size_t hstep = (size_t)HALF * K * 2;
    const size_t tstep = 2 * hstep;
    const unsigned ldsw = (unsigned)wid * 1024u;
    const int aoff = lds_byte(wr * 64 + fr, fq * 8), boff = lds_byte(wc * 32 + fr, fq * 8);
#define PG8_SA(b, h) (((b) * 2 + (h)) * HTB)
#define PG8_SB(b, h) ((4 + (b) * 2 + (h)) * HTB)
#define PG8_STAGE(bufoff, gbase, voff) do { _Pragma("unroll") for (int _i = 0; _i < 2; ++_i) \
        __builtin_amdgcn_global_load_lds((const unsigned*)((const char*)(gbase) + (voff)[_i]), (PG8_LAS unsigned*)(lds + (bufoff) + ldsw + _i * 8192), 16, 0, 0); } while (0)
#define PG8_LDA(dst, b, h) do { _Pragma("unroll") for (int m = 0; m < 4; ++m) _Pragma("unroll") for (int k = 0; k < 2; ++k) dst[m][k] = *(const PG8_LAS bf16x8*)(lds + PG8_SA(b, h) + aoff + m * 2048 + k * 1024); } while (0)
#define PG8_LDB(dst, b, h) do { _Pragma("unroll") for (int n = 0; n < 2; ++n) _Pragma("unroll") for (int k = 0; k < 2; ++k) dst[n][k] = *(const PG8_LAS bf16x8*)(lds + PG8_SB(b, h) + boff + n * 2048 + k * 1024); } while (0)
#define PG8_MMA(ai, bj, At, Bt) do { __builtin_amdgcn_s_setprio(1); _Pragma("unroll") for (int m = 0; m < 4; ++m) _Pragma("unroll") for (int n = 0; n < 2; ++n) _Pragma("unroll") for (int k = 0; k < 2; ++k) \
        acc[ai][bj][m][n] = __builtin_amdgcn_mfma_f32_16x16x32_bf16(Bt[n][k], At[m][k], acc[ai][bj][m][n], 0, 0, 0); __builtin_amdgcn_s_setprio(0); } while (0)
#define PG8_WAIT_V(n) asm volatile("s_waitcnt vmcnt(" #n ")" ::: "memory")
#define PG8_WAIT_L(n) asm volatile("s_waitcnt lgkmcnt(" #n ")" ::: "memory")
#define PG8_BAR __builtin_amdgcn_s_barrier()
#define PG8_SCHED __builtin_amdgcn_sched_barrier(0)
    Unit cur, nxt; int ui = 0;
    if (!S.next(0, cur)) return;
    f32x4 acc[2][2][4][2];
#pragma unroll
    for (int a = 0; a < 2; ++a)
#pragma unroll
        for (int b = 0; b < 2; ++b)
#pragma unroll
            for (int m = 0; m < 4; ++m)
#pragma unroll
                for (int n = 0; n < 2; ++n) acc[a][b][m][n] = (f32x4){0.f, 0.f, 0.f, 0.f};
    bf16x8 At[4][2], B0[2][2], B1[2][2];
    const char* cA = (const char*)g.A + (size_t)cur.pm * tstep; const char* cB = (const char*)g.Bt + (size_t)cur.pn * tstep;
    S.a_ready(cur);
    if constexpr (SP2) {
        PG8_STAGE(PG8_SB(0, 0), cB, voffB); PG8_STAGE(PG8_SB(0, 1), cB + hstep, voffB); PG8_STAGE(PG8_SA(0, 0), cA, voffA); PG8_STAGE(PG8_SA(0, 1), cA + hstep, voffA);
        if (wr == 1) PG8_BAR;
        PG8_WAIT_V(2); PG8_BAR;
        PG8_STAGE(PG8_SB(1, 0), cB + kstep, voffB); PG8_STAGE(PG8_SA(1, 0), cA + kstep, voffA); PG8_STAGE(PG8_SB(1, 1), cB + hstep + kstep, voffB);
        PG8_WAIT_V(6); PG8_BAR;
    } else {
        PG8_STAGE(PG8_SB(0, 0), cB, voffB); PG8_STAGE(PG8_SA(0, 0), cA, voffA); PG8_STAGE(PG8_SB(0, 1), cB + hstep, voffB); PG8_STAGE(PG8_SA(0, 1), cA + hstep, voffA);
        if (wr == 1) PG8_BAR;
        PG8_WAIT_V(4); PG8_BAR;
        PG8_STAGE(PG8_SB(1, 0), cB + kstep, voffB); PG8_STAGE(PG8_SA(1, 0), cA + kstep, voffA); PG8_STAGE(PG8_SB(1, 1), cB + hstep + kstep, voffB);
        PG8_WAIT_V(6); PG8_BAR;
    }
    for (;;) {
        const bool has_next = S.next(ui + 1, nxt);
        const char* nA = has_next ? (const char*)g.A + (size_t)nxt.pm * tstep : cA; const char* nB = has_next ? (const char*)g.Bt + (size_t)nxt.pn * tstep : cB;
        for (int t = 0; t < nt; t += 2) {
            const bool last = (t == nt - 2);
            const char* a1 = cA + (size_t)(t + 1) * kstep;
            const char* a2 = last ? nA : cA + (size_t)(t + 2) * kstep; const char* b2 = last ? nB : cB + (size_t)(t + 2) * kstep;
            const char* a3 = a2 + kstep; const char* b3 = b2 + kstep;
            if (last && has_next) S.a_ready(nxt);
            if constexpr (SP2) {
            PG8_LDB(B0, 0, 0); PG8_LDB(B1, 0, 1); PG8_SCHED; PG8_LDA(At, 0, 0); PG8_STAGE(PG8_SA(1, 1), a1 + hstep, voffA);
            PG8_WAIT_V(8); PG8_WAIT_L(0); PG8_BAR; PG8_MMA(0, 0, At, B0); PG8_MMA(0, 1, At, B1); PG8_BAR; PG8_SCHED;
            PG8_LDA(At, 0, 1); PG8_STAGE(PG8_SB(0, 0), b2, voffB); PG8_STAGE(PG8_SB(0, 1), b2 + hstep, voffB); PG8_STAGE(PG8_SA(0, 0), a2, voffA);
            PG8_WAIT_V(8); PG8_WAIT_L(0); PG8_BAR; PG8_MMA(1, 0, At, B0); PG8_MMA(1, 1, At, B1); PG8_BAR; PG8_SCHED;
            PG8_LDB(B0, 1, 0); PG8_LDB(B1, 1, 1); PG8_SCHED; PG8_LDA(At, 1, 0); PG8_STAGE(PG8_SA(0, 1), a2 + hstep, voffA);
            PG8_WAIT_V(8); PG8_WAIT_L(0); PG8_BAR; PG8_MMA(0, 0, At, B0); PG8_MMA(0, 1, At, B1); PG8_BAR; PG8_SCHED;
            PG8_LDA(At, 1, 1); PG8_STAGE(PG8_SB(1, 0), b3, voffB); PG8_STAGE(PG8_SB(1, 1), b3 + hstep, voffB); PG8_STAGE(PG8_SA(1, 0), a3, voffA);
            PG8_WAIT_V(8); PG8_WAIT_L(0); PG8_BAR; PG8_MMA(1, 0, At, B0); PG8_MMA(1, 1, At, B1); PG8_BAR; PG8_SCHED;
            } else {
            PG8_LDB(B0, 0, 0); PG8_SCHED; PG8_LDA(At, 0, 0); PG8_STAGE(PG8_SA(1, 1), a1 + hstep, voffA);
            PG8_WAIT_L(8); PG8_BAR; PG8_WAIT_L(0); PG8_MMA(0, 0, At, B0); PG8_BAR; PG8_SCHED;
            PG8_LDB(B1, 0, 1); PG8_STAGE(PG8_SB(0, 0), b2, voffB);
            PG8_BAR; PG8_WAIT_L(0); PG8_MMA(0, 1, At, B1); PG8_BAR;
            PG8_LDA(At, 0, 1); PG8_STAGE(PG8_SA(0, 0), a2, voffA);
            PG8_BAR; PG8_WAIT_L(0); PG8_MMA(1, 0, At, B0); PG8_BAR; PG8_SCHED;
            PG8_STAGE(PG8_SB(0, 1), b2 + hstep, voffB);
            PG8_WAIT_V(6); PG8_BAR; PG8_MMA(1, 1, At, B1); PG8_BAR;
            PG8_LDB(B0, 1, 0); PG8_SCHED; PG8_LDA(At, 1, 0); PG8_STAGE(PG8_SA(0, 1), a2 + hstep, voffA);
            PG8_WAIT_L(8); PG8_BAR; PG8_WAIT_L(0); PG8_MMA(0, 0, At, B0); PG8_BAR; PG8_SCHED;
            PG8_LDB(B1, 1, 1); PG8_STAGE(PG8_SB(1, 0), b3, voffB);
            PG8_BAR; PG8_WAIT_L(0); PG8_MMA(0, 1, At, B1); PG8_BAR;
            PG8_LDA(At, 1, 1); PG8_STAGE(PG8_SA(1, 0), a3, voffA);
            PG8_BAR; PG8_WAIT_L(0); PG8_MMA(1, 0, At, B0); PG8_BAR; PG8_SCHED;
            PG8_STAGE(PG8_SB(1, 1), b3 + hstep, voffB);
            PG8_WAIT_V(6); PG8_BAR; PG8_MMA(1, 1, At, B1); PG8_BAR;
            }
        }
        if constexpr (ALIGN_EPI) { if (wr == 0) PG8_BAR; }
        if constexpr (!Epi::AFTER_DRAIN) { E(acc, cur, wr, wc, fr, fq); S.done(cur); }
        if (!has_next) break;
#pragma unroll
        for (int a = 0; a < 2; ++a)
#pragma unroll
            for (int b = 0; b < 2; ++b)
#pragma unroll
                for (int m = 0; m < 4; ++m)
#pragma unroll
                    for (int n = 0; n < 2; ++n) acc[a][b][m][n] = (f32x4){0.f, 0.f, 0.f, 0.f};
        cur = nxt; cA = nA; cB = nB; ++ui;
        if constexpr (ALIGN_EPI) { if (wr == 1) PG8_BAR; }
    }
    PG8_WAIT_V(0);
    if constexpr (!ALIGN_EPI) { if (wr == 0) PG8_BAR; }
    PG8_BAR;
    if constexpr (Epi::AFTER_DRAIN) { E.fused(acc, cur, wr, wc, fr, fq, lds, wid, lane); S.done(cur); }
#undef PG8_SA
#undef PG8_SB
#undef PG8_STAGE
#undef PG8_LDA
#undef PG8_LDB
#undef PG8_MMA
#undef PG8_WAIT_V
#undef PG8_WAIT_L
#undef PG8_BAR
#undef PG8_SCHED
}
}
#include <hip/hip_cooperative_groups.h>
namespace cg = cooperative_groups;
#define DI __device__ __forceinline__
typedef unsigned short bf16;
typedef float f32x4 __attribute__((ext_vector_type(4)));
typedef short bf16x8 __attribute__((ext_vector_type(8)));
typedef unsigned u32x4 __attribute__((ext_vector_type(4)));
typedef unsigned u32x2 __attribute__((ext_vector_type(2)));
#define LAS __attribute__((address_space(3)))

constexpr int M = 32768, DM = 1024, DFF = 2816, SEQ = 4096;
constexpr float EPS = 1e-6f;
constexpr size_t HM = 512u * 1024u;
constexpr size_t WS_W = 2 * HM, WL = 83 * HM;
constexpr size_t OW_GU1 = 0, OW_D1 = 22 * HM, OW_INA = 33 * HM, OW_INB = 42 * HM, OW_OUT = 46 * HM, OW_GU2 = 50 * HM, OW_D2 = 72 * HM;
constexpr size_t WS_XB = WS_W + 2 * WL, WS_SSQ = WS_XB + 128 * HM, WS_R = WS_SSQ + 4 * HM;
constexpr size_t R_QKNA = 0, R_VT = 128 * HM, R_GR = 256 * HM, R_GP = 320 * HM, R_SBEF = 448 * HM, R_GQK = 576 * HM, R_KT = 640 * HM, R_CODES = 704 * HM, R_DEC = 708 * HM, R_END = 710 * HM;
constexpr size_t R_MIX = 576 * HM, R_H = 0;
constexpr size_t WS_END = WS_R + R_END;
constexpr int LDS_BYTES = 147456;
constexpr int NWAVES = 8;

DI unsigned pk2(float lo, float hi) { return pg8::cvt_pk_bf16(lo, hi); }
DI float bflo(unsigned w) { return __uint_as_float(w << 16); }
DI float bfhi(unsigned w) { return __uint_as_float(w & 0xffff0000u); }
DI bf16x8 ld16(const bf16* p) { return *(const bf16x8*)p; }
DI bf16x8 ld8x2(const bf16* p0, const bf16* p1) { const u32x2 a = *(const u32x2*)p0, b = *(const u32x2*)p1; u32x4 v; v.x = a.x; v.y = a.y; v.z = b.x; v.w = b.y; return __builtin_bit_cast(bf16x8, v); }
DI f32x4 mfma16(bf16x8 a, bf16x8 b, f32x4 c) { return __builtin_amdgcn_mfma_f32_16x16x32_bf16(a, b, c, 0, 0, 0); }
DI bf16x8 pack8(f32x4 a, f32x4 b) { u32x4 v; v.x = pk2(a[0], a[1]); v.y = pk2(a[2], a[3]); v.z = pk2(b[0], b[1]); v.w = pk2(b[2], b[3]); return __builtin_bit_cast(bf16x8, v); }
DI float silu_f(float x) { return x * __builtin_amdgcn_rcpf(1.0f + __expf(-x)); }
DI float wave_sum(float v) {
#pragma unroll
    for (int o = 1; o < 64; o <<= 1) v += __shfl_xor(v, o);
    return v;
}

DI void row_rstd(const float* ssq, int row0, int fq, float (&rs)[2][4]) {
#pragma unroll
    for (int ai = 0; ai < 2; ++ai)
#pragma unroll
        for (int m = 0; m < 4; ++m) {
            const f32x4 v = *(const f32x4*)(ssq + (size_t)(row0 + ai * 128 + m * 16) * 16 + 4 * fq);
            float s = (v[0] + v[1]) + (v[2] + v[3]);
            s += __shfl_xor(s, 16); s += __shfl_xor(s, 32);
            rs[ai][m] = rsqrtf(s * (1.0f / DM) + EPS);
        }
}
struct EpiSwiGLU {
    static constexpr bool PERM = true, AFTER_DRAIN = false;
    bf16* H; const float* ssq;
    DI void operator()(const f32x4 (&acc)[2][2][4][2], const pg8::Unit& u, int wr, int wc, int fr, int fq) const {
        const int row0 = u.pm * 256 + wr * 64 + fr, col0 = u.pn * 128 + wc * 32 + 8 * fq;
        float rs[2][4]; row_rstd(ssq, row0, fq, rs);
#pragma unroll
        for (int ai = 0; ai < 2; ++ai)
#pragma unroll
            for (int m = 0; m < 4; ++m) {
                typedef float f32x2 __attribute__((ext_vector_type(2)));
                const float r = rs[ai][m]; const float r2s = r * r, rls = r * -1.44269504f; const f32x2 r2 = {r2s, r2s}, rl = {rls, rls};
                unsigned hw[4];
#pragma unroll
                for (int q = 0; q < 4; ++q) {
                    const f32x4 gq = acc[ai][0][m][q >> 1], uq = acc[ai][1][m][q >> 1];
                    const f32x2 g2 = {gq[2 * (q & 1)], gq[2 * (q & 1) + 1]}, u2 = {uq[2 * (q & 1)], uq[2 * (q & 1) + 1]};
                    const f32x2 t = g2 * rl; f32x2 e; e.x = __builtin_amdgcn_exp2f(t.x); e.y = __builtin_amdgcn_exp2f(t.y);
                    const f32x2 d = e + 1.0f; f32x2 rc; rc.x = __builtin_amdgcn_rcpf(d.x); rc.y = __builtin_amdgcn_rcpf(d.y);
                    const f32x2 hv = ((g2 * u2) * r2) * rc;
                    hw[q] = pk2(hv.x, hv.y);
                }
                u32x4 w; w.x = hw[0]; w.y = hw[1]; w.z = hw[2]; w.w = hw[3];
                *(u32x4*)(H + (size_t)(row0 + ai * 128 + m * 16) * DFF + col0) = w;
            }
    }
};
struct EpiResid {
    static constexpr bool PERM = true, AFTER_DRAIN = false;
    const float* base32; bf16* XB; float* ssq; float alpha;
    DI void operator()(const f32x4 (&acc)[2][2][4][2], const pg8::Unit& u, int wr, int wc, int fr, int fq) const {
        const int row0 = u.pm * 256 + wr * 64 + fr, col0 = u.pn * 256 + wc * 32 + 8 * fq;
#pragma unroll
        for (int ai = 0; ai < 2; ++ai)
#pragma unroll
            for (int m = 0; m < 4; ++m) {
                const int row = row0 + ai * 128 + m * 16; float ss = 0.f;
#pragma unroll
                for (int bj = 0; bj < 2; ++bj) {
                    const size_t off = (size_t)row * DM + col0 + bj * 128;
                    f32x4 b0, b1;
                    if (base32) { b0 = *(const f32x4*)(base32 + off); b1 = *(const f32x4*)(base32 + off + 4); }
                    else { const u32x4 bb = *(const u32x4*)(XB + off); b0 = (f32x4){bflo(bb.x), bfhi(bb.x), bflo(bb.y), bfhi(bb.y)}; b1 = (f32x4){bflo(bb.z), bfhi(bb.z), bflo(bb.w), bfhi(bb.w)}; }
                    const f32x4 v0 = b0 + acc[ai][bj][m][0] * alpha, v1 = b1 + acc[ai][bj][m][1] * alpha;
                    ss += ((v0[0] * v0[0] + v0[1] * v0[1]) + (v0[2] * v0[2] + v0[3] * v0[3])) + ((v1[0] * v1[0] + v1[1] * v1[1]) + (v1[2] * v1[2] + v1[3] * v1[3]));
                    u32x4 w; w.x = pk2(v0[0], v0[1]); w.y = pk2(v0[2], v0[3]); w.z = pk2(v1[0], v1[1]); w.w = pk2(v1[2], v1[3]);
                    *(u32x4*)(XB + off) = w;
                }
                ss += __shfl_xor(ss, 16); ss += __shfl_xor(ss, 32);
                if (fq == 0) ssq[(size_t)row * 16 + u.pn * 4 + wc] = ss;
                asm volatile("" ::: "memory");
            }
    }
};
struct EpiProj {
    static constexpr bool PERM = true, AFTER_DRAIN = false;
    bf16* QKNA; bf16* GQK; bf16* GR; bf16* CODES; const float* ssq;
    DI void operator()(const f32x4 (&acc)[2][2][4][2], const pg8::Unit& u, int wr, int wc, int fr, int fq) const {
        const int row0 = u.pm * 256 + wr * 64 + fr; const int pn = u.pn;
        float rs[2][4]; row_rstd(ssq, row0, fq, rs);
        bf16* dst; int ld, cb;
        if (pn < 4) { dst = QKNA; ld = 1024; cb = 256 * pn; } else if (pn < 6) { dst = GQK; ld = 512; cb = 256 * (pn - 4); } else if (pn < 8) { dst = GR; ld = 512; cb = 256 * (pn - 6); } else { dst = CODES; ld = 32; cb = 0; }
        const int col0 = cb + wc * 32 + 8 * fq;
#pragma unroll
        for (int ai = 0; ai < 2; ++ai)
#pragma unroll
            for (int m = 0; m < 4; ++m) {
                const float r = rs[ai][m];
#pragma unroll
                for (int bj = 0; bj < 2; ++bj) {
                    const f32x4 a = acc[ai][bj][m][0] * r, b = acc[ai][bj][m][1] * r;
                    u32x4 w; w.x = pk2(a[0], a[1]); w.y = pk2(a[2], a[3]); w.z = pk2(b[0], b[1]); w.w = pk2(b[2], b[3]);
                    if (pn < 8 || (bj == 0 && wc == 0)) *(u32x4*)(dst + (size_t)(row0 + ai * 128 + m * 16) * ld + col0 + bj * 128) = w;
                }
            }
    }
};
struct EpiVT {
    static constexpr bool PERM = true, AFTER_DRAIN = false;
    bf16* VT; const float* ssq;
    DI void operator()(const f32x4 (&acc)[2][2][4][2], const pg8::Unit& u, int wr, int wc, int fr, int fq) const {
        const int row0 = u.pm * 256 + wr * 64 + fr, tok0 = u.pn * 256 + wc * 32 + 8 * fq;
#pragma unroll
        for (int bj = 0; bj < 2; ++bj) {
            float rs[8];
#pragma unroll
            for (int j = 0; j < 8; ++j) {
                float s = ssq[(size_t)(tok0 + bj * 128 + j) * 16 + fr];
                s += __shfl_xor(s, 1); s += __shfl_xor(s, 2); s += __shfl_xor(s, 4); s += __shfl_xor(s, 8);
                rs[j] = rsqrtf(s * (1.0f / DM) + EPS);
            }
#pragma unroll
            for (int ai = 0; ai < 2; ++ai)
#pragma unroll
                for (int m = 0; m < 4; ++m) {
                    const f32x4 a = acc[ai][bj][m][0], b = acc[ai][bj][m][1];
                    u32x4 w; w.x = pk2(a[0] * rs[0], a[1] * rs[1]); w.y = pk2(a[2] * rs[2], a[3] * rs[3]); w.z = pk2(b[0] * rs[4], b[1] * rs[5]); w.w = pk2(b[2] * rs[6], b[3] * rs[7]);
                    *(u32x4*)(VT + ((size_t)((tok0 + bj * 128) >> 3) * 1024 + (row0 + ai * 128 + m * 16)) * 8) = w;
                }
        }
    }
};

DI void conv_item(const float* W, int K, int N, int kb, int n0, bf16* dst  , const float* gain, float* scr, int lane) {
    const int k0 = 64 * kb;
#pragma unroll
    for (int i = 0; i < 8; ++i) {
        const int kk = 8 * i + (lane >> 3), cc = 4 * (lane & 7);
        f32x4 v = *(const f32x4*)(W + (size_t)(k0 + kk) * N + n0 + cc); if (gain) v = v * gain[k0 + kk];
        scr[kk * 33 + cc] = v[0]; scr[kk * 33 + cc + 1] = v[1]; scr[kk * 33 + cc + 2] = v[2]; scr[kk * 33 + cc + 3] = v[3];
    }
    asm volatile("s_waitcnt lgkmcnt(0)" ::: "memory");
    const int c = lane & 7;
#pragma unroll
    for (int j = 0; j < 4; ++j) { const int n = (lane >> 3) + 8 * j; const float* s = scr + (8 * c) * 33 + n;
        u32x4 o; o.x = pk2(s[0 * 33], s[1 * 33]); o.y = pk2(s[2 * 33], s[3 * 33]); o.z = pk2(s[4 * 33], s[5 * 33]); o.w = pk2(s[6 * 33], s[7 * 33]);
        *(u32x4*)(dst + (size_t)n * K + k0 + 8 * c) = o; }
    asm volatile("s_waitcnt lgkmcnt(0)" ::: "memory");
}
struct Args { const float* in[20]; float* out; unsigned char* ws; };
#define INP(i) ((const float*)karg(8 * (i)))
#define WSP() ((unsigned char*)karg(168))
#define OUTP() ((float*)karg(160))
typedef const char __attribute__((address_space(4)))* kaptr_t;
DI const void* karg(int off) { asm volatile("" : "+s"(off)); kaptr_t ka = (kaptr_t)__builtin_amdgcn_kernarg_segment_ptr(); return *(const void* const __attribute__((address_space(4)))*)(ka + off); }
struct KA { DI const float* inp(int i) const { return (const float*)karg(8 * i); } };

DI void prologue(const Args& A, unsigned char* lds, int wave, int lane) {
    float* scr = (float*)(lds + wave * 16384);
    const int gw = blockIdx.x * NWAVES + wave, NGW = gridDim.x * NWAVES;
    constexpr int I_GU = 16 * 88, I_D = 44 * 32, I_IN = 16 * 97, I_OUT = 16 * 32, PER_L = 6 * I_GU + I_IN + I_OUT;
    static_assert(I_GU == I_D, "");
    for (int it = gw; it < 2 * PER_L; it += NGW) {
        const int l = it / PER_L; int r = it % PER_L;
        unsigned char* wb = WSP() + WS_W + (size_t)l * WL;
        const int seg = r < 6 * I_GU ? r / I_GU : (r < 6 * I_GU + I_IN ? 6 : 7);
        if (seg < 6) {
            r -= seg * I_GU;
            const int ffn = seg / 3, kind = seg % 3;
            if (kind < 2) {
                const float* W = INP((ffn ? 16 : 2) + kind) + (size_t)l * DM * DFF; const float* gn = INP(ffn ? 15 : 1) + l * DM;
                const int kb = r / 88, nb = r % 88, n0 = 32 * nb;
                bf16* dst = (bf16*)(wb + (ffn ? OW_GU2 : OW_GU1)) + (size_t)((n0 >> 7) * 256 + kind * 128 + (n0 & 127)) * DM;
                conv_item(W, DM, DFF, kb, n0, dst, gn, scr, lane);
            } else {
                const float* W = INP(ffn ? 18 : 4) + (size_t)l * DM * DFF;
                const int kb = r / 32, nb = r % 32, n0 = 32 * nb;
                bf16* dst = (bf16*)(wb + (ffn ? OW_D2 : OW_D1)) + (size_t)n0 * DFF;
                conv_item(W, DFF, DM, kb, n0, dst, nullptr, scr, lane);
            }
        } else if (seg == 6) {
            r -= 6 * I_GU;
            const float* W = INP(6) + (size_t)l * DM * 3104; const float* gn = INP(5) + l * DM;
            const int kb = r / 97, nb = r % 97, n0 = 32 * nb;
            bf16* wa = (bf16*)(wb + OW_INA); bf16* wv = (bf16*)(wb + OW_INB); bf16* dst;
            if (n0 < 1024) dst = wa + (size_t)n0 * DM;
            else if (n0 < 1536) dst = wv + (size_t)(n0 - 1024) * DM;
            else if (n0 < 2048) dst = wa + (size_t)(n0 - 512) * DM;
            else if (n0 < 2560) dst = wv + (size_t)(n0 - 1536) * DM;
            else if (n0 < 3072) dst = wa + (size_t)(n0 - 1024) * DM;
            else dst = wa + (size_t)2048 * DM;
            conv_item(W, DM, 3104, kb, n0, dst, gn, scr, lane);
        } else {
            r -= 6 * I_GU + I_IN;
            const float* W = INP(14) + (size_t)l * DM * DM;
            const int kb = r / 32, nb = r % 32, n0 = 32 * nb;
            conv_item(W, DM, DM, kb, n0, (bf16*)(wb + OW_OUT) + (size_t)n0 * DM, nullptr, scr, lane);
        }
    }
    const float* x = INP(0); bf16* XB = (bf16*)(WSP() + WS_XB); float* ssq = (float*)(WSP() + WS_SSQ);
    for (int m = gw; m < M; m += NGW) {
        const f32x4* xr = (const f32x4*)(x + (size_t)m * DM) + lane; f32x4 v[4]; float s = 0.f;
#pragma unroll
        for (int j = 0; j < 4; ++j) { v[j] = xr[64 * j]; s += (v[j][0] * v[j][0] + v[j][1] * v[j][1]) + (v[j][2] * v[j][2] + v[j][3] * v[j][3]); }
        s = wave_sum(s);
        u32x2* o = (u32x2*)(XB + (size_t)m * DM) + lane;
#pragma unroll
        for (int j = 0; j < 4; ++j) { u32x2 w; w.x = pk2(v[j][0], v[j][1]); w.y = pk2(v[j][2], v[j][3]); o[64 * j] = w; }
        if (lane < 16) ssq[(size_t)m * 16 + lane] = lane == 0 ? s : 0.f;
    }
}
#define SCHED_FENCE() __builtin_amdgcn_sched_barrier(0)
DI float log_sigmoid_f(float z) { return fminf(z, 0.f) - __logf(1.0f + __expf(-fabsf(z))); }
DI void gla_prep_item(const Args& A, int l, unsigned char* ldsb, int item, int tid, bool stage) {
    float* gl = (float*)ldsb; float* tot = gl + 2 * 64 * 65; float* wg = tot + 512; float* bg = wg + 2048; bf16* T = (bf16*)(bg + 128);
    unsigned char* R = WSP() + WS_R;
    const bf16* CODES = (const bf16*)(R + R_CODES); const bf16* GQK = (const bf16*)(R + R_GQK);
    bf16* GP = (bf16*)(R + R_GP); bf16* KT = (bf16*)(R + R_KT); float* DEC = (float*)(R + R_DEC);
    const int c = item & 63, bh = item >> 6, h = bh & 3, b = bh >> 2;
    const size_t tok0 = (size_t)b * SEQ + c * 64;
    const int t = tid >> 3, dg = tid & 7;
    const u32x4* cp = (const u32x4*)(CODES + (tok0 + t) * 32);
    const u32x4 cq0 = cp[0], cq1 = cp[1], cq2 = cp[2], cq3 = cp[3];
    const u32x4 qv = *(const u32x4*)(GQK + (tok0 + t) * 512 + h * 64 + 8 * dg), kv = *(const u32x4*)(GQK + (tok0 + t) * 512 + 256 + h * 64 + 8 * dg);
    if (stage) {
        const int idx = tid * 4, dir = idx >> 10, r = (idx >> 6) & 15, d = idx & 63;
        const float* w = (dir ? INP(11) : INP(9)) + (size_t)l * 16 * 256 + r * 256 + h * 64 + d;
        *(f32x4*)(wg + idx) = *(const f32x4*)w;
        if (tid < 128) { const int dr = tid >> 6, dd = tid & 63; bg[tid] = (dr ? INP(12) : INP(10))[l * 256 + h * 64 + dd]; }
        __syncthreads();
    }
    {
        float cf[32];
#pragma unroll
        for (int j = 0; j < 4; ++j) { const u32x4 v = j == 0 ? cq0 : (j == 1 ? cq1 : (j == 2 ? cq2 : cq3)); cf[8 * j + 0] = bflo(v.x); cf[8 * j + 1] = bfhi(v.x); cf[8 * j + 2] = bflo(v.y); cf[8 * j + 3] = bfhi(v.y); cf[8 * j + 4] = bflo(v.z); cf[8 * j + 5] = bfhi(v.z); cf[8 * j + 6] = bflo(v.w); cf[8 * j + 7] = bfhi(v.w); }
#pragma unroll
        for (int dir = 0; dir < 2; ++dir) {
            float z[8];
#pragma unroll
            for (int dd = 0; dd < 8; ++dd) z[dd] = bg[dir * 64 + 8 * dg + dd];
#pragma unroll
            for (int r = 0; r < 16; ++r) {
                const f32x4 w0 = *(const f32x4*)(wg + dir * 1024 + r * 64 + 8 * dg), w1 = *(const f32x4*)(wg + dir * 1024 + r * 64 + 8 * dg + 4);
                const float cv = cf[dir * 16 + r];
                z[0] += cv * w0[0]; z[1] += cv * w0[1]; z[2] += cv * w0[2]; z[3] += cv * w0[3]; z[4] += cv * w1[0]; z[5] += cv * w1[1]; z[6] += cv * w1[2]; z[7] += cv * w1[3];
            }
#pragma unroll
            for (int dd = 0; dd < 8; ++dd) gl[(dir * 64 + t) * 65 + 8 * dg + dd] = log_sigmoid_f(z[dd]) * (1.0f / 16.0f);
        }
    }
    __syncthreads();
    {
        const int dir = tid >> 8, seg = (tid >> 6) & 3, d = tid & 63;
        float* gp = gl + (dir * 64 + 16 * seg) * 65 + d; float v[16];
#pragma unroll
        for (int tt = 0; tt < 16; ++tt) v[tt] = gp[tt * 65];
        if (dir == 0) {
#pragma unroll
            for (int tt = 1; tt < 16; ++tt) v[tt] += v[tt - 1];
        } else {
#pragma unroll
            for (int tt = 14; tt >= 0; --tt) v[tt] += v[tt + 1];
        }
        tot[(dir * 4 + seg) * 64 + d] = dir == 0 ? v[15] : v[0];
        __syncthreads();
        float off = 0.f;
        if (dir == 0) { for (int s2 = 0; s2 < 4; ++s2) if (s2 < seg) off += tot[s2 * 64 + d]; }
        else { for (int s2 = 0; s2 < 4; ++s2) if (s2 > seg) off += tot[(4 + s2) * 64 + d]; }
#pragma unroll
        for (int tt = 0; tt < 16; ++tt) gp[tt * 65] = v[tt] + off;
    }
    __syncthreads();
    {
        float q[8], k[8];
        q[0] = bflo(qv.x); q[1] = bfhi(qv.x); q[2] = bflo(qv.y); q[3] = bfhi(qv.y); q[4] = bflo(qv.z); q[5] = bfhi(qv.z); q[6] = bflo(qv.w); q[7] = bfhi(qv.w);
        k[0] = bflo(kv.x); k[1] = bfhi(kv.x); k[2] = bflo(kv.y); k[3] = bfhi(kv.y); k[4] = bflo(kv.z); k[5] = bfhi(kv.z); k[6] = bflo(kv.w); k[7] = bfhi(kv.w);
        float qf[8], kf[8], qb[8], kb[8];
#pragma unroll
        for (int dd = 0; dd < 8; ++dd) {
            const int d = 8 * dg + dd;
            const float bf = gl[t * 65 + d], bb = gl[(64 + t) * 65 + d], bfl = gl[63 * 65 + d], bb0 = gl[64 * 65 + d];
            qf[dd] = q[dd] * 0.125f * __expf(bf); kf[dd] = k[dd] * __expf(-bf);
            qb[dd] = q[dd] * 0.125f * __expf(bb); kb[dd] = k[dd] * __expf(-bb);
            T[d * 72 + t] = (bf16)(pk2(k[dd] * __expf(bfl - bf), 0.f) & 0xffffu);
            T[(64 + d) * 72 + t] = (bf16)(pk2(k[dd] * __expf(bb0 - bb), 0.f) & 0xffffu);
        }
        const size_t go = (tok0 + t) * 256 + h * 64 + 8 * dg; const size_t AS = (size_t)M * 256;
        u32x4 w;
        w.x = pk2(qf[0], qf[1]); w.y = pk2(qf[2], qf[3]); w.z = pk2(qf[4], qf[5]); w.w = pk2(qf[6], qf[7]); *(u32x4*)(GP + go) = w;
        w.x = pk2(kf[0], kf[1]); w.y = pk2(kf[2], kf[3]); w.z = pk2(kf[4], kf[5]); w.w = pk2(kf[6], kf[7]); *(u32x4*)(GP + AS + go) = w;
        w.x = pk2(qb[0], qb[1]); w.y = pk2(qb[2], qb[3]); w.z = pk2(qb[4], qb[5]); w.w = pk2(qb[6], qb[7]); *(u32x4*)(GP + 2 * AS + go) = w;
        w.x = pk2(kb[0], kb[1]); w.y = pk2(kb[2], kb[3]); w.z = pk2(kb[4], kb[5]); w.w = pk2(kb[6], kb[7]); *(u32x4*)(GP + 3 * AS + go) = w;
        if (tid < 128) { const int dir = tid >> 6, d = tid & 63; DEC[((size_t)(dir * 32 + bh) * 64 + c) * 64 + d] = __expf(dir ? gl[64 * 65 + d] : gl[63 * 65 + d]); }
    }
    __syncthreads();
#pragma unroll
    for (int i = 0; i < 2; ++i) {
        const int u = tid + 512 * i, dir = u >> 9, d = (u >> 3) & 63, j = u & 7;
        *(u32x4*)(KT + ((size_t)((tok0 >> 3) + j) * 512 + dir * 256 + h * 64 + d) * 8) = *(const u32x4*)(T + (dir * 64 + d) * 72 + 8 * j);
    }
    __syncthreads();
}

DI void gla_scan_item(const Args& A, int item, int wave, int lane) {
    unsigned char* R = WSP() + WS_R;
    const bf16* VT = (const bf16*)(R + R_VT); const bf16* KT = (const bf16*)(R + R_KT); const float* DEC = (const float*)(R + R_DEC); bf16* SBEF = (bf16*)(R + R_SBEF);
    const int es = item & 3, chain = item >> 2, dir = chain >> 5, bh = chain & 31, h = bh & 3, b = bh >> 2;
    const int c = lane & 15, g = lane >> 4, ebl = wave >> 2, db = wave & 3, e0 = 32 * es + 16 * ebl;
    const bf16* kp = KT + ((size_t)(b * 512 + g) * 512 + dir * 256 + h * 64 + 16 * db + c) * 8;
    const bf16* vp = VT + ((size_t)(b * 512 + g) * 1024 + 512 + h * 128 + e0 + c) * 8;
    const float* dp = DEC + (size_t)chain * 64 * 64 + 16 * db + 4 * g;
    bf16* sp = SBEF + ((size_t)chain * 64 * 128 + e0 + c) * 64 + 16 * db + 4 * g;
    f32x4 S = {0.f, 0.f, 0.f, 0.f};
#define SC_CH(n) (dir ? 63 - (n) : (n))
#define SC_LOAD(k, n) do { const int c_ = SC_CH((n) < 63 ? (n) : 63); a0##k = ld16(kp + (size_t)c_ * 32768); a1##k = ld16(kp + (size_t)c_ * 32768 + 16384); b0##k = ld16(vp + (size_t)c_ * 65536); b1##k = ld16(vp + (size_t)c_ * 65536 + 32768); dc##k = *(const f32x4*)(dp + c_ * 64); } while (0)
#define SC_STEP(k, n) do { u32x2 w_; w_.x = pk2(S[0], S[1]); w_.y = pk2(S[2], S[3]); *(u32x2*)(sp + (size_t)SC_CH(n) * 128 * 64) = w_; S = S * dc##k; S = mfma16(a0##k, b0##k, S); S = mfma16(a1##k, b1##k, S); } while (0)
    bf16x8 a00, a10, b00, b10, a01, a11, b01, b11, a02, a12, b02, b12, a03, a13, b03, b13; f32x4 dc0, dc1, dc2, dc3;
    SC_LOAD(0, 0); SC_LOAD(1, 1); SC_LOAD(2, 2); SC_LOAD(3, 3);
#pragma unroll 1
    for (int n = 0; n < 64; n += 4) {
        SC_STEP(0, n); SC_LOAD(0, n + 4);
        SC_STEP(1, n + 1); SC_LOAD(1, n + 5);
        SC_STEP(2, n + 2); SC_LOAD(2, n + 6);
        SC_STEP(3, n + 3); SC_LOAD(3, n + 7);
    }
#undef SC_CH
#undef SC_LOAD
#undef SC_STEP
}

DI void gla_out_item(const Args& A, int l, int item, int tb, int lane) {
    unsigned char* R = WSP() + WS_R;
    const bf16* VT = (const bf16*)(R + R_VT); const bf16* GP = (const bf16*)(R + R_GP); const bf16* SBEF = (const bf16*)(R + R_SBEF); const bf16* GR = (const bf16*)(R + R_GR); bf16* MIX = (bf16*)(R + R_MIX);
    const size_t AS = (size_t)M * 256;
    const int ck = item & 63, bh = item >> 6, h = bh & 3, b = bh >> 2, c = lane & 15, g = lane >> 4;
    const size_t tok0 = (size_t)b * SEQ + ck * 64;
    const size_t qo = (tok0 + 16 * tb + c) * 256 + h * 64 + 8 * g;
    const bf16x8 qf0 = ld16(GP + qo), qf1 = ld16(GP + qo + 32), qb0 = ld16(GP + 2 * AS + qo), qb1 = ld16(GP + 2 * AS + qo + 32);
    bf16x8 kfr[8], kbr[8];
#pragma unroll
    for (int i = 0; i < 8; ++i) {
        const size_t ko = (tok0 + 16 * (i >> 1) + c) * 256 + h * 64 + 8 * g + 32 * (i & 1);
        kfr[i] = ld16(GP + AS + ko); kbr[i] = ld16(GP + 3 * AS + ko);
    }
    const bf16* sf = SBEF + ((size_t)(bh * 64 + ck) * 128 + c) * 64 + 8 * g;
    const bf16* sbk = SBEF + ((size_t)((32 + bh) * 64 + ck) * 128 + c) * 64 + 8 * g;
    const bf16* vt = VT + ((size_t)((tok0 >> 3) + (g >> 1)) * 1024 + 512 + h * 128 + c) * 8 + 4 * (g & 1);
    u32x2 vv[2][8]; bf16x8 sv[2][8];
#define GO_LOAD(buf, eb0) do { _Pragma("unroll") for (int e_ = 0; e_ < 2; ++e_) { const bf16* v_ = vt + 128 * ((eb0) + e_); \
        vv[buf][4 * e_ + 0] = *(const u32x2*)(v_); vv[buf][4 * e_ + 1] = *(const u32x2*)(v_ + 16384); vv[buf][4 * e_ + 2] = *(const u32x2*)(v_ + 32768); vv[buf][4 * e_ + 3] = *(const u32x2*)(v_ + 49152); \
        sv[buf][4 * e_ + 0] = ld16(sf + ((eb0) + e_) * 1024); sv[buf][4 * e_ + 1] = ld16(sf + ((eb0) + e_) * 1024 + 32); sv[buf][4 * e_ + 2] = ld16(sbk + ((eb0) + e_) * 1024); sv[buf][4 * e_ + 3] = ld16(sbk + ((eb0) + e_) * 1024 + 32); } } while (0)
    GO_LOAD(0, 0);
    SCHED_FENCE();
    f32x4 at[4];
#pragma unroll
    for (int sb = 0; sb < 4; ++sb) {
        f32x4 f = {0.f, 0.f, 0.f, 0.f}, bk = {0.f, 0.f, 0.f, 0.f};
        f = mfma16(kfr[2 * sb], qf0, f); f = mfma16(kfr[2 * sb + 1], qf1, f);
        bk = mfma16(kbr[2 * sb], qb0, bk); bk = mfma16(kbr[2 * sb + 1], qb1, bk);
#pragma unroll
        for (int i = 0; i < 4; ++i) at[sb][i] = (16 * sb + 4 * g + i <= 16 * tb + c) ? f[i] : bk[i];
    }
    const bf16x8 p0 = pack8(at[0], at[1]), p1 = pack8(at[2], at[3]);
    SCHED_FENCE();
    f32x4 o[8]; float ss = 0.f;
#pragma unroll
    for (int bp = 0; bp < 4; ++bp) {
        if (bp < 3) GO_LOAD((bp + 1) & 1, 2 * bp + 2);
        SCHED_FENCE();
#pragma unroll
        for (int e = 0; e < 2; ++e) {
            f32x4 acc = {0.f, 0.f, 0.f, 0.f};
            const u32x2 v0 = vv[bp & 1][4 * e], v1 = vv[bp & 1][4 * e + 1], v2 = vv[bp & 1][4 * e + 2], v3 = vv[bp & 1][4 * e + 3];
            u32x4 a0; a0.x = v0.x; a0.y = v0.y; a0.z = v1.x; a0.w = v1.y; u32x4 a1; a1.x = v2.x; a1.y = v2.y; a1.z = v3.x; a1.w = v3.y;
            acc = mfma16(__builtin_bit_cast(bf16x8, a0), p0, acc); acc = mfma16(__builtin_bit_cast(bf16x8, a1), p1, acc);
            acc = mfma16(sv[bp & 1][4 * e], qf0, acc); acc = mfma16(sv[bp & 1][4 * e + 1], qf1, acc);
            acc = mfma16(sv[bp & 1][4 * e + 2], qb0, acc); acc = mfma16(sv[bp & 1][4 * e + 3], qb1, acc);
            o[2 * bp + e] = acc; ss += (acc[0] * acc[0] + acc[1] * acc[1]) + (acc[2] * acc[2] + acc[3] * acc[3]);
        }
        SCHED_FENCE();
    }
#undef GO_LOAD
    ss += __shfl_xor(ss, 16); ss += __shfl_xor(ss, 32);
    const float rstd = rsqrtf(ss * (1.0f / 128.0f) + EPS);
    const float* gain = INP(13) + l * 128 + 4 * g;
    const size_t tok = tok0 + 16 * tb + c;
#pragma unroll
    for (int eb = 0; eb < 8; ++eb) {
        const f32x4 gn = *(const f32x4*)(gain + 16 * eb);
        const u32x2 gr = *(const u32x2*)(GR + tok * 512 + h * 128 + 16 * eb + 4 * g);
        const float r0 = bflo(gr.x), r1 = bfhi(gr.x), r2 = bflo(gr.y), r3 = bfhi(gr.y);
        u32x2 w; w.x = pk2(o[eb][0] * rstd * gn[0] * silu_f(r0), o[eb][1] * rstd * gn[1] * silu_f(r1)); w.y = pk2(o[eb][2] * rstd * gn[2] * silu_f(r2), o[eb][3] * rstd * gn[3] * silu_f(r3));
        *(u32x2*)(MIX + tok * 1024 + 512 + h * 128 + 16 * eb + 4 * g) = w;
    }
}

constexpr int GO_KF = 0, GO_KB = 9216, GO_VT = 18432, GO_SF = 34816, GO_SB = 53248, GO_ITEM = 71680;
struct GoStage { u32x4 r[16]; bf16x8 q[4]; };
DI void go_gload(GoStage& st, int item, int t256, int tb, int lane) {
    unsigned char* R = WSP() + WS_R;
    const bf16* VT = (const bf16*)(R + R_VT); const bf16* GP = (const bf16*)(R + R_GP); const bf16* SBEF = (const bf16*)(R + R_SBEF);
    const size_t AS = (size_t)M * 256;
    const int ck = item & 63, bh = item >> 6, h = bh & 3, b = bh >> 2;
    const size_t tok0 = (size_t)b * SEQ + ck * 64;
#pragma unroll
    for (int j = 0; j < 16; ++j) {
        const int q = t256 + 256 * (j & 3);
        const bf16* src;
        if (j < 2)       { const int qq = t256 + 256 * j;       src = GP + AS + (tok0 + (qq >> 3)) * 256 + h * 64 + (qq & 7) * 8; }
        else if (j < 4)  { const int qq = t256 + 256 * (j - 2); src = GP + 3 * AS + (tok0 + (qq >> 3)) * 256 + h * 64 + (qq & 7) * 8; }
        else if (j < 8)  { src = VT + ((size_t)((tok0 >> 3) + (q >> 7)) * 1024 + 512 + h * 128 + (q & 127)) * 8; }
        else if (j < 12) { src = SBEF + (size_t)(bh * 64 + ck) * 8192 + q * 8; }
        else             { src = SBEF + (size_t)((32 + bh) * 64 + ck) * 8192 + q * 8; }
        st.r[j] = *(const u32x4*)src;
    }
    const size_t qo = (tok0 + 16 * tb + (lane & 15)) * 256 + h * 64 + 8 * (lane >> 4);
    st.q[0] = ld16(GP + qo); st.q[1] = ld16(GP + qo + 32); st.q[2] = ld16(GP + 2 * AS + qo); st.q[3] = ld16(GP + 2 * AS + qo + 32);
}
DI void go_lwrite(const GoStage& st, unsigned char* base, int t256) {
#pragma unroll
    for (int j = 0; j < 16; ++j) {
        const int q = t256 + 256 * (j & 3); unsigned char* dst;
        if (j < 2)       { const int qq = t256 + 256 * j;       dst = base + GO_KF + (qq >> 3) * 144 + (qq & 7) * 16; }
        else if (j < 4)  { const int qq = t256 + 256 * (j - 2); dst = base + GO_KB + (qq >> 3) * 144 + (qq & 7) * 16; }
        else if (j < 8)  { dst = base + GO_VT + q * 16; }
        else if (j < 12) { dst = base + GO_SF + (q >> 3) * 144 + (q & 7) * 16; }
        else             { dst = base + GO_SB + (q >> 3) * 144 + (q & 7) * 16; }
        *(u32x4*)dst = st.r[j];
    }
}
DI void go_compute(int l, const unsigned char* base, const bf16x8 (&qq)[4], int item, int tb, int lane) {
    unsigned char* R = WSP() + WS_R;
    const bf16* GR = (const bf16*)(R + R_GR); bf16* MIX = (bf16*)(R + R_MIX);
    const int ck = item & 63, bh = item >> 6, h = bh & 3, b = bh >> 2, c = lane & 15, g = lane >> 4;
    const size_t tok0 = (size_t)b * SEQ + ck * 64;
    const bf16x8 qf0 = qq[0], qf1 = qq[1], qb0 = qq[2], qb1 = qq[3];
    f32x4 at[4];
#pragma unroll
    for (int sb = 0; sb < 4; ++sb) {
        const unsigned char* kf = base + GO_KF + (16 * sb + c) * 144 + g * 16; const unsigned char* kb = base + GO_KB + (16 * sb + c) * 144 + g * 16;
        f32x4 f = {0.f, 0.f, 0.f, 0.f}, bk = {0.f, 0.f, 0.f, 0.f};
        f = mfma16(*(const bf16x8*)kf, qf0, f); f = mfma16(*(const bf16x8*)(kf + 64), qf1, f);
        bk = mfma16(*(const bf16x8*)kb, qb0, bk); bk = mfma16(*(const bf16x8*)(kb + 64), qb1, bk);
#pragma unroll
        for (int i = 0; i < 4; ++i) at[sb][i] = (16 * sb + 4 * g + i <= 16 * tb + c) ? f[i] : bk[i];
    }
    const bf16x8 p0 = pack8(at[0], at[1]), p1 = pack8(at[2], at[3]);
    f32x4 o[8]; float ss = 0.f;
#pragma unroll
    for (int eb = 0; eb < 8; ++eb) {
        const unsigned char* vp = base + GO_VT + (g >> 1) * 2048 + (16 * eb + c) * 16 + (g & 1) * 8;
        const u32x2 v0 = *(const u32x2*)vp, v1 = *(const u32x2*)(vp + 4096), v2 = *(const u32x2*)(vp + 8192), v3 = *(const u32x2*)(vp + 12288);
        u32x4 a0; a0.x = v0.x; a0.y = v0.y; a0.z = v1.x; a0.w = v1.y; u32x4 a1; a1.x = v2.x; a1.y = v2.y; a1.z = v3.x; a1.w = v3.y;
        const unsigned char* sfp = base + GO_SF + (16 * eb + c) * 144 + g * 16; const unsigned char* sbp = base + GO_SB + (16 * eb + c) * 144 + g * 16;
        f32x4 acc = {0.f, 0.f, 0.f, 0.f};
        acc = mfma16(__builtin_bit_cast(bf16x8, a0), p0, acc); acc = mfma16(__builtin_bit_cast(bf16x8, a1), p1, acc);
        acc = mfma16(*(const bf16x8*)sfp, qf0, acc); acc = mfma16(*(const bf16x8*)(sfp + 64), qf1, acc);
        acc = mfma16(*(const bf16x8*)sbp, qb0, acc); acc = mfma16(*(const bf16x8*)(sbp + 64), qb1, acc);
        o[eb] = acc; ss += (acc[0] * acc[0] + acc[1] * acc[1]) + (acc[2] * acc[2] + acc[3] * acc[3]);
    }
    ss += __shfl_xor(ss, 16); ss += __shfl_xor(ss, 32);
    const float rstd = rsqrtf(ss * (1.0f / 128.0f) + EPS);
    const float* gain = INP(13) + l * 128 + 4 * g;
    const size_t tok = tok0 + 16 * tb + c;
#pragma unroll
    for (int eb = 0; eb < 8; ++eb) {
        const f32x4 gn = *(const f32x4*)(gain + 16 * eb);
        const u32x2 gr = *(const u32x2*)(GR + tok * 512 + h * 128 + 16 * eb + 4 * g);
        const float r0 = bflo(gr.x), r1 = bfhi(gr.x), r2 = bflo(gr.y), r3 = bfhi(gr.y);
        u32x2 w; w.x = pk2(o[eb][0] * rstd * gn[0] * silu_f(r0), o[eb][1] * rstd * gn[1] * silu_f(r1)); w.y = pk2(o[eb][2] * rstd * gn[2] * silu_f(r2), o[eb][3] * rstd * gn[3] * silu_f(r3));
        *(u32x2*)(MIX + tok * 1024 + 512 + h * 128 + 16 * eb + 4 * g) = w;
    }
}
DI int go_item(bool xl, int xq, int k, int half) { const int idx = 2 * k + half; return xl ? ((((xq << 2) | (idx >> 6)) << 6) | (idx & 63)) : idx; }
DI void gla_out_phase(int l, unsigned char* ldsb, int tid, int wave, int lane, bool xl, int xq, int k0, int kend, int kstep) {
    const int half = wave >> 2, tb = wave & 3, t256 = tid & 255;
    unsigned char* base = ldsb + half * GO_ITEM;
    if (k0 >= kend) return;
    GoStage st; go_gload(st, go_item(xl, xq, k0, half), t256, tb, lane);
    for (int k = k0; k < kend; k += kstep) {
        go_lwrite(st, base, t256);
        bf16x8 qq[4] = {st.q[0], st.q[1], st.q[2], st.q[3]};
        __syncthreads();
        if (k + kstep < kend) go_gload(st, go_item(xl, xq, k + kstep, half), t256, tb, lane);
        SCHED_FENCE();
        go_compute(l, base, qq, go_item(xl, xq, k, half), tb, lane);
        __syncthreads();
    }
}

DI void na_stage_rpb(int l, float* rpbs, int tid) {
    const float* rpb = INP(7) + (size_t)l * 8 * 465;
    for (int i = tid; i < 8 * 465; i += NWAVES * 64) rpbs[i] = rpb[i];
    __syncthreads();
}
DI void na_item(const Args& A, int l, float* nss, const float* rpbs, int item, int h, int lane) {
    unsigned char* R = WSP() + WS_R;
    const bf16* QK = (const bf16*)(R + R_QKNA); const bf16* VT = (const bf16*)(R + R_VT); bf16* MIX = (bf16*)(R + R_MIX);
    const float* rpb = rpbs + h * 465;
    const int c = lane & 15, g = lane >> 4;
    const int j = item & 3, r = (item >> 2) & 63, b = item >> 8;
    const int rs = min(max(r - 4, 0), 56), c0 = min(max(16 * j - 8, 0), 32);
    const size_t tokq = (size_t)b * SEQ + r * 64 + 16 * j + c;
    const bf16x8 q0 = ld16(QK + tokq * 1024 + h * 64 + 8 * g), q1 = ld16(QK + tokq * 1024 + h * 64 + 32 + 8 * g);
    const bf16* kbase = QK + ((size_t)b * SEQ + rs * 64 + c0 + c) * 1024 + 512 + h * 64 + 8 * g;
    const bf16* vbase = VT + ((size_t)((b * SEQ + rs * 64 + c0 + 4 * g) >> 3) * 1024 + h * 64 + c) * 8 + 4 * (g & 1);
    f32x4 st[8][2];
    bf16x8 kf[2][16];
#pragma unroll
    for (int bb = 0; bb < 2; ++bb)
#pragma unroll
        for (int i = 0; i < 16; ++i) kf[bb][i] = ld16(kbase + (size_t)(4 * bb + (i >> 2)) * 65536 + ((i >> 1) & 1) * 16384 + (i & 1) * 32);
    SCHED_FENCE();
    u32x2 vf[2][16];
#pragma unroll
    for (int bb = 0; bb < 2; ++bb) {
#pragma unroll
        for (int t = 0; t < 8; ++t) {
            f32x4 s = {0.f, 0.f, 0.f, 0.f}; s = mfma16(kf[bb][2 * t], q0, s); s = mfma16(kf[bb][2 * t + 1], q1, s); st[4 * bb + (t >> 1)][t & 1] = s;
        }
        SCHED_FENCE();
        if (bb == 0) {
#pragma unroll
            for (int i = 0; i < 16; ++i) vf[0][i] = *(const u32x2*)(vbase + (size_t)(i >> 3) * 65536 + 128 * ((i >> 1) & 3) + (i & 1) * 16384);
            SCHED_FENCE();
        }
    }
    const int qc = 16 * j + c, cs = min(max(qc - 8, 0), 48);
    float mx = -3.0e38f;
#pragma unroll
    for (int w = 0; w < 8; ++w) {
        const float* rp = rpb + (rs + w - r + 7) * 31;
#pragma unroll
        for (int hf = 0; hf < 2; ++hf)
#pragma unroll
            for (int i = 0; i < 4; ++i) {
                const int kc = c0 + 16 * hf + 4 * g + i; const bool valid = (kc >= cs) && (kc < cs + 16);
                const int dc = min(max(kc - qc + 15, 0), 30);
                const float bv = rp[dc];
                const float s = valid ? st[w][hf][i] * 0.125f + bv : -1.0e30f;
                st[w][hf][i] = s; mx = fmaxf(mx, s);
            }
    }
    mx = fmaxf(mx, __shfl_xor(mx, 16)); mx = fmaxf(mx, __shfl_xor(mx, 32));
    float sum = 0.f;
#pragma unroll
    for (int w = 0; w < 8; ++w)
#pragma unroll
        for (int hf = 0; hf < 2; ++hf)
#pragma unroll
            for (int i = 0; i < 4; ++i) { const float p = __expf(st[w][hf][i] - mx); st[w][hf][i] = p; sum += p; }
    sum += __shfl_xor(sum, 16); sum += __shfl_xor(sum, 32);
    f32x4 o[4];
#pragma unroll
    for (int db = 0; db < 4; ++db) o[db] = (f32x4){0.f, 0.f, 0.f, 0.f};
#pragma unroll
    for (int wp = 0; wp < 4; ++wp) {
        if (wp < 3) {
#pragma unroll
            for (int i = 0; i < 16; ++i) vf[(wp + 1) & 1][i] = *(const u32x2*)(vbase + (size_t)(2 * wp + 2 + (i >> 3)) * 65536 + 128 * ((i >> 1) & 3) + (i & 1) * 16384);
        }
        SCHED_FENCE();
#pragma unroll
        for (int ww = 0; ww < 2; ++ww) {
            const bf16x8 p = pack8(st[2 * wp + ww][0], st[2 * wp + ww][1]);
#pragma unroll
            for (int db = 0; db < 4; ++db) {
                const u32x2 lo = vf[wp & 1][8 * ww + 2 * db], hi = vf[wp & 1][8 * ww + 2 * db + 1];
                u32x4 v; v.x = lo.x; v.y = lo.y; v.z = hi.x; v.w = hi.y;
                o[db] = mfma16(__builtin_bit_cast(bf16x8, v), p, o[db]);
            }
        }
        SCHED_FENCE();
    }
    const float inv = 1.0f / sum; float ss = 0.f;
#pragma unroll
    for (int db = 0; db < 4; ++db) { o[db] = o[db] * inv; ss += (o[db][0] * o[db][0] + o[db][1] * o[db][1]) + (o[db][2] * o[db][2] + o[db][3] * o[db][3]); }
    ss += __shfl_xor(ss, 16); ss += __shfl_xor(ss, 32);
    if (g == 0) nss[h * 16 + c] = ss;
    __syncthreads();
    float tot = 0.f;
#pragma unroll
    for (int hh = 0; hh < 8; ++hh) tot += nss[hh * 16 + c];
    const float rstd = rsqrtf(tot * (1.0f / 512.0f) + EPS);
    const float* gain = INP(8) + l * 512 + h * 64 + 4 * g;
#pragma unroll
    for (int db = 0; db < 4; ++db) {
        const f32x4 gn = *(const f32x4*)(gain + 16 * db);
        u32x2 w; w.x = pk2(o[db][0] * rstd * gn[0], o[db][1] * rstd * gn[1]); w.y = pk2(o[db][2] * rstd * gn[2], o[db][3] * rstd * gn[3]);
        *(u32x2*)(MIX + tokq * 1024 + h * 64 + 16 * db + 4 * g) = w;
    }
    __syncthreads();
}

struct NaKV { bf16x8 k[4]; u32x2 v[8]; };
DI NaKV na_load_kv(const bf16* kbase, const bf16* vbase, int krel) {
    NaKV f;
#pragma unroll
    for (int i = 0; i < 4; ++i) f.k[i] = ld16(kbase + (size_t)krel * 65536 + (i >> 1) * 16384 + (i & 1) * 32);
#pragma unroll
    for (int i = 0; i < 8; ++i) f.v[i] = *(const u32x2*)(vbase + (size_t)krel * 65536 + 128 * (i >> 1) + (i & 1) * 16384);
    return f;
}
DI void na_pair(const NaKV& f, bf16x8 q0, bf16x8 q1, const float* rp  , const int (&dcv)[8], unsigned vmask, float& m, float& l, f32x4 (&o)[4]) {
    f32x4 s0 = {0.f, 0.f, 0.f, 0.f}, s1 = {0.f, 0.f, 0.f, 0.f};
    s0 = mfma16(f.k[0], q0, s0); s0 = mfma16(f.k[1], q1, s0);
    s1 = mfma16(f.k[2], q0, s1); s1 = mfma16(f.k[3], q1, s1);
    float sv[8]; float mx = -1.0e30f;
#pragma unroll
    for (int e = 0; e < 8; ++e) {
        const float raw = e < 4 ? s0[e] : s1[e - 4];
        const float bv = rp[dcv[e]];
        sv[e] = ((vmask >> e) & 1u) ? raw * 0.125f + bv : -1.0e30f;
        mx = fmaxf(mx, sv[e]);
    }
    mx = fmaxf(mx, __shfl_xor(mx, 16)); mx = fmaxf(mx, __shfl_xor(mx, 32));
    const float mn = fmaxf(m, mx), alpha = __expf(m - mn); m = mn;
    float ps = 0.f; f32x4 p0, p1;
#pragma unroll
    for (int e = 0; e < 4; ++e) { p0[e] = __expf(sv[e] - mn); p1[e] = __expf(sv[4 + e] - mn); ps += p0[e] + p1[e]; }
    l = l * alpha + ps;
    const bf16x8 p = pack8(p0, p1);
#pragma unroll
    for (int db = 0; db < 4; ++db) {
        u32x4 v; v.x = f.v[2 * db].x; v.y = f.v[2 * db].y; v.z = f.v[2 * db + 1].x; v.w = f.v[2 * db + 1].y;
        o[db] = mfma16(__builtin_bit_cast(bf16x8, v), p, o[db] * alpha);
    }
}
DI void na_strip(const Args& A, int l, float* nss, const float* rpbs, int item, int h, int lane) {
    unsigned char* R = WSP() + WS_R;
    const bf16* QK = (const bf16*)(R + R_QKNA); const bf16* VT = (const bf16*)(R + R_VT); bf16* MIX = (bf16*)(R + R_MIX);
    const float* rpb = rpbs + h * 465;
    const int c = lane & 15, g = lane >> 4;
    const int j = item & 3, r0 = ((item >> 2) & 15) * 4, b = item >> 6;
    const int c0 = min(max(16 * j - 8, 0), 32);
    const int kmin = min(max(r0 - 4, 0), 56), kmax = min(max(r0 + 3 - 4, 0), 56) + 7, nrows = kmax - kmin + 1;
    const int qc = 16 * j + c, cs = min(max(qc - 8, 0), 48);
    int dcv[8]; unsigned vmask = 0u;
#pragma unroll
    for (int e = 0; e < 8; ++e) { const int kc = c0 + 16 * (e >> 2) + 4 * g + (e & 3); if (kc >= cs && kc < cs + 16) vmask |= 1u << e; dcv[e] = min(max(kc - qc + 15, 0), 30); }
    bf16x8 q0[4], q1[4];
#pragma unroll
    for (int i = 0; i < 4; ++i) { const bf16* qp = QK + ((size_t)b * SEQ + (r0 + i) * 64 + 16 * j + c) * 1024 + h * 64 + 8 * g; q0[i] = ld16(qp); q1[i] = ld16(qp + 32); }
    const bf16* kbase = QK + ((size_t)b * SEQ + kmin * 64 + c0 + c) * 1024 + 512 + h * 64 + 8 * g;
    const bf16* vbase = VT + ((size_t)((b * SEQ + kmin * 64 + c0 + 4 * g) >> 3) * 1024 + h * 64 + c) * 8 + 4 * (g & 1);
    float m[4], ls[4]; f32x4 o[4][4];
#pragma unroll
    for (int i = 0; i < 4; ++i) { m[i] = -1.0e30f; ls[i] = 0.f;
#pragma unroll
        for (int db = 0; db < 4; ++db) o[i][db] = (f32x4){0.f, 0.f, 0.f, 0.f}; }
    int rs[4];
#pragma unroll
    for (int i = 0; i < 4; ++i) rs[i] = min(max(r0 + i - 4, 0), 56);
#define NA_ROW(F, KR) do { _Pragma("unroll") for (int i_ = 0; i_ < 4; ++i_) { if ((KR) >= rs[i_] && (KR) <= rs[i_] + 7) na_pair(F, q0[i_], q1[i_], rpb + ((KR) - (r0 + i_) + 7) * 31, dcv, vmask, m[i_], ls[i_], o[i_]); } } while (0)
    NaKV fa = na_load_kv(kbase, vbase, 0), fb;
#pragma unroll 1
    for (int t = 0; t < nrows; t += 2) {
        fb = na_load_kv(kbase, vbase, min(t + 1, nrows - 1));
        SCHED_FENCE();
        NA_ROW(fa, kmin + t);
        SCHED_FENCE();
        fa = na_load_kv(kbase, vbase, min(t + 2, nrows - 1));
        SCHED_FENCE();
        if (t + 1 < nrows) NA_ROW(fb, kmin + t + 1);
        SCHED_FENCE();
    }
#undef NA_ROW
    float ssv[4];
#pragma unroll
    for (int i = 0; i < 4; ++i) {
        float lt = ls[i]; lt += __shfl_xor(lt, 16); lt += __shfl_xor(lt, 32);
        const float inv = 1.0f / lt; float ss = 0.f;
#pragma unroll
        for (int db = 0; db < 4; ++db) { o[i][db] = o[i][db] * inv; ss += (o[i][db][0] * o[i][db][0] + o[i][db][1] * o[i][db][1]) + (o[i][db][2] * o[i][db][2] + o[i][db][3] * o[i][db][3]); }
        ss += __shfl_xor(ss, 16); ss += __shfl_xor(ss, 32);
        ssv[i] = ss;
        if (g == 0) nss[(i * 8 + h) * 16 + c] = ss;
    }
    __syncthreads();
    const float* gain = INP(8) + l * 512 + h * 64 + 4 * g;
#pragma unroll
    for (int i = 0; i < 4; ++i) {
        float tot = 0.f;
#pragma unroll
        for (int hh = 0; hh < 8; ++hh) tot += nss[(i * 8 + hh) * 16 + c];
        const float rstd = rsqrtf(tot * (1.0f / 512.0f) + EPS);
        const size_t tokq = (size_t)b * SEQ + (r0 + i) * 64 + 16 * j + c;
#pragma unroll
        for (int db = 0; db < 4; ++db) {
            const f32x4 gn = *(const f32x4*)(gain + 16 * db);
            u32x2 w; w.x = pk2(o[i][db][0] * rstd * gn[0], o[i][db][1] * rstd * gn[1]); w.y = pk2(o[i][db][2] * rstd * gn[2], o[i][db][3] * rstd * gn[3]);
            *(u32x2*)(MIX + tokq * 1024 + h * 64 + 16 * db + 4 * g) = w;
        }
    }
    (void)ssv;
    __syncthreads();
}

#define XB_TMO      128
#define XB_XCNT(j)  (256  + 64 * (j))
#define XB_XSUB(j)  (1280 + 64 * (j))
#define XB_XGEN(j)  (2304 + 64 * (j))
#define XB_TOP      3328
#define XB_TOPGEN   3392
#define XCD_BAR_WORDS 3456
#define XB_SPIN_CAP (1u << 18)

__device__ __forceinline__ unsigned xb_ld(unsigned* p)              { return __hip_atomic_load(p, __ATOMIC_RELAXED, __HIP_MEMORY_SCOPE_AGENT); }
__device__ __forceinline__ unsigned xb_add(unsigned* p, unsigned v) { return __hip_atomic_fetch_add(p, v, __ATOMIC_RELAXED, __HIP_MEMORY_SCOPE_AGENT); }
__device__ __forceinline__ unsigned xb_xcc_id() { return (unsigned)__builtin_amdgcn_s_getreg((3 << 11) | 20) & 0xFu; }
#define XB_SPIN(cond, bar) do { unsigned _sp = 0; while (cond) { __builtin_amdgcn_s_sleep(1); \
    if ((++_sp & 255u) == 0u) { if (xb_ld(&(bar)[XB_TMO])) break; if (_sp > XB_SPIN_CAP) { atomicAdd(&(bar)[XB_TMO], 1u); break; } } } } while (0)

struct XcdBarrier {
    unsigned* bar; unsigned x;
    volatile LAS unsigned* st;
};

__device__ __forceinline__ XcdBarrier xcd_barrier_post(unsigned* bar, volatile LAS unsigned* st) {
    XcdBarrier b; b.bar = bar; b.x = xb_xcc_id(); b.st = st;
    if (threadIdx.x == 0) (void)xb_add(&bar[XB_XCNT(b.x)], 1u);
    return b;
}
__device__ __forceinline__ void xcd_barrier_complete(unsigned* bar, unsigned x, unsigned& nloc, unsigned& nx) {
    const unsigned G = gridDim.x * gridDim.y * gridDim.z;
    unsigned sum, cnt, mine, sp = 0u;
    for (;;) {
        sum = 0u; cnt = 0u; mine = 0u;
#pragma unroll
        for (unsigned j = 0; j < 16; ++j) { const unsigned c = xb_ld(&bar[XB_XCNT(j)]); sum += c; cnt += (c > 0u) ? 1u : 0u; mine = (j == x) ? c : mine; }
        if (sum == G) break;
        __builtin_amdgcn_s_sleep(1);
        if ((++sp & 255u) == 0u) { if (xb_ld(&bar[XB_TMO])) break; if (sp > XB_SPIN_CAP) { atomicAdd(&bar[XB_TMO], 1u); break; } }
    }
    nloc = mine > 0u ? mine : 1u; nx = cnt > 0u ? cnt : 1u;
}

__device__ __forceinline__ void xcd_barrier(const XcdBarrier& b) {
    asm volatile("s_waitcnt vmcnt(0)" ::: "memory");
    __syncthreads();
    if (threadIdx.x == 0) {
        unsigned* bar = b.bar;
        __builtin_amdgcn_s_waitcnt(0);
        unsigned nloc = b.st[0], nx = b.st[1];
        if (nloc == 0u) { xcd_barrier_complete(bar, b.x, nloc, nx); b.st[0] = nloc; b.st[1] = nx; }
        const unsigned old = xb_add(&bar[XB_XSUB(b.x)], 1u);
        const unsigned gen = old / nloc;
        if (old + 1u == (gen + 1u) * nloc) {
            __builtin_amdgcn_fence(__ATOMIC_RELEASE, "agent");
            asm volatile("s_waitcnt vmcnt(0)" ::: "memory");
            const unsigned og = xb_add(&bar[XB_TOP], 1u);
            const unsigned tg = og / nx;
            if (og + 1u == (tg + 1u) * nx) xb_add(&bar[XB_TOPGEN], 1u);
            else XB_SPIN(xb_ld(&bar[XB_TOPGEN]) == tg, bar);
            __builtin_amdgcn_fence(__ATOMIC_ACQUIRE, "agent");
            xb_add(&bar[XB_XGEN(b.x)], 1u);
            asm volatile("s_waitcnt vmcnt(0)" ::: "memory");
        } else {
            XB_SPIN(xb_ld(&bar[XB_XGEN(b.x)]) == gen, bar);
            __builtin_amdgcn_fence(__ATOMIC_ACQUIRE, "agent");
            asm volatile("s_waitcnt vmcnt(0)" ::: "memory");
        }
    }
    __syncthreads();
}

#define XL_SUB(j) (3456 + 64 * (j))
#define XL_GEN(j) (4480 + 64 * (j))
__device__ __forceinline__ void xcd_local_barrier(unsigned* bar, unsigned x, unsigned nloc) {
    asm volatile("s_waitcnt vmcnt(0)" ::: "memory");
    __syncthreads();
    if (threadIdx.x == 0) {
        const unsigned old = xb_add(&bar[XL_SUB(x)], 1u); const unsigned gen = old / nloc;
        if (old + 1u == (gen + 1u) * nloc) xb_add(&bar[XL_GEN(x)], 1u);
        else XB_SPIN(xb_ld(&bar[XL_GEN(x)]) == gen, bar);
        __builtin_amdgcn_fence(__ATOMIC_ACQUIRE, "agent");
        asm volatile("s_waitcnt vmcnt(0)" ::: "memory");
    }
    __syncthreads();
}
#ifndef REP_PRO
#define REP_PRO 1
#define REP_SYNC 1
#define REP_GEMM 1
#define REP_PREP 1
#define REP_SCAN 1
#define REP_OUT 1
#define REP_NA 1
#endif
#define LAUNDER_TID int t_ = threadIdx.x; asm volatile("" : "+v"(t_)); const int tid = t_, lane = t_ & 63, wave = __builtin_amdgcn_readfirstlane(t_ >> 6); (void)tid; (void)lane; (void)wave;
#define GSYNC() do { for (int r_ = 0; r_ < REP_SYNC; ++r_) xcd_barrier(xbar); } while (0)
#define LSYNC() do { for (int r_ = 0; r_ < REP_SYNC; ++r_) { if (xl) xcd_local_barrier(xbar.bar, xbar.x, (unsigned)(G >> 3)); else xcd_barrier(xbar); } } while (0)
__global__ void __launch_bounds__(NWAVES * 64, 2) fwd_megakernel(Args A) {
    extern __shared__ __attribute__((aligned(16))) unsigned char lds[];
    cg::grid_group grid = cg::this_grid();
    const int G = gridDim.x, bx = blockIdx.x;
    LAS unsigned char* ldsg = (LAS unsigned char*)lds;
    unsigned char* ws = WSP(); unsigned char* R = ws + WS_R;
    bf16* XB = (bf16*)(ws + WS_XB); float* SSQ = (float*)(ws + WS_SSQ); float* X = OUTP();
    bf16* H = (bf16*)(R + R_H); bf16* MIX = (bf16*)(R + R_MIX);

    if (threadIdx.x < 16) ((volatile LAS unsigned*)(ldsg + (LDS_BYTES - 128)))[threadIdx.x] = 0u;
    __syncthreads();
    volatile LAS unsigned* ldsw = (volatile LAS unsigned*)(ldsg + (LDS_BYTES - 128));
    XcdBarrier xbar; xbar.bar = (unsigned*)ws; xbar.x = xb_xcc_id(); xbar.st = ldsw;
    if (threadIdx.x == 0) ldsw[4] = xb_add(&xbar.bar[XB_XCNT(xbar.x)], 1u);
    for (int rep = 0; rep < REP_PRO; ++rep) { LAUNDER_TID prologue(A, lds, wave, lane); }
    if (G > (1 << 20)) grid.sync();
    xcd_barrier(xbar);
    if (threadIdx.x == 0) {
        bool ok = (G % 8 == 0);
        for (unsigned j = 0; j < 16; ++j) { const unsigned cn = xb_ld(&xbar.bar[XB_XCNT(j)]); ok = ok && (cn == (j < 8 ? (unsigned)(G / 8) : 0u)); }
        ldsw[5] = ok ? (xbar.x + 8u * ldsw[4]) : (unsigned)bx; ldsw[6] = ok ? 1u : 0u;
    }
    __syncthreads();
    const int vcu = __builtin_amdgcn_readfirstlane((int)ldsw[5]);
    const bool xl = __builtin_amdgcn_readfirstlane((int)ldsw[6]) != 0;
    const int xq = vcu & 7, rk = vcu >> 3, nl = G >> 3;

#pragma unroll 1
    for (int l = 0; l < 2; ++l) {
        unsigned char* wb = ws + WS_W + (size_t)l * WL;
        for (int rep = 0; rep < REP_GEMM; ++rep) {
            pg8::Gemm gm{XB, (const bf16*)(wb + OW_GU1), M, 2 * DFF, DM}; pg8::StaticOrder S; S.init(M, 2 * DFF, G, vcu);
            EpiSwiGLU E{H, SSQ};
            pg8::gemm_phase<EpiSwiGLU, pg8::StaticOrder, true, true>(ldsg, gm, S, E);
        }
        LSYNC();
        for (int rep = 0; rep < REP_GEMM; ++rep) {
            pg8::Gemm gm{H, (const bf16*)(wb + OW_D1), M, DM, DFF}; pg8::StaticOrder S; S.init(M, DM, G, vcu);
            EpiResid E{(l == 0 && rep == 0) ? INP(0) : (const float*)nullptr, XB, SSQ, rep == 0 ? 0.5f : 0.f};
            pg8::gemm_phase<EpiResid, pg8::StaticOrder, true, true>(ldsg, gm, S, E);
        }
        GSYNC();
        for (int rep = 0; rep < REP_GEMM; ++rep) {
            pg8::Gemm gm{XB, (const bf16*)(wb + OW_INA), M, 2304, DM}; pg8::StaticOrder S; S.init(M, 2304, G, vcu);
            EpiProj E{(bf16*)(R + R_QKNA), (bf16*)(R + R_GQK), (bf16*)(R + R_GR), (bf16*)(R + R_CODES), SSQ};
            pg8::gemm_phase<EpiProj, pg8::StaticOrder, true, true>(ldsg, gm, S, E);
            pg8::Gemm gv{(const bf16*)(wb + OW_INB), XB, 1024, M, DM}; pg8::StaticOrder S2; S2.init(1024, M, G, vcu);
            EpiVT E2{(bf16*)(R + R_VT), SSQ};
            pg8::gemm_phase<EpiVT, pg8::StaticOrder, true, true>(ldsg, gv, S2, E2);
        }
        LSYNC();
        for (int rep = 0; rep < REP_PREP; ++rep) { LAUNDER_TID int ph_ = -1; for (int k = xl ? rk : vcu; k < (xl ? 256 : 2048); k += (xl ? nl : G)) { const int it = xl ? ((((xq << 2) | (k >> 6)) << 6) | (k & 63)) : k; const int h_ = (it >> 6) & 3; gla_prep_item(A, l, lds, it, tid, h_ != ph_); ph_ = h_; } }
        LSYNC();
        for (int rep = 0; rep < REP_SCAN; ++rep) { LAUNDER_TID for (int k = xl ? rk : vcu; k < (xl ? 32 : 256); k += (xl ? nl : G)) gla_scan_item(A, xl ? ((((k >> 4) * 32 + xq * 4 + ((k >> 2) & 3)) << 2) | (k & 3)) : k, wave, lane); }
        GSYNC();
        for (int rep = 0; rep < REP_OUT; ++rep) { LAUNDER_TID gla_out_phase(l, lds, tid, wave, lane, xl, xq, xl ? rk : vcu, xl ? 128 : 1024, xl ? nl : G); }
        for (int rep = 0; rep < REP_NA; ++rep) { LAUNDER_TID na_stage_rpb(l, (float*)lds + 512, tid); if (G % 8 == 0) { for (int li = vcu >> 3; li < 64; li += (G >> 3)) na_strip(A, l, (float*)lds, (const float*)lds + 512, ((vcu & 7) << 6) | li, wave, lane); } else { for (int it = vcu; it < 512; it += G) na_strip(A, l, (float*)lds, (const float*)lds + 512, it, wave, lane); } }
        GSYNC();
        for (int rep = 0; rep < REP_GEMM; ++rep) {
            pg8::Gemm gm{MIX, (const bf16*)(wb + OW_OUT), M, DM, DM}; pg8::StaticOrder S; S.init(M, DM, G, vcu);
            EpiResid E{nullptr, XB, SSQ, rep == 0 ? 1.0f : 0.f};
            pg8::gemm_phase<EpiResid, pg8::StaticOrder, true, true>(ldsg, gm, S, E);
        }
        LSYNC();
        for (int rep = 0; rep < REP_GEMM; ++rep) {
            pg8::Gemm gm{XB, (const bf16*)(wb + OW_GU2), M, 2 * DFF, DM}; pg8::StaticOrder S; S.init(M, 2 * DFF, G, vcu);
            EpiSwiGLU E{H, SSQ};
            pg8::gemm_phase<EpiSwiGLU, pg8::StaticOrder, true, true>(ldsg, gm, S, E);
        }
        LSYNC();
        for (int rep = 0; rep < REP_GEMM; ++rep) {
            pg8::Gemm gm{H, (const bf16*)(wb + OW_D2), M, DM, DFF}; pg8::StaticOrder S; S.init(M, DM, G, vcu);
            EpiResid E{nullptr, XB, SSQ, rep == 0 ? 0.5f : 0.f};
            pg8::gemm_phase<EpiResid, pg8::StaticOrder, true, true>(ldsg, gm, S, E);
        }
        LSYNC();
    }
    {
        LAUNDER_TID
        const float* gn = INP(19);
        const int gw = vcu * NWAVES + wave, NGW = G * NWAVES;
        for (int m = xl ? xq * 4096 + rk * NWAVES + wave : gw; m < (xl ? (xq + 1) * 4096 : M); m += (xl ? nl * NWAVES : NGW)) {
            float s = lane < 16 ? SSQ[(size_t)m * 16 + lane] : 0.f; s = wave_sum(s);
            const float rstd = rsqrtf(s * (1.0f / DM) + EPS);
            f32x4* xr = (f32x4*)(X + (size_t)m * DM) + lane; const f32x4* gr = (const f32x4*)gn + lane; const u32x2* xb = (const u32x2*)(XB + (size_t)m * DM) + lane;
#pragma unroll
            for (int j = 0; j < 4; ++j) { const u32x2 bb = xb[64 * j]; const f32x4 v = {bflo(bb.x), bfhi(bb.x), bflo(bb.y), bfhi(bb.y)}; xr[64 * j] = v * rstd * gr[64 * j]; }
        }
    }
}

extern "C" void kernel_launch(void* const* d_in, const int* in_sizes, int n_in, void* d_out, int out_size, void* d_ws, size_t ws_size, hipStream_t stream) {
    static int grid = 0;
    if (grid == 0) {
        if (n_in != 20 || out_size != M * DM || ws_size < WS_END) { fprintf(stderr, "kernel_launch: unexpected shapes / workspace (n_in %d out %d ws %zu need %zu)\n", n_in, out_size, ws_size, (size_t)WS_END); grid = -1; return; }
        int dev = 0, cus = 0, per_cu = 0;
        hipGetDevice(&dev); hipDeviceGetAttribute(&cus, hipDeviceAttributeMultiprocessorCount, dev);
        hipFuncSetAttribute((const void*)fwd_megakernel, hipFuncAttributeMaxDynamicSharedMemorySize, LDS_BYTES);
        hipOccupancyMaxActiveBlocksPerMultiprocessor(&per_cu, (const void*)fwd_megakernel, NWAVES * 64, LDS_BYTES);
        if (per_cu < 1) per_cu = 1;
        grid = cus * per_cu;
        (void)hipGetLastError();
    }
    if (grid < 0) return;
    Args a{};
    for (int i = 0; i < 20; ++i) a.in[i] = (const float*)d_in[i];
    a.out = (float*)d_out; a.ws = (unsigned char*)d_ws;
    if (hipMemsetAsync(d_ws, 0, 32768, stream) != hipSuccess) { fprintf(stderr, "memset failed\n"); return; }
    void* args[] = {&a};
    hipError_t e = hipLaunchCooperativeKernel((const void*)fwd_megakernel, dim3(grid), dim3(NWAVES * 64), args, LDS_BYTES, stream);
    if (e != hipSuccess) fprintf(stderr, "cooperative launch failed: %s (grid %d)\n", hipGetErrorString(e), grid);
}
```

```cpp
#include <hip/hip_runtime.h>
#include <cstdio>
#include <cstdint>
namespace pg8 {
#define PG8_LAS __attribute__((address_space(3)))
typedef unsigned short bf16_t;
typedef short bf16x8 __attribute__((ext_vector_type(8)));
typedef float f32x4 __attribute__((ext_vector_type(4)));
typedef unsigned u32x4 __attribute__((ext_vector_type(4)));
constexpr int BM = 256, BK = 64, HALF = 128, HTB = HALF * BK * 2  , STAGE_BYTES = 8 * HTB, NXCD = 8, WGM = 8;

__host__ __device__ __forceinline__ int lds_byte(int r, int c) { const int st = (r >> 4) * 2 + (c >> 5), rr = r & 15, cc = c & 31, ob = rr * 64 + cc * 2; return st * 1024 + (ob ^ (((ob >> 9) & 1) << 5)); }
__host__ __device__ __forceinline__ void stage_rc(int b, int& R, int& C) { const int st = b / 1024, sb = b % 1024, swz = sb ^ (((sb >> 9) & 1) << 5); R = (st >> 1) * 16 + swz / 64; C = (st & 1) * 32 + (swz % 64) / 2; }
__host__ __device__ __forceinline__ int perm32(int rho) { const int n = rho >> 4, i = rho & 15; return 8 * (i >> 2) + 4 * n + (i & 3); }

struct Unit { int pm, pn; };
struct Gemm { const bf16_t* A; const bf16_t* Bt; int M, N, K; };

struct StaticOrder {
    int nM, nN, nwg, G, c;
    __host__ __device__ void init(int M, int N, int G_, int c_) { nM = M / BM; nN = N / BM; nwg = nM * nN; G = G_; c = c_; }
    __host__ __device__ bool next(int i, Unit& u) const {
        const long L = (long)i * G + c; if (L >= nwg) return false;
        int wgid = (int)L; { const int q = nwg / NXCD, r = nwg % NXCD, xcd = wgid % NXCD, off = wgid / NXCD; wgid = (xcd < r ? xcd * (q + 1) : r * (q + 1) + (xcd - r) * q) + off; }
        const int nig = WGM * nN, gid = wgid / nig, fm = gid * WGM, gsz = (nM - fm) < WGM ? (nM - fm) : WGM;
        u.pm = fm + ((wgid % nig) % gsz); u.pn = (wgid % nig) / gsz; return true;
    }
    __device__ __forceinline__ void a_ready(const Unit&) const {}
    __device__ __forceinline__ void done(const Unit&) const {}
};

typedef __bf16 bf16x2_cv_t __attribute__((ext_vector_type(2)));
typedef float f32x2_cv_t __attribute__((ext_vector_type(2)));
__device__ __forceinline__ unsigned cvt_pk_bf16(float lo, float hi) { const f32x2_cv_t v = {lo, hi}; const bf16x2_cv_t b = __builtin_convertvector(v, bf16x2_cv_t); return __builtin_bit_cast(unsigned, b); }
typedef float f32x2 __attribute__((ext_vector_type(2)));
template <class Epi, class Sched, bool ALIGN_EPI = false, bool SP2 = false>
__device__ __forceinline__ void gemm_phase(PG8_LAS unsigned char* lds, const Gemm g, const Sched& S, const Epi& E) {
    int tid_ = threadIdx.x; asm volatile("" : "+v"(tid_));
    const int tid = tid_, wid = __builtin_amdgcn_readfirstlane(tid >> 6), lane = tid & 63, wr = wid >> 2, wc = wid & 3, fr = lane & 15, fq = lane >> 4;
    const int K = g.K, nt = K / BK;
    unsigned voffA[2], voffB[2];
#pragma unroll
    for (int i = 0; i < 2; ++i) { int R, C; stage_rc(tid * 16 + i * 8192, R, C); const int Rb = Epi::PERM ? ((R & ~31) + perm32(R & 31)) : R;
        voffA[i] = (unsigned)(R * K + C) * 2u; voffB[i] = (unsigned)(Rb * K + C) * 2u; }
    const size_t kstep = (size_t)(BK * 2);
    const size_t hstep = (size_t)HALF * K * 2;
    const size_t tstep = 2 * hstep;
    const unsigned ldsw = (unsigned)wid * 1024u;
    const int aoff = lds_byte(wr * 64 + fr, fq * 8), boff = lds_byte(wc * 32 + fr, fq * 8);
#define PG8_SA(b, h) (((b) * 2 + (h)) * HTB)
#define PG8_SB(b, h) ((4 + (b) * 2 + (h)) * HTB)
#define PG8_STAGE(bufoff, gbase, voff) do { _Pragma("unroll") for (int _i = 0; _i < 2; ++_i) \
        __builtin_amdgcn_global_load_lds((const unsigned*)((const char*)(gbase) + (voff)[_i]), (PG8_LAS unsigned*)(lds + (bufoff) + ldsw + _i * 8192), 16, 0, 0); } while (0)
#define PG8_LDA(dst, b, h) do { _Pragma("unroll") for (int m = 0; m < 4; ++m) _Pragma("unroll") for (int k = 0; k < 2; ++k) dst[m][k] = *(const PG8_LAS bf16x8*)(lds + PG8_SA(b, h) + aoff + m * 2048 + k * 1024); } while (0)
#define PG8_LDB(dst, b, h) do { _Pragma("unroll") for (int n = 0; n < 2; ++n) _Pragma("unroll") for (int k = 0; k < 2; ++k) dst[n][k] = *(const PG8_LAS bf16x8*)(lds + PG8_SB(b, h) + boff + n * 2048 + k * 1024); } while (0)
#define PG8_MMA(ai, bj, At, Bt) do { __builtin_amdgcn_s_setprio(1); _Pragma("unroll") for (int m = 0; m < 4; ++m) _Pragma("unroll") for (int n = 0; n < 2; ++n) _Pragma("unroll") for (int k = 0; k < 2; ++k) \
        acc[ai][bj][m][n] = __builtin_amdgcn_mfma_f32_16x16x32_bf16(Bt[n][k], At[m][k], acc[ai][bj][m][n], 0, 0, 0); __builtin_amdgcn_s_setprio(0); } while (0)
#define PG8_WAIT_V(n) asm volatile("s_waitcnt vmcnt(" #n ")" ::: "memory")
#define PG8_WAIT_L(n) asm volatile("s_waitcnt lgkmcnt(" #n ")" ::: "memory")
#define PG8_BAR __builtin_amdgcn_s_barrier()
#define PG8_SCHED __builtin_amdgcn_sched_barrier(0)
    Unit cur, nxt; int ui = 0;
    if (!S.next(0, cur)) return;
    f32x4 acc[2][2][4][2];
#pragma unroll
    for (int a = 0; a < 2; ++a)
#pragma unroll
        for (int b = 0; b < 2; ++b)
#pragma unroll
            for (int m = 0; m < 4; ++m)
#pragma unroll
                for (int n = 0; n < 2; ++n) acc[a][b][m][n] = (f32x4){0.f, 0.f, 0.f, 0.f};
    bf16x8 At[4][2], B0[2][2], B1[2][2];
    const char* cA = (const char*)g.A + (size_t)cur.pm * tstep; const char* cB = (const char*)g.Bt + (size_t)cur.pn * tstep;
    S.a_ready(cur);
    if constexpr (SP2) {
        PG8_STAGE(PG8_SB(0, 0), cB, voffB); PG8_STAGE(PG8_SB(0, 1), cB + hstep, voffB); PG8_STAGE(PG8_SA(0, 0), cA, voffA); PG8_STAGE(PG8_SA(0, 1), cA + hstep, voffA);
        if (wr == 1) PG8_BAR;
        PG8_WAIT_V(2); PG8_BAR;
        PG8_STAGE(PG8_SB(1, 0), cB + kstep, voffB); PG8_STAGE(PG8_SA(1, 0), cA + kstep, voffA); PG8_STAGE(PG8_SB(1, 1), cB + hstep + kstep, voffB);
        PG8_WAIT_V(6); PG8_BAR;
    } else {
        PG8_STAGE(PG8_SB(0, 0), cB, voffB); PG8_STAGE(PG8_SA(0, 0), cA, voffA); PG8_STAGE(PG8_SB(0, 1), cB + hstep, voffB); PG8_STAGE(PG8_SA(0, 1), cA + hstep, voffA);
        if (wr == 1) PG8_BAR;
        PG8_WAIT_V(4); PG8_BAR;
        PG8_STAGE(PG8_SB(1, 0), cB + kstep, voffB); PG8_STAGE(PG8_SA(1, 0), cA + kstep, voffA); PG8_STAGE(PG8_SB(1, 1), cB + hstep + kstep, voffB);
        PG8_WAIT_V(6); PG8_BAR;
    }
    for (;;) {
        const bool has_next = S.next(ui + 1, nxt);
        const char* nA = has_next ? (const char*)g.A + (size_t)nxt.pm * tstep : cA; const char* nB = has_next ? (const char*)g.Bt + (size_t)nxt.pn * tstep : cB;
        for (int t = 0; t < nt; t += 2) {
            const bool last = (t == nt - 2);
            const char* a1 = cA + (size_t)(t + 1) * kstep;
            const char* a2 = last ? nA : cA + (size_t)(t + 2) * kstep; const char* b2 = last ? nB : cB + (size_t)(t + 2) * kstep;
            const char* a3 = a2 + kstep; const char* b3 = b2 + kstep;
            if (last && has_next) S.a_ready(nxt);
            if constexpr (SP2) {
            PG8_LDB(B0, 0, 0); PG8_LDB(B1, 0, 1); PG8_SCHED; PG8_LDA(At, 0, 0); PG8_STAGE(PG8_SA(1, 1), a1 + hstep, voffA);
            PG8_WAIT_V(8); PG8_WAIT_L(0); PG8_BAR; PG8_MMA(0, 0, At, B0); PG8_MMA(0, 1, At, B1); PG8_BAR; PG8_SCHED;
            PG8_LDA(At, 0, 1); PG8_STAGE(PG8_SB(0, 0), b2, voffB); PG8_STAGE(PG8_SB(0, 1), b2 + hstep, voffB); PG8_STAGE(PG8_SA(0, 0), a2, voffA);
            PG8_WAIT_V(8); PG8_WAIT_L(0); PG8_BAR; PG8_MMA(1, 0, At, B0); PG8_MMA(1, 1, At, B1); PG8_BAR; PG8_SCHED;
            PG8_LDB(B0, 1, 0); PG8_LDB(B1, 1, 1); PG8_SCHED; PG8_LDA(At, 1, 0); PG8_STAGE(PG8_SA(0, 1), a2 + hstep, voffA);
            PG8_WAIT_V(8); PG8_WAIT_L(0); PG8_BAR; PG8_MMA(0, 0, At, B0); PG8_MMA(0, 1, At, B1); PG8_BAR; PG8_SCHED;
            PG8_LDA(At, 1, 1); PG8_STAGE(PG8_SB(1, 0), b3, voffB); PG8_STAGE(PG8_SB(1, 1), b3 + hstep, voffB); PG8_STAGE(PG8_SA(1, 0), a3, voffA);
            PG8_WAIT_V(8); PG8_WAIT_L(0); PG8_BAR; PG8_MMA(1, 0, At, B0); PG8_MMA(1, 1, At, B1); PG8_BAR; PG8_SCHED;
            } else {
            PG8_LDB(B0, 0, 0); PG8_SCHED; PG8_LDA(At, 0, 0); PG8_STAGE(PG8_SA(1, 1), a1 + hstep, voffA);
            PG8_WAIT_L(8); PG8_BAR; PG8_WAIT_L(0); PG8_MMA(0, 0, At, B0); PG8_BAR; PG8_SCHED;
            PG8_LDB(B1, 0, 1); PG8_STAGE(PG8_SB(0, 0), b2, voffB);
            PG8_BAR; PG8_WAIT_L(0); PG8_MMA(0, 1, At, B1); PG8_BAR;
            PG8_LDA(At, 0, 1); PG8_STAGE(PG8_SA(0, 0), a2, voffA);
            PG8_BAR; PG8_WAIT_L(0); PG8_MMA(1, 0, At, B0); PG8_BAR; PG8_SCHED;
            PG8_STAGE(PG8_SB(0, 1), b2 + hstep, voffB);
            PG8_WAIT_V(6); PG8_BAR; PG8_MMA(1, 1, At, B1); PG8_BAR;
            PG8_LDB(B0, 1, 0); PG8_SCHED; PG8_LDA(At, 1, 0); PG8_STAGE(PG8_SA(0, 1), a2 + hstep, voffA);
            PG8_WAIT_L(8); PG8_BAR; PG8_WAIT_L(0); PG8_MMA(0, 0, At, B0); PG8_BAR; PG8_SCHED;
            PG8_LDB(B1, 1, 1); PG8_STAGE(PG8_SB(1, 0), b3, voffB);
            PG8_BAR; PG8_WAIT_L(0); PG8_MMA(0, 1, At, B1); PG8_BAR;
            PG8_LDA(At, 1, 1); PG8_STAGE(PG8_SA(1, 0), a3, voffA);
            PG8_BAR; PG8_WAIT_L(0); PG8_MMA(1, 0, At, B0); PG8_BAR; PG8_SCHED;
            PG8_STAGE(PG8_SB(1, 1), b3 + hstep, voffB);
            PG8_WAIT_V(6); PG8_BAR; PG8_MMA(1, 1, At, B1); PG8_BAR;
            }
        }
        if constexpr (ALIGN_EPI) { if (wr == 0) PG8_BAR; }
        if constexpr (!Epi::AFTER_DRAIN) { E(acc, cur, wr, wc, fr, fq); S.done(cur); }
        if (!has_next) break;
#pragma unroll
        for (int a = 0; a < 2; ++a)
#pragma unroll
            for (int b = 0; b < 2; ++b)
#pragma unroll
                for (int m = 0; m < 4; ++m)
#pragma unroll
                    for (int n = 0; n < 2; ++n) acc[a][b][m][n] = (f32x4){0.f, 0.f, 0.f, 0.f};
        cur = nxt; cA = nA; cB = nB; ++ui;
        if constexpr (ALIGN_EPI) { if (wr == 1) PG8_BAR; }
    }
    PG8_WAIT_V(0);
    if constexpr (!ALIGN_EPI) { if (wr == 0) PG8_BAR; }
    PG8_BAR;
    if constexpr (Epi::AFTER_DRAIN) { E.fused(acc, cur, wr, wc, fr, fq, lds, wid, lane); S.done(cur); }
#undef PG8_SA
#undef PG8_SB
#undef PG8_STAGE
#undef PG8_LDA
#undef PG8_LDB
#undef PG8_MMA
#undef PG8_WAIT_V
#undef PG8_WAIT_L
#undef PG8_BAR
#undef PG8_SCHED
}
}
#include <hip/hip_cooperative_groups.h>
namespace cg = cooperative_groups;
#define DI __device__ __forceinline__
typedef unsigned short bf16;
typedef float f32x4 __attribute__((ext_vector_type(4)));
typedef short bf16x8 __attribute__((ext_vector_type(8)));
typedef unsigned u32x4 __attribute__((ext_vector_type(4)));
typedef unsigned u32x2 __attribute__((ext_vector_type(2)));
#define LAS __attribute__((address_space(3)))

constexpr int M = 32768, DM = 1024, DFF = 2816, SEQ = 4096;
constexpr float EPS = 1e-6f;
constexpr size_t HM = 512u * 1024u;
constexpr size_t WS_W = 2 * HM, WL = 83 * HM;
constexpr size_t OW_GU1 = 0, OW_D1 = 22 * HM, OW_INA = 33 * HM, OW_INB = 42 * HM, OW_OUT = 46 * HM, OW_GU2 = 50 * HM, OW_D2 = 72 * HM;
constexpr size_t WS_XB = WS_W + 2 * WL, WS_SSQ = WS_XB + 128 * HM, WS_R = WS_SSQ + 4 * HM;
constexpr size_t R_QKNA = 0, R_VT = 128 * HM, R_GR = 256 * HM, R_GP = 320 * HM, R_SBEF = 448 * HM, R_GQK = 576 * HM, R_KT = 640 * HM, R_CODES = 704 * HM, R_DEC = 708 * HM, R_END = 710 * HM;
constexpr size_t R_MIX = 576 * HM, R_H = 0;
constexpr size_t WS_END = WS_R + R_END;
constexpr int LDS_BYTES = 147456;
constexpr int NWAVES = 8;

DI unsigned pk2(float lo, float hi) { return pg8::cvt_pk_bf16(lo, hi); }
DI float bflo(unsigned w) { return __uint_as_float(w << 16); }
DI float bfhi(unsigned w) { return __uint_as_float(w & 0xffff0000u); }
DI bf16x8 ld16(const bf16* p) { return *(const bf16x8*)p; }
DI bf16x8 ld8x2(const bf16* p0, const bf16* p1) { const u32x2 a = *(const u32x2*)p0, b = *(const u32x2*)p1; u32x4 v; v.x = a.x; v.y = a.y; v.z = b.x; v.w = b.y; return __builtin_bit_cast(bf16x8, v); }
DI f32x4 mfma16(bf16x8 a, bf16x8 b, f32x4 c) { return __builtin_amdgcn_mfma_f32_16x16x32_bf16(a, b, c, 0, 0, 0); }
DI bf16x8 pack8(f32x4 a, f32x4 b) { u32x4 v; v.x = pk2(a[0], a[1]); v.y = pk2(a[2], a[3]); v.z = pk2(b[0], b[1]); v.w = pk2(b[2], b[3]); return __builtin_bit_cast(bf16x8, v); }
DI float silu_f(float x) { return x * __builtin_amdgcn_rcpf(1.0f + __expf(-x)); }
DI float wave_sum(float v) {
#pragma unroll
    for (int o = 1; o < 64; o <<= 1) v += __shfl_xor(v, o);
    return v;
}

DI void row_rstd(const float* ssq, int row0, int fq, float (&rs)[2][4]) {
#pragma unroll
    for (int ai = 0; ai < 2; ++ai)
#pragma unroll
        for (int m = 0; m < 4; ++m) {
            const f32x4 v = *(const f32x4*)(ssq + (size_t)(row0 + ai * 128 + m * 16) * 16 + 4 * fq);
            float s = (v[0] + v[1]) + (v[2] + v[3]);
            s += __shfl_xor(s, 16); s += __shfl_xor(s, 32);
            rs[ai][m] = rsqrtf(s * (1.0f / DM) + EPS);
        }
}
struct EpiSwiGLU {
    static constexpr bool PERM = true, AFTER_DRAIN = false;
    bf16* H; const float* ssq;
    DI void operator()(const f32x4 (&acc)[2][2][4][2], const pg8::Unit& u, int wr, int wc, int fr, int fq) const {
        const int row0 = u.pm * 256 + wr * 64 + fr, col0 = u.pn * 128 + wc * 32 + 8 * fq;
        float rs[2][4]; row_rstd(ssq, row0, fq, rs);
#pragma unroll
        for (int ai = 0; ai < 2; ++ai)
#pragma unroll
            for (int m = 0; m < 4; ++m) {
                typedef float f32x2 __attribute__((ext_vector_type(2)));
                const float r = rs[ai][m]; const float r2s = r * r, rls = r * -1.44269504f; const f32x2 r2 = {r2s, r2s}, rl = {rls, rls};
                unsigned hw[4];
#pragma unroll
                for (int q = 0; q < 4; ++q) {
                    const f32x4 gq = acc[ai][0][m][q >> 1], uq = acc[ai][1][m][q >> 1];
                    const f32x2 g2 = {gq[2 * (q & 1)], gq[2 * (q & 1) + 1]}, u2 = {uq[2 * (q & 1)], uq[2 * (q & 1) + 1]};
                    const f32x2 t = g2 * rl; f32x2 e; e.x = __builtin_amdgcn_exp2f(t.x); e.y = __builtin_amdgcn_exp2f(t.y);
                    const f32x2 d = e + 1.0f; f32x2 rc; rc.x = __builtin_amdgcn_rcpf(d.x); rc.y = __builtin_amdgcn_rcpf(d.y);
                    const f32x2 hv = ((g2 * u2) * r2) * rc;
                    hw[q] = pk2(hv.x, hv.y);
                }
                u32x4 w; w.x = hw[0]; w.y = hw[1]; w.z = hw[2]; w.w = hw[3];
                *(u32x4*)(H + (size_t)(row0 + ai * 128 + m * 16) * DFF + col0) = w;
            }
    }
};
struct EpiResid {
    static constexpr bool PERM = true, AFTER_DRAIN = false;
    const float* base32; bf16* XB; float* ssq; float alpha;
    DI void operator()(const f32x4 (&acc)[2][2][4][2], const pg8::Unit& u, int wr, int wc, int fr, int fq) const {
        const int row0 = u.pm * 256 + wr * 64 + fr, col0 = u.pn * 256 + wc * 32 + 8 * fq;
#pragma unroll
        for (int ai = 0; ai < 2; ++ai)
#pragma unroll
            for (int m = 0; m < 4; ++m) {
                const int row = row0 + ai * 128 + m * 16; float ss = 0.f;
#pragma unroll
                for (int bj = 0; bj < 2; ++bj) {
                    const size_t off = (size_t)row * DM + col0 + bj * 128;
                    f32x4 b0, b1;
                    if (base32) { b0 = *(const f32x4*)(base32 + off); b1 = *(const f32x4*)(base32 + off + 4); }
                    else { const u32x4 bb = *(const u32x4*)(XB + off); b0 = (f32x4){bflo(bb.x), bfhi(bb.x), bflo(bb.y), bfhi(bb.y)}; b1 = (f32x4){bflo(bb.z), bfhi(bb.z), bflo(bb.w), bfhi(bb.w)}; }
                    const f32x4 v0 = b0 + acc[ai][bj][m][0] * alpha, v1 = b1 + acc[ai][bj][m][1] * alpha;
                    ss += ((v0[0] * v0[0] + v0[1] * v0[1]) + (v0[2] * v0[2] + v0[3] * v0[3])) + ((v1[0] * v1[0] + v1[1] * v1[1]) + (v1[2] * v1[2] + v1[3] * v1[3]));
                    u32x4 w; w.x = pk2(v0[0], v0[1]); w.y = pk2(v0[2], v0[3]); w.z = pk2(v1[0], v1[1]); w.w = pk2(v1[2], v1[3]);
                    *(u32x4*)(XB + off) = w;
                }
                ss += __shfl_xor(ss, 16); ss += __shfl_xor(ss, 32);
                if (fq == 0) ssq[(size_t)row * 16 + u.pn * 4 + wc] = ss;
                asm volatile("" ::: "memory");
            }
    }
};
struct EpiProj {
    static constexpr bool PERM = true, AFTER_DRAIN = false;
    bf16* QKNA; bf16* GQK; bf16* GR; bf16* CODES; const float* ssq;
    DI void operator()(const f32x4 (&acc)[2][2][4][2], const pg8::Unit& u, int wr, int wc, int fr, int fq) const {
        const int row0 = u.pm * 256 + wr * 64 + fr; const int pn = u.pn;
        float rs[2][4]; row_rstd(ssq, row0, fq, rs);
        bf16* dst; int ld, cb;
        if (pn < 4) { dst = QKNA; ld = 1024; cb = 256 * pn; } else if (pn < 6) { dst = GQK; ld = 512; cb = 256 * (pn - 4); } else if (pn < 8) { dst = GR; ld = 512; cb = 256 * (pn - 6); } else { dst = CODES; ld = 32; cb = 0; }
        const int col0 = cb + wc * 32 + 8 * fq;
#pragma unroll
        for (int ai = 0; ai < 2; ++ai)
#pragma unroll
            for (int m = 0; m < 4; ++m) {
                const float r = rs[ai][m];
#pragma unroll
                for (int bj = 0; bj < 2; ++bj) {
                    const f32x4 a = acc[ai][bj][m][0] * r, b = acc[ai][bj][m][1] * r;
                    u32x4 w; w.x = pk2(a[0], a[1]); w.y = pk2(a[2], a[3]); w.z = pk2(b[0], b[1]); w.w = pk2(b[2], b[3]);
                    if (pn < 8 || (bj == 0 && wc == 0)) *(u32x4*)(dst + (size_t)(row0 + ai * 128 + m * 16) * ld + col0 + bj * 128) = w;
                }
            }
    }
};
struct EpiVT {
    static constexpr bool PERM = true, AFTER_DRAIN = false;
    bf16* VT; const float* ssq;
    DI void operator()(const f32x4 (&acc)[2][2][4][2], const pg8::Unit& u, int wr, int wc, int fr, int fq) const {
        const int row0 = u.pm * 256 + wr * 64 + fr, tok0 = u.pn * 256 + wc * 32 + 8 * fq;
#pragma unroll
        for (int bj = 0; bj < 2; ++bj) {
            float rs[8];
#pragma unroll
            for (int j = 0; j < 8; ++j) {
                float s = ssq[(size_t)(tok0 + bj * 128 + j) * 16 + fr];
                s += __shfl_xor(s, 1); s += __shfl_xor(s, 2); s += __shfl_xor(s, 4); s += __shfl_xor(s, 8);
                rs[j] = rsqrtf(s * (1.0f / DM) + EPS);
            }
#pragma unroll
            for (int ai = 0; ai < 2; ++ai)
#pragma unroll
                for (int m = 0; m < 4; ++m) {
                    const f32x4 a = acc[ai][bj][m][0], b = acc[ai][bj][m][1];
                    u32x4 w; w.x = pk2(a[0] * rs[0], a[1] * rs[1]); w.y = pk2(a[2] * rs[2], a[3] * rs[3]); w.z = pk2(b[0] * rs[4], b[1] * rs[5]); w.w = pk2(b[2] * rs[6], b[3] * rs[7]);
                    *(u32x4*)(VT + ((size_t)((tok0 + bj * 128) >> 3) * 1024 + (row0 + ai * 128 + m * 16)) * 8) = w;
                }
        }
    }
};

DI void conv_item(const float* W, int K, int N, int kb, int n0, bf16* dst  , const float* gain, float* scr, int lane) {
    const int k0 = 64 * kb;
#pragma unroll
    for (int i = 0; i < 8; ++i) {
        const int kk = 8 * i + (lane >> 3), cc = 4 * (lane & 7);
        f32x4 v = *(const f32x4*)(W + (size_t)(k0 + kk) * N + n0 + cc); if (gain) v = v * gain[k0 + kk];
        scr[kk * 33 + cc] = v[0]; scr[kk * 33 + cc + 1] = v[1]; scr[kk * 33 + cc + 2] = v[2]; scr[kk * 33 + cc + 3] = v[3];
    }
    asm volatile("s_waitcnt lgkmcnt(0)" ::: "memory");
    const int c = lane & 7;
#pragma unroll
    for (int j = 0; j < 4; ++j) { const int n = (lane >> 3) + 8 * j; const float* s = scr + (8 * c) * 33 + n;
        u32x4 o; o.x = pk2(s[0 * 33], s[1 * 33]); o.y = pk2(s[2 * 33], s[3 * 33]); o.z = pk2(s[4 * 33], s[5 * 33]); o.w = pk2(s[6 * 33], s[7 * 33]);
        *(u32x4*)(dst + (size_t)n * K + k0 + 8 * c) = o; }
    asm volatile("s_waitcnt lgkmcnt(0)" ::: "memory");
}
struct Args { const float* in[20]; float* out; unsigned char* ws; };
#define INP(i) ((const float*)karg(8 * (i)))
#define WSP() ((unsigned char*)karg(168))
#define OUTP() ((float*)karg(160))
typedef const char __attribute__((address_space(4)))* kaptr_t;
DI const void* karg(int off) { asm volatile("" : "+s"(off)); kaptr_t ka = (kaptr_t)__builtin_amdgcn_kernarg_segment_ptr(); return *(const void* const __attribute__((address_space(4)))*)(ka + off); }
struct KA { DI const float* inp(int i) const { return (const float*)karg(8 * i); } };

DI void prologue(const Args& A, unsigned char* lds, int wave, int lane) {
    float* scr = (float*)(lds + wave * 16384);
    const int gw = blockIdx.x * NWAVES + wave, NGW = gridDim.x * NWAVES;
    constexpr int I_GU = 16 * 88, I_D = 44 * 32, I_IN = 16 * 97, I_OUT = 16 * 32, PER_L = 6 * I_GU + I_IN + I_OUT;
    static_assert(I_GU == I_D, "");
    for (int it = gw; it < 2 * PER_L; it += NGW) {
        const int l = it / PER_L; int r = it % PER_L;
        unsigned char* wb = WSP() + WS_W + (size_t)l * WL;
        const int seg = r < 6 * I_GU ? r / I_GU : (r < 6 * I_GU + I_IN ? 6 : 7);
        if (seg < 6) {
            r -= seg * I_GU;
            const int ffn = seg / 3, kind = seg % 3;
            if (kind < 2) {
                const float* W = INP((ffn ? 16 : 2) + kind) + (size_t)l * DM * DFF; const float* gn = INP(ffn ? 15 : 1) + l * DM;
                const int kb = r / 88, nb = r % 88, n0 = 32 * nb;
                bf16* dst = (bf16*)(wb + (ffn ? OW_GU2 : OW_GU1)) + (size_t)((n0 >> 7) * 256 + kind * 128 + (n0 & 127)) * DM;
                conv_item(W, DM, DFF, kb, n0, dst, gn, scr, lane);
            } else {
                const float* W = INP(ffn ? 18 : 4) + (size_t)l * DM * DFF;
                const int kb = r / 32, nb = r % 32, n0 = 32 * nb;
                bf16* dst = (bf16*)(wb + (ffn ? OW_D2 : OW_D1)) + (size_t)n0 * DFF;
                conv_item(W, DFF, DM, kb, n0, dst, nullptr, scr, lane);
            }
        } else if (seg == 6) {
            r -= 6 * I_GU;
            const float* W = INP(6) + (size_t)l * DM * 3104; const float* gn = INP(5) + l * DM;
            const int kb = r / 97, nb = r % 97, n0 = 32 * nb;
            bf16* wa = (bf16*)(wb + OW_INA); bf16* wv = (bf16*)(wb + OW_INB); bf16* dst;
            if (n0 < 1024) dst = wa + (size_t)n0 * DM;
            else if (n0 < 1536) dst = wv + (size_t)(n0 - 1024) * DM;
            else if (n0 < 2048) dst = wa + (size_t)(n0 - 512) * DM;
            else if (n0 < 2560) dst = wv + (size_t)(n0 - 1536) * DM;
            else if (n0 < 3072) dst = wa + (size_t)(n0 - 1024) * DM;
            else dst = wa + (size_t)2048 * DM;
            conv_item(W, DM, 3104, kb, n0, dst, gn, scr, lane);
        } else {
            r -= 6 * I_GU + I_IN;
            const float* W = INP(14) + (size_t)l * DM * DM;
            const int kb = r / 32, nb = r % 32, n0 = 32 * nb;
            conv_item(W, DM, DM, kb, n0, (bf16*)(wb + OW_OUT) + (size_t)n0 * DM, nullptr, scr, lane);
        }
    }
    const float* x = INP(0); bf16* XB = (bf16*)(WSP() + WS_XB); float* ssq = (float*)(WSP() + WS_SSQ);
    for (int m = gw; m < M; m += NGW) {
        const f32x4* xr = (const f32x4*)(x + (size_t)m * DM) + lane; f32x4 v[4]; float s = 0.f;
#pragma unroll
        for (int j = 0; j < 4; ++j) { v[j] = xr[64 * j]; s += (v[j][0] * v[j][0] + v[j][1] * v[j][1]) + (v[j][2] * v[j][2] + v[j][3] * v[j][3]); }
        s = wave_sum(s);
        u32x2* o = (u32x2*)(XB + (size_t)m * DM) + lane;
#pragma unroll
        for (int j = 0; j < 4; ++j) { u32x2 w; w.x = pk2(v[j][0], v[j][1]); w.y = pk2(v[j][2], v[j][3]); o[64 * j] = w; }
        if (lane < 16) ssq[(size_t)m * 16 + lane] = lane == 0 ? s : 0.f;
    }
}
#define SCHED_FENCE() __builtin_amdgcn_sched_barrier(0)
DI float log_sigmoid_f(float z) { return fminf(z, 0.f) - __logf(1.0f + __expf(-fabsf(z))); }
DI void gla_prep_item(const Args& A, int l, unsigned char* ldsb, int item, int tid, bool stage) {
    float* gl = (float*)ldsb; float* tot = gl + 2 * 64 * 65; float* wg = tot + 512; float* bg = wg + 2048; bf16* T = (bf16*)(bg + 128);
    unsigned char* R = WSP() + WS_R;
    const bf16* CODES = (const bf16*)(R + R_CODES); const bf16* GQK = (const bf16*)(R + R_GQK);
    bf16* GP = (bf16*)(R + R_GP); bf16* KT = (bf16*)(R + R_KT); float* DEC = (float*)(R + R_DEC);
    const int c = item & 63, bh = item >> 6, h = bh & 3, b = bh >> 2;
    const size_t tok0 = (size_t)b * SEQ + c * 64;
    const int t = tid >> 3, dg = tid & 7;
    const u32x4* cp = (const u32x4*)(CODES + (tok0 + t) * 32);
    const u32x4 cq0 = cp[0], cq1 = cp[1], cq2 = cp[2], cq3 = cp[3];
    const u32x4 qv = *(const u32x4*)(GQK + (tok0 + t) * 512 + h * 64 + 8 * dg), kv = *(const u32x4*)(GQK + (tok0 + t) * 512 + 256 + h * 64 + 8 * dg);
    if (stage) {
        const int idx = tid * 4, dir = idx >> 10, r = (idx >> 6) & 15, d = idx & 63;
        const float* w = (dir ? INP(11) : INP(9)) + (size_t)l * 16 * 256 + r * 256 + h * 64 + d;
        *(f32x4*)(wg + idx) = *(const f32x4*)w;
        if (tid < 128) { const int dr = tid >> 6, dd = tid & 63; bg[tid] = (dr ? INP(12) : INP(10))[l * 256 + h * 64 + dd]; }
        __syncthreads();
    }
    {
        float cf[32];
#pragma unroll
        for (int j = 0; j < 4; ++j) { const u32x4 v = j == 0 ? cq0 : (j == 1 ? cq1 : (j == 2 ? cq2 : cq3)); cf[8 * j + 0] = bflo(v.x); cf[8 * j + 1] = bfhi(v.x); cf[8 * j + 2] = bflo(v.y); cf[8 * j + 3] = bfhi(v.y); cf[8 * j + 4] = bflo(v.z); cf[8 * j + 5] = bfhi(v.z); cf[8 * j + 6] = bflo(v.w); cf[8 * j + 7] = bfhi(v.w); }
#pragma unroll
        for (int dir = 0; dir < 2; ++dir) {
            float z[8];
#pragma unroll
            for (int dd = 0; dd < 8; ++dd) z[dd] = bg[dir * 64 + 8 * dg + dd];
#pragma unroll
            for (int r = 0; r < 16; ++r) {
                const f32x4 w0 = *(const f32x4*)(wg + dir * 1024 + r * 64 + 8 * dg), w1 = *(const f32x4*)(wg + dir * 1024 + r * 64 + 8 * dg + 4);
                const float cv = cf[dir * 16 + r];
                z[0] += cv * w0[0]; z[1] += cv * w0[1]; z[2] += cv * w0[2]; z[3] += cv * w0[3]; z[4] += cv * w1[0]; z[5] += cv * w1[1]; z[6] += cv * w1[2]; z[7] += cv * w1[3];
            }
#pragma unroll
            for (int dd = 0; dd < 8; ++dd) gl[(dir * 64 + t) * 65 + 8 * dg + dd] = log_sigmoid_f(z[dd]) * (1.0f / 16.0f);
        }
    }
    __syncthreads();
    {
        const int dir = tid >> 8, seg = (tid >> 6) & 3, d = tid & 63;
        float* gp = gl + (dir * 64 + 16 * seg) * 65 + d; float v[16];
#pragma unroll
        for (int tt = 0; tt < 16; ++tt) v[tt] = gp[tt * 65];
        if (dir == 0) {
#pragma unroll
            for (int tt = 1; tt < 16; ++tt) v[tt] += v[tt - 1];
        } else {
#pragma unroll
            for (int tt = 14; tt >= 0; --tt) v[tt] += v[tt + 1];
        }
        tot[(dir * 4 + seg) * 64 + d] = dir == 0 ? v[15] : v[0];
        __syncthreads();
        float off = 0.f;
        if (dir == 0) { for (int s2 = 0; s2 < 4; ++s2) if (s2 < seg) off += tot[s2 * 64 + d]; }
        else { for (int s2 = 0; s2 < 4; ++s2) if (s2 > seg) off += tot[(4 + s2) * 64 + d]; }
#pragma unroll
        for (int tt = 0; tt < 16; ++tt) gp[tt * 65] = v[tt] + off;
    }
    __syncthreads();
    {
        float q[8], k[8];
        q[0] = bflo(qv.x); q[1] = bfhi(qv.x); q[2] = bflo(qv.y); q[3] = bfhi(qv.y); q[4] = bflo(qv.z); q[5] = bfhi(qv.z); q[6] = bflo(qv.w); q[7] = bfhi(qv.w);
        k[0] = bflo(kv.x); k[1] = bfhi(kv.x); k[2] = bflo(kv.y); k[3] = bfhi(kv.y); k[4] = bflo(kv.z); k[5] = bfhi(kv.z); k[6] = bflo(kv.w); k[7] = bfhi(kv.w);
        float qf[8], kf[8], qb[8], kb[8];
#pragma unroll
        for (int dd = 0; dd < 8; ++dd) {
            const int d = 8 * dg + dd;
            const float bf = gl[t * 65 + d], bb = gl[(64 + t) * 65 + d], bfl = gl[63 * 65 + d], bb0 = gl[64 * 65 + d];
            qf[dd] = q[dd] * 0.125f * __expf(bf); kf[dd] = k[dd] * __expf(-bf);
            qb[dd] = q[dd] * 0.125f * __expf(bb); kb[dd] = k[dd] * __expf(-bb);
            T[d * 72 + t] = (bf16)(pk2(k[dd] * __expf(bfl - bf), 0.f) & 0xffffu);
            T[(64 + d) * 72 + t] = (bf16)(pk2(k[dd] * __expf(bb0 - bb), 0.f) & 0xffffu);
        }
        const size_t go = (tok0 + t) * 256 + h * 64 + 8 * dg; const size_t AS = (size_t)M * 256;
        u32x4 w;
        w.x = pk2(qf[0], qf[1]); w.y = pk2(qf[2], qf[3]); w.z = pk2(qf[4], qf[5]); w.w = pk2(qf[6], qf[7]); *(u32x4*)(GP + go) = w;
        w.x = pk2(kf[0], kf[1]); w.y = pk2(kf[2], kf[3]); w.z = pk2(kf[4], kf[5]); w.w = pk2(kf[6], kf[7]); *(u32x4*)(GP + AS + go) = w;
        w.x = pk2(qb[0], qb[1]); w.y = pk2(qb[2], qb[3]); w.z = pk2(qb[4], qb[5]); w.w = pk2(qb[6], qb[7]); *(u32x4*)(GP + 2 * AS + go) = w;
        w.x = pk2(kb[0], kb[1]); w.y = pk2(kb[2], kb[3]); w.z = pk2(kb[4], kb[5]); w.w = pk2(kb[6], kb[7]); *(u32x4*)(GP + 3 * AS + go) = w;
        if (tid < 128) { const int dir = tid >> 6, d = tid & 63; DEC[((size_t)(dir * 32 + bh) * 64 + c) * 64 + d] = __expf(dir ? gl[64 * 65 + d] : gl[63 * 65 + d]); }
    }
    __syncthreads();
#pragma unroll
    for (int i = 0; i < 2; ++i) {
        const int u = tid + 512 * i, dir = u >> 9, d = (u >> 3) & 63, j = u & 7;
        *(u32x4*)(KT + ((size_t)((tok0 >> 3) + j) * 512 + dir * 256 + h * 64 + d) * 8) = *(const u32x4*)(T + (dir * 64 + d) * 72 + 8 * j);
    }
    __syncthreads();
}

DI void gla_scan_item(const Args& A, int item, int wave, int lane) {
    unsigned char* R = WSP() + WS_R;
    const bf16* VT = (const bf16*)(R + R_VT); const bf16* KT = (const bf16*)(R + R_KT); const float* DEC = (const float*)(R + R_DEC); bf16* SBEF = (bf16*)(R + R_SBEF);
    const int es = item & 3, chain = item >> 2, dir = chain >> 5, bh = chain & 31, h = bh & 3, b = bh >> 2;
    const int c = lane & 15, g = lane >> 4, ebl = wave >> 2, db = wave & 3, e0 = 32 * es + 16 * ebl;
    const bf16* kp = KT + ((size_t)(b * 512 + g) * 512 + dir * 256 + h * 64 + 16 * db + c) * 8;
    const bf16* vp = VT + ((size_t)(b * 512 + g) * 1024 + 512 + h * 128 + e0 + c) * 8;
    const float* dp = DEC + (size_t)chain * 64 * 64 + 16 * db + 4 * g;
    bf16* sp = SBEF + ((size_t)chain * 64 * 128 + e0 + c) * 64 + 16 * db + 4 * g;
    f32x4 S = {0.f, 0.f, 0.f, 0.f};
#define SC_CH(n) (dir ? 63 - (n) : (n))
#define SC_LOAD(k, n) do { const int c_ = SC_CH((n) < 63 ? (n) : 63); a0##k = ld16(kp + (size_t)c_ * 32768); a1##k = ld16(kp + (size_t)c_ * 32768 + 16384); b0##k = ld16(vp + (size_t)c_ * 65536); b1##k = ld16(vp + (size_t)c_ * 65536 + 32768); dc##k = *(const f32x4*)(dp + c_ * 64); } while (0)
#define SC_STEP(k, n) do { u32x2 w_; w_.x = pk2(S[0], S[1]); w_.y = pk2(S[2], S[3]); *(u32x2*)(sp + (size_t)SC_CH(n) * 128 * 64) = w_; S = S * dc##k; S = mfma16(a0##k, b0##k, S); S = mfma16(a1##k, b1##k, S); } while (0)
    bf16x8 a00, a10, b00, b10, a01, a11, b01, b11, a02, a12, b02, b12, a03, a13, b03, b13; f32x4 dc0, dc1, dc2, dc3;
    SC_LOAD(0, 0); SC_LOAD(1, 1); SC_LOAD(2, 2); SC_LOAD(3, 3);
#pragma unroll 1
    for (int n = 0; n < 64; n += 4) {
        SC_STEP(0, n); SC_LOAD(0, n + 4);
        SC_STEP(1, n + 1); SC_LOAD(1, n + 5);
        SC_STEP(2, n + 2); SC_LOAD(2, n + 6);
        SC_STEP(3, n + 3); SC_LOAD(3, n + 7);
    }
#undef SC_CH
#undef SC_LOAD
#undef SC_STEP
}

constexpr int SC_STEP_B = 12544, SC_BATCH_B = 4 * SC_STEP_B;
struct ScStage { u32x4 k[4]; u32x4 x[4]; };
DI void sc_gload(ScStage& st, int item, int batch, int tid) {
    unsigned char* R = WSP() + WS_R;
    const bf16* VT = (const bf16*)(R + R_VT); const bf16* KT = (const bf16*)(R + R_KT); const float* DEC = (const float*)(R + R_DEC);
    const int es = item & 3, chain = item >> 2, dir = chain >> 5, bh = chain & 31, h = bh & 3, b = bh >> 2;
#pragma unroll
    for (int s4 = 0; s4 < 4; ++s4) {
        const int n = 4 * batch + s4, cc = dir ? 63 - n : n;
        st.k[s4] = *(const u32x4*)(KT + ((size_t)(b * 512 + cc * 8 + (tid >> 6)) * 512 + dir * 256 + h * 64 + (tid & 63)) * 8);
        if (tid < 256) st.x[s4] = *(const u32x4*)(VT + ((size_t)(b * 512 + cc * 8 + (tid >> 5)) * 1024 + 512 + h * 128 + 32 * es + (tid & 31)) * 8);
        else if (tid < 272) st.x[s4] = *(const u32x4*)(DEC + ((size_t)chain * 64 + cc) * 64 + (tid - 256) * 4);
    }
}
DI void sc_lwrite(const ScStage& st, unsigned char* buf, int tid) {
#pragma unroll
    for (int s4 = 0; s4 < 4; ++s4) {
        *(u32x4*)(buf + s4 * SC_STEP_B + tid * 16) = st.k[s4];
        if (tid < 256) *(u32x4*)(buf + s4 * SC_STEP_B + 8192 + tid * 16) = st.x[s4];
        else if (tid < 272) *(u32x4*)(buf + s4 * SC_STEP_B + 12288 + (tid - 256) * 16) = st.x[s4];
    }
}
DI void gla_scan_item_lds(unsigned char* ldsb, int item, int tid, int wave, int lane) {
    unsigned char* R = WSP() + WS_R; bf16* SBEF = (bf16*)(R + R_SBEF);
    const int es = item & 3, chain = item >> 2, dir = chain >> 5;
    const int c = lane & 15, g = lane >> 4, ebl = wave >> 2, db = wave & 3, e0 = 32 * es + 16 * ebl;
    bf16* sp = SBEF + ((size_t)chain * 64 * 128 + e0 + c) * 64 + 16 * db + 4 * g;
    const int ao = g * 1024 + (16 * db + c) * 16, bo = 8192 + g * 512 + (16 * ebl + c) * 16, dco = 12288 + (16 * db + 4 * g) * 4;
    f32x4 S = {0.f, 0.f, 0.f, 0.f};
    ScStage st; sc_gload(st, item, 0, tid); sc_lwrite(st, ldsb, tid); sc_gload(st, item, 1, tid);
    __syncthreads();
#pragma unroll 1
    for (int m = 0; m < 16; ++m) {
        const unsigned char* buf = ldsb + (m & 1) * SC_BATCH_B;
#pragma unroll
        for (int s4 = 0; s4 < 4; ++s4) {
            const int n = 4 * m + s4, cc = dir ? 63 - n : n; const unsigned char* sb = buf + s4 * SC_STEP_B;
            u32x2 w_; w_.x = pk2(S[0], S[1]); w_.y = pk2(S[2], S[3]); *(u32x2*)(sp + (size_t)cc * 128 * 64) = w_;
            const f32x4 dc = *(const f32x4*)(sb + dco);
            S = S * dc;
            S = mfma16(*(const bf16x8*)(sb + ao), *(const bf16x8*)(sb + bo), S);
            S = mfma16(*(const bf16x8*)(sb + ao + 4096), *(const bf16x8*)(sb + bo + 2048), S);
        }
        if (m < 15) sc_lwrite(st, ldsb + ((m + 1) & 1) * SC_BATCH_B, tid);
        if (m < 14) sc_gload(st, item, m + 2, tid);
        __syncthreads();
    }
}

DI void gla_out_item(const Args& A, int l, int item, int tb, int lane) {
    unsigned char* R = WSP() + WS_R;
    const bf16* VT = (const bf16*)(R + R_VT); const bf16* GP = (const bf16*)(R + R_GP); const bf16* SBEF = (const bf16*)(R + R_SBEF); const bf16* GR = (const bf16*)(R + R_GR); bf16* MIX = (bf16*)(R + R_MIX);
    const size_t AS = (size_t)M * 256;
    const int ck = item & 63, bh = item >> 6, h = bh & 3, b = bh >> 2, c = lane & 15, g = lane >> 4;
    const size_t tok0 = (size_t)b * SEQ + ck * 64;
    const size_t qo = (tok0 + 16 * tb + c) * 256 + h * 64 + 8 * g;
    const bf16x8 qf0 = ld16(GP + qo), qf1 = ld16(GP + qo + 32), qb0 = ld16(GP + 2 * AS + qo), qb1 = ld16(GP + 2 * AS + qo + 32);
    bf16x8 kfr[8], kbr[8];
#pragma unroll
    for (int i = 0; i < 8; ++i) {
        const size_t ko = (tok0 + 16 * (i >> 1) + c) * 256 + h * 64 + 8 * g + 32 * (i & 1);
        kfr[i] = ld16(GP + AS + ko); kbr[i] = ld16(GP + 3 * AS + ko);
    }
    const bf16* sf = SBEF + ((size_t)(bh * 64 + ck) * 128 + c) * 64 + 8 * g;
    const bf16* sbk = SBEF + ((size_t)((32 + bh) * 64 + ck) * 128 + c) * 64 + 8 * g;
    const bf16* vt = VT + ((size_t)((tok0 >> 3) + (g >> 1)) * 1024 + 512 + h * 128 + c) * 8 + 4 * (g & 1);
    u32x2 vv[2][8]; bf16x8 sv[2][8];
#define GO_LOAD(buf, eb0) do { _Pragma("unroll") for (int e_ = 0; e_ < 2; ++e_) { const bf16* v_ = vt + 128 * ((eb0) + e_); \
        vv[buf][4 * e_ + 0] = *(const u32x2*)(v_); vv[buf][4 * e_ + 1] = *(const u32x2*)(v_ + 16384); vv[buf][4 * e_ + 2] = *(const u32x2*)(v_ + 32768); vv[buf][4 * e_ + 3] = *(const u32x2*)(v_ + 49152); \
        sv[buf][4 * e_ + 0] = ld16(sf + ((eb0) + e_) * 1024); sv[buf][4 * e_ + 1] = ld16(sf + ((eb0) + e_) * 1024 + 32); sv[buf][4 * e_ + 2] = ld16(sbk + ((eb0) + e_) * 1024); sv[buf][4 * e_ + 3] = ld16(sbk + ((eb0) + e_) * 1024 + 32); } } while (0)
    GO_LOAD(0, 0);
    SCHED_FENCE();
    f32x4 at[4];
#pragma unroll
    for (int sb = 0; sb < 4; ++sb) {
        f32x4 f = {0.f, 0.f, 0.f, 0.f}, bk = {0.f, 0.f, 0.f, 0.f};
        f = mfma16(kfr[2 * sb], qf0, f); f = mfma16(kfr[2 * sb + 1], qf1, f);
        bk = mfma16(kbr[2 * sb], qb0, bk); bk = mfma16(kbr[2 * sb + 1], qb1, bk);
#pragma unroll
        for (int i = 0; i < 4; ++i) at[sb][i] = (16 * sb + 4 * g + i <= 16 * tb + c) ? f[i] : bk[i];
    }
    const bf16x8 p0 = pack8(at[0], at[1]), p1 = pack8(at[2], at[3]);
    SCHED_FENCE();
    f32x4 o[8]; float ss = 0.f;
#pragma unroll
    for (int bp = 0; bp < 4; ++bp) {
        if (bp < 3) GO_LOAD((bp + 1) & 1, 2 * bp + 2);
        SCHED_FENCE();
#pragma unroll
        for (int e = 0; e < 2; ++e) {
            f32x4 acc = {0.f, 0.f, 0.f, 0.f};
            const u32x2 v0 = vv[bp & 1][4 * e], v1 = vv[bp & 1][4 * e + 1], v2 = vv[bp & 1][4 * e + 2], v3 = vv[bp & 1][4 * e + 3];
            u32x4 a0; a0.x = v0.x; a0.y = v0.y; a0.z = v1.x; a0.w = v1.y; u32x4 a1; a1.x = v2.x; a1.y = v2.y; a1.z = v3.x; a1.w = v3.y;
            acc = mfma16(__builtin_bit_cast(bf16x8, a0), p0, acc); acc = mfma16(__builtin_bit_cast(bf16x8, a1), p1, acc);
            acc = mfma16(sv[bp & 1][4 * e], qf0, acc); acc = mfma16(sv[bp & 1][4 * e + 1], qf1, acc);
            acc = mfma16(sv[bp & 1][4 * e + 2], qb0, acc); acc = mfma16(sv[bp & 1][4 * e + 3], qb1, acc);
            o[2 * bp + e] = acc; ss += (acc[0] * acc[0] + acc[1] * acc[1]) + (acc[2] * acc[2] + acc[3] * acc[3]);
        }
        SCHED_FENCE();
    }
#undef GO_LOAD
    ss += __shfl_xor(ss, 16); ss += __shfl_xor(ss, 32);
    const float rstd = rsqrtf(ss * (1.0f / 128.0f) + EPS);
    const float* gain = INP(13) + l * 128 + 4 * g;
    const size_t tok = tok0 + 16 * tb + c;
#pragma unroll
    for (int eb = 0; eb < 8; ++eb) {
        const f32x4 gn = *(const f32x4*)(gain + 16 * eb);
        const u32x2 gr = *(const u32x2*)(GR + tok * 512 + h * 128 + 16 * eb + 4 * g);
        const float r0 = bflo(gr.x), r1 = bfhi(gr.x), r2 = bflo(gr.y), r3 = bfhi(gr.y);
        u32x2 w; w.x = pk2(o[eb][0] * rstd * gn[0] * silu_f(r0), o[eb][1] * rstd * gn[1] * silu_f(r1)); w.y = pk2(o[eb][2] * rstd * gn[2] * silu_f(r2), o[eb][3] * rstd * gn[3] * silu_f(r3));
        *(u32x2*)(MIX + tok * 1024 + 512 + h * 128 + 16 * eb + 4 * g) = w;
    }
}

constexpr int GO_KF = 0, GO_KB = 9216, GO_VT = 18432, GO_SF = 34816, GO_SB = 53248, GO_ITEM = 71680;
struct GoStage { u32x4 r[16]; bf16x8 q[4]; };
DI void go_gload(GoStage& st, int item, int t256, int tb, int lane) {
    unsigned char* R = WSP() + WS_R;
    const bf16* VT = (const bf16*)(R + R_VT); const bf16* GP = (const bf16*)(R + R_GP); const bf16* SBEF = (const bf16*)(R + R_SBEF);
    const size_t AS = (size_t)M * 256;
    const int ck = item & 63, bh = item >> 6, h = bh & 3, b = bh >> 2;
    const size_t tok0 = (size_t)b * SEQ + ck * 64;
#pragma unroll
    for (int j = 0; j < 16; ++j) {
        const int q = t256 + 256 * (j & 3);
        const bf16* src;
        if (j < 2)       { const int qq = t256 + 256 * j;       src = GP + AS + (tok0 + (qq >> 3)) * 256 + h * 64 + (qq & 7) * 8; }
        else if (j < 4)  { const int qq = t256 + 256 * (j - 2); src = GP + 3 * AS + (tok0 + (qq >> 3)) * 256 + h * 64 + (qq & 7) * 8; }
        else if (j < 8)  { src = VT + ((size_t)((tok0 >> 3) + (q >> 7)) * 1024 + 512 + h * 128 + (q & 127)) * 8; }
        else if (j < 12) { src = SBEF + (size_t)(bh * 64 + ck) * 8192 + q * 8; }
        else             { src = SBEF + (size_t)((32 + bh) * 64 + ck) * 8192 + q * 8; }
        st.r[j] = *(const u32x4*)src;
    }
    const size_t qo = (tok0 + 16 * tb + (lane & 15)) * 256 + h * 64 + 8 * (lane >> 4);
    st.q[0] = ld16(GP + qo); st.q[1] = ld16(GP + qo + 32); st.q[2] = ld16(GP + 2 * AS + qo); st.q[3] = ld16(GP + 2 * AS + qo + 32);
}
DI void go_lwrite(const GoStage& st, unsigned char* base, int t256) {
#pragma unroll
    for (int j = 0; j < 16; ++j) {
        const int q = t256 + 256 * (j & 3); unsigned char* dst;
        if (j < 2)       { const int qq = t256 + 256 * j;       dst = base + GO_KF + (qq >> 3) * 144 + (qq & 7) * 16; }
        else if (j < 4)  { const int qq = t256 + 256 * (j - 2); dst = base + GO_KB + (qq >> 3) * 144 + (qq & 7) * 16; }
        else if (j < 8)  { dst = base + GO_VT + q * 16; }
        else if (j < 12) { dst = base + GO_SF + (q >> 3) * 144 + (q & 7) * 16; }
        else             { dst = base + GO_SB + (q >> 3) * 144 + (q & 7) * 16; }
        *(u32x4*)dst = st.r[j];
    }
}
DI void go_compute(int l, const unsigned char* base, const bf16x8 (&qq)[4], int item, int tb, int lane) {
    unsigned char* R = WSP() + WS_R;
    const bf16* GR = (const bf16*)(R + R_GR); bf16* MIX = (bf16*)(R + R_MIX);
    const int ck = item & 63, bh = item >> 6, h = bh & 3, b = bh >> 2, c = lane & 15, g = lane >> 4;
    const size_t tok0 = (size_t)b * SEQ + ck * 64;
    const bf16x8 qf0 = qq[0], qf1 = qq[1], qb0 = qq[2], qb1 = qq[3];
    f32x4 at[4];
#pragma unroll
    for (int sb = 0; sb < 4; ++sb) {
        const unsigned char* kf = base + GO_KF + (16 * sb + c) * 144 + g * 16; const unsigned char* kb = base + GO_KB + (16 * sb + c) * 144 + g * 16;
        f32x4 f = {0.f, 0.f, 0.f, 0.f}, bk = {0.f, 0.f, 0.f, 0.f};
        f = mfma16(*(const bf16x8*)kf, qf0, f); f = mfma16(*(const bf16x8*)(kf + 64), qf1, f);
        bk = mfma16(*(const bf16x8*)kb, qb0, bk); bk = mfma16(*(const bf16x8*)(kb + 64), qb1, bk);
#pragma unroll
        for (int i = 0; i < 4; ++i) at[sb][i] = (16 * sb + 4 * g + i <= 16 * tb + c) ? f[i] : bk[i];
    }
    const bf16x8 p0 = pack8(at[0], at[1]), p1 = pack8(at[2], at[3]);
    f32x4 o[8]; float ss = 0.f;
#pragma unroll
    for (int eb = 0; eb < 8; ++eb) {
        const unsigned char* vp = base + GO_VT + (g >> 1) * 2048 + (16 * eb + c) * 16 + (g & 1) * 8;
        const u32x2 v0 = *(const u32x2*)vp, v1 = *(const u32x2*)(vp + 4096), v2 = *(const u32x2*)(vp + 8192), v3 = *(const u32x2*)(vp + 12288);
        u32x4 a0; a0.x = v0.x; a0.y = v0.y; a0.z = v1.x; a0.w = v1.y; u32x4 a1; a1.x = v2.x; a1.y = v2.y; a1.z = v3.x; a1.w = v3.y;
        const unsigned char* sfp = base + GO_SF + (16 * eb + c) * 144 + g * 16; const unsigned char* sbp = base + GO_SB + (16 * eb + c) * 144 + g * 16;
        f32x4 acc = {0.f, 0.f, 0.f, 0.f};
        acc = mfma16(__builtin_bit_cast(bf16x8, a0), p0, acc); acc = mfma16(__builtin_bit_cast(bf16x8, a1), p1, acc);
        acc = mfma16(*(const bf16x8*)sfp, qf0, acc); acc = mfma16(*(const bf16x8*)(sfp + 64), qf1, acc);
        acc = mfma16(*(const bf16x8*)sbp, qb0, acc); acc = mfma16(*(const bf16x8*)(sbp + 64), qb1, acc);
        o[eb] = acc; ss += (acc[0] * acc[0] + acc[1] * acc[1]) + (acc[2] * acc[2] + acc[3] * acc[3]);
    }
    ss += __shfl_xor(ss, 16); ss += __shfl_xor(ss, 32);
    const float rstd = rsqrtf(ss * (1.0f / 128.0f) + EPS);
    const float* gain = INP(13) + l * 128 + 4 * g;
    const size_t tok = tok0 + 16 * tb + c;
#pragma unroll
    for (int eb = 0; eb < 8; ++eb) {
        const f32x4 gn = *(const f32x4*)(gain + 16 * eb);
        const u32x2 gr = *(const u32x2*)(GR + tok * 512 + h * 128 + 16 * eb + 4 * g);
        const float r0 = bflo(gr.x), r1 = bfhi(gr.x), r2 = bflo(gr.y), r3 = bfhi(gr.y);
        u32x2 w; w.x = pk2(o[eb][0] * rstd * gn[0] * silu_f(r0), o[eb][1] * rstd * gn[1] * silu_f(r1)); w.y = pk2(o[eb][2] * rstd * gn[2] * silu_f(r2), o[eb][3] * rstd * gn[3] * silu_f(r3));
        *(u32x2*)(MIX + tok * 1024 + 512 + h * 128 + 16 * eb + 4 * g) = w;
    }
}
DI int go_item(bool xl, int xq, int k, int half) { const int idx = 2 * k + half; return xl ? ((((xq << 2) | (idx >> 6)) << 6) | (idx & 63)) : idx; }
DI void gla_out_phase(int l, unsigned char* ldsb, int tid, int wave, int lane, bool xl, int xq, int k0, int kend, int kstep) {
    const int half = wave >> 2, tb = wave & 3, t256 = tid & 255;
    unsigned char* base = ldsb + half * GO_ITEM;
    if (k0 >= kend) return;
    GoStage st; go_gload(st, go_item(xl, xq, k0, half), t256, tb, lane);
    for (int k = k0; k < kend; k += kstep) {
        go_lwrite(st, base, t256);
        bf16x8 qq[4] = {st.q[0], st.q[1], st.q[2], st.q[3]};
        __syncthreads();
        if (k + kstep < kend) go_gload(st, go_item(xl, xq, k + kstep, half), t256, tb, lane);
        SCHED_FENCE();
        go_compute(l, base, qq, go_item(xl, xq, k, half), tb, lane);
        __syncthreads();
    }
}

DI void na_stage_rpb(int l, float* rpbs, int tid) {
    const float* rpb = INP(7) + (size_t)l * 8 * 465;
    for (int i = tid; i < 8 * 465; i += NWAVES * 64) rpbs[i] = rpb[i];
    __syncthreads();
}
DI void na_item(const Args& A, int l, float* nss, const float* rpbs, int item, int h, int lane) {
    unsigned char* R = WSP() + WS_R;
    const bf16* QK = (const bf16*)(R + R_QKNA); const bf16* VT = (const bf16*)(R + R_VT); bf16* MIX = (bf16*)(R + R_MIX);
    const float* rpb = rpbs + h * 465;
    const int c = lane & 15, g = lane >> 4;
    const int j = item & 3, r = (item >> 2) & 63, b = item >> 8;
    const int rs = min(max(r - 4, 0), 56), c0 = min(max(16 * j - 8, 0), 32);
    const size_t tokq = (size_t)b * SEQ + r * 64 + 16 * j + c;
    const bf16x8 q0 = ld16(QK + tokq * 1024 + h * 64 + 8 * g), q1 = ld16(QK + tokq * 1024 + h * 64 + 32 + 8 * g);
    const bf16* kbase = QK + ((size_t)b * SEQ + rs * 64 + c0 + c) * 1024 + 512 + h * 64 + 8 * g;
    const bf16* vbase = VT + ((size_t)((b * SEQ + rs * 64 + c0 + 4 * g) >> 3) * 1024 + h * 64 + c) * 8 + 4 * (g & 1);
    f32x4 st[8][2];
    bf16x8 kf[2][16];
#pragma unroll
    for (int bb = 0; bb < 2; ++bb)
#pragma unroll
        for (int i = 0; i < 16; ++i) kf[bb][i] = ld16(kbase + (size_t)(4 * bb + (i >> 2)) * 65536 + ((i >> 1) & 1) * 16384 + (i & 1) * 32);
    SCHED_FENCE();
    u32x2 vf[2][16];
#pragma unroll
    for (int bb = 0; bb < 2; ++bb) {
#pragma unroll
        for (int t = 0; t < 8; ++t) {
            f32x4 s = {0.f, 0.f, 0.f, 0.f}; s = mfma16(kf[bb][2 * t], q0, s); s = mfma16(kf[bb][2 * t + 1], q1, s); st[4 * bb + (t >> 1)][t & 1] = s;
        }
        SCHED_FENCE();
        if (bb == 0) {
#pragma unroll
            for (int i = 0; i < 16; ++i) vf[0][i] = *(const u32x2*)(vbase + (size_t)(i >> 3) * 65536 + 128 * ((i >> 1) & 3) + (i & 1) * 16384);
            SCHED_FENCE();
        }
    }
    const int qc = 16 * j + c, cs = min(max(qc - 8, 0), 48);
    float mx = -3.0e38f;
#pragma unroll
    for (int w = 0; w < 8; ++w) {
        const float* rp = rpb + (rs + w - r + 7) * 31;
#pragma unroll
        for (int hf = 0; hf < 2; ++hf)
#pragma unroll
            for (int i = 0; i < 4; ++i) {
                const int kc = c0 + 16 * hf + 4 * g + i; const bool valid = (kc >= cs) && (kc < cs + 16);
                const int dc = min(max(kc - qc + 15, 0), 30);
                const float bv = rp[dc];
                const float s = valid ? st[w][hf][i] * 0.125f + bv : -1.0e30f;
                st[w][hf][i] = s; mx = fmaxf(mx, s);
            }
    }
    mx = fmaxf(mx, __shfl_xor(mx, 16)); mx = fmaxf(mx, __shfl_xor(mx, 32));
    float sum = 0.f;
#pragma unroll
    for (int w = 0; w < 8; ++w)
#pragma unroll
        for (int hf = 0; hf < 2; ++hf)
#pragma unroll
            for (int i = 0; i < 4; ++i) { const float p = __expf(st[w][hf][i] - mx); st[w][hf][i] = p; sum += p; }
    sum += __shfl_xor(sum, 16); sum += __shfl_xor(sum, 32);
    f32x4 o[4];
#pragma unroll
    for (int db = 0; db < 4; ++db) o[db] = (f32x4){0.f, 0.f, 0.f, 0.f};
#pragma unroll
    for (int wp = 0; wp < 4; ++wp) {
        if (wp < 3) {
#pragma unroll
            for (int i = 0; i < 16; ++i) vf[(wp + 1) & 1][i] = *(const u32x2*)(vbase + (size_t)(2 * wp + 2 + (i >> 3)) * 65536 + 128 * ((i >> 1) & 3) + (i & 1) * 16384);
        }
        SCHED_FENCE();
#pragma unroll
        for (int ww = 0; ww < 2; ++ww) {
            const bf16x8 p = pack8(st[2 * wp + ww][0], st[2 * wp + ww][1]);
#pragma unroll
            for (int db = 0; db < 4; ++db) {
                const u32x2 lo = vf[wp & 1][8 * ww + 2 * db], hi = vf[wp & 1][8 * ww + 2 * db + 1];
                u32x4 v; v.x = lo.x; v.y = lo.y; v.z = hi.x; v.w = hi.y;
                o[db] = mfma16(__builtin_bit_cast(bf16x8, v), p, o[db]);
            }
        }
        SCHED_FENCE();
    }
    const float inv = 1.0f / sum; float ss = 0.f;
#pragma unroll
    for (int db = 0; db < 4; ++db) { o[db] = o[db] * inv; ss += (o[db][0] * o[db][0] + o[db][1] * o[db][1]) + (o[db][2] * o[db][2] + o[db][3] * o[db][3]); }
    ss += __shfl_xor(ss, 16); ss += __shfl_xor(ss, 32);
    if (g == 0) nss[h * 16 + c] = ss;
    __syncthreads();
    float tot = 0.f;
#pragma unroll
    for (int hh = 0; hh < 8; ++hh) tot += nss[hh * 16 + c];
    const float rstd = rsqrtf(tot * (1.0f / 512.0f) + EPS);
    const float* gain = INP(8) + l * 512 + h * 64 + 4 * g;
#pragma unroll
    for (int db = 0; db < 4; ++db) {
        const f32x4 gn = *(const f32x4*)(gain + 16 * db);
        u32x2 w; w.x = pk2(o[db][0] * rstd * gn[0], o[db][1] * rstd * gn[1]); w.y = pk2(o[db][2] * rstd * gn[2], o[db][3] * rstd * gn[3]);
        *(u32x2*)(MIX + tokq * 1024 + h * 64 + 16 * db + 4 * g) = w;
    }
    __syncthreads();
}

struct NaKV { bf16x8 k[4]; u32x2 v[8]; };
DI NaKV na_load_kv(const bf16* kbase, const bf16* vbase, int krel) {
    NaKV f;
#pragma unroll
    for (int i = 0; i < 4; ++i) f.k[i] = ld16(kbase + (size_t)krel * 65536 + (i >> 1) * 16384 + (i & 1) * 32);
#pragma unroll
    for (int i = 0; i < 8; ++i) f.v[i] = *(const u32x2*)(vbase + (size_t)krel * 65536 + 128 * (i >> 1) + (i & 1) * 16384);
    return f;
}
DI void na_pair(const NaKV& f, bf16x8 q0, bf16x8 q1, const float* rp  , const int (&dcv)[8], unsigned vmask, float& m, float& l, f32x4 (&o)[4]) {
    f32x4 s0 = {0.f, 0.f, 0.f, 0.f}, s1 = {0.f, 0.f, 0.f, 0.f};
    s0 = mfma16(f.k[0], q0, s0); s0 = mfma16(f.k[1], q1, s0);
    s1 = mfma16(f.k[2], q0, s1); s1 = mfma16(f.k[3], q1, s1);
    float sv[8]; float mx = -1.0e30f;
#pragma unroll
    for (int e = 0; e < 8; ++e) {
        const float raw = e < 4 ? s0[e] : s1[e - 4];
        const float bv = rp[dcv[e]];
        sv[e] = ((vmask >> e) & 1u) ? raw * 0.125f + bv : -1.0e30f;
        mx = fmaxf(mx, sv[e]);
    }
    mx = fmaxf(mx, __shfl_xor(mx, 16)); mx = fmaxf(mx, __shfl_xor(mx, 32));
    const float mn = fmaxf(m, mx), alpha = __expf(m - mn); m = mn;
    float ps = 0.f; f32x4 p0, p1;
#pragma unroll
    for (int e = 0; e < 4; ++e) { p0[e] = __expf(sv[e] - mn); p1[e] = __expf(sv[4 + e] - mn); ps += p0[e] + p1[e]; }
    l = l * alpha + ps;
    const bf16x8 p = pack8(p0, p1);
#pragma unroll
    for (int db = 0; db < 4; ++db) {
        u32x4 v; v.x = f.v[2 * db].x; v.y = f.v[2 * db].y; v.z = f.v[2 * db + 1].x; v.w = f.v[2 * db + 1].y;
        o[db] = mfma16(__builtin_bit_cast(bf16x8, v), p, o[db] * alpha);
    }
}
DI void na_strip(const Args& A, int l, float* nss, const float* rpbs, int item, int h, int lane) {
    unsigned char* R = WSP() + WS_R;
    const bf16* QK = (const bf16*)(R + R_QKNA); const bf16* VT = (const bf16*)(R + R_VT); bf16* MIX = (bf16*)(R + R_MIX);
    const float* rpb = rpbs + h * 465;
    const int c = lane & 15, g = lane >> 4;
    const int j = item & 3, r0 = ((item >> 2) & 15) * 4, b = item >> 6;
    const int c0 = min(max(16 * j - 8, 0), 32);
    const int kmin = min(max(r0 - 4, 0), 56), kmax = min(max(r0 + 3 - 4, 0), 56) + 7, nrows = kmax - kmin + 1;
    const int qc = 16 * j + c, cs = min(max(qc - 8, 0), 48);
    int dcv[8]; unsigned vmask = 0u;
#pragma unroll
    for (int e = 0; e < 8; ++e) { const int kc = c0 + 16 * (e >> 2) + 4 * g + (e & 3); if (kc >= cs && kc < cs + 16) vmask |= 1u << e; dcv[e] = min(max(kc - qc + 15, 0), 30); }
    bf16x8 q0[4], q1[4];
#pragma unroll
    for (int i = 0; i < 4; ++i) { const bf16* qp = QK + ((size_t)b * SEQ + (r0 + i) * 64 + 16 * j + c) * 1024 + h * 64 + 8 * g; q0[i] = ld16(qp); q1[i] = ld16(qp + 32); }
    const bf16* kbase = QK + ((size_t)b * SEQ + kmin * 64 + c0 + c) * 1024 + 512 + h * 64 + 8 * g;
    const bf16* vbase = VT + ((size_t)((b * SEQ + kmin * 64 + c0 + 4 * g) >> 3) * 1024 + h * 64 + c) * 8 + 4 * (g & 1);
    float m[4], ls[4]; f32x4 o[4][4];
#pragma unroll
    for (int i = 0; i < 4; ++i) { m[i] = -1.0e30f; ls[i] = 0.f;
#pragma unroll
        for (int db = 0; db < 4; ++db) o[i][db] = (f32x4){0.f, 0.f, 0.f, 0.f}; }
    int rs[4];
#pragma unroll
    for (int i = 0; i < 4; ++i) rs[i] = min(max(r0 + i - 4, 0), 56);
#define NA_ROW(F, KR) do { _Pragma("unroll") for (int i_ = 0; i_ < 4; ++i_) { if ((KR) >= rs[i_] && (KR) <= rs[i_] + 7) na_pair(F, q0[i_], q1[i_], rpb + ((KR) - (r0 + i_) + 7) * 31, dcv, vmask, m[i_], ls[i_], o[i_]); } } while (0)
    NaKV fa = na_load_kv(kbase, vbase, 0), fb;
#pragma unroll 1
    for (int t = 0; t < nrows; t += 2) {
        fb = na_load_kv(kbase, vbase, min(t + 1, nrows - 1));
        SCHED_FENCE();
        NA_ROW(fa, kmin + t);
        SCHED_FENCE();
        fa = na_load_kv(kbase, vbase, min(t + 2, nrows - 1));
        SCHED_FENCE();
        if (t + 1 < nrows) NA_ROW(fb, kmin + t + 1);
        SCHED_FENCE();
    }
#undef NA_ROW
    float ssv[4];
#pragma unroll
    for (int i = 0; i < 4; ++i) {
        float lt = ls[i]; lt += __shfl_xor(lt, 16); lt += __shfl_xor(lt, 32);
        const float inv = 1.0f / lt; float ss = 0.f;
#pragma unroll
        for (int db = 0; db < 4; ++db) { o[i][db] = o[i][db] * inv; ss += (o[i][db][0] * o[i][db][0] + o[i][db][1] * o[i][db][1]) + (o[i][db][2] * o[i][db][2] + o[i][db][3] * o[i][db][3]); }
        ss += __shfl_xor(ss, 16); ss += __shfl_xor(ss, 32);
        ssv[i] = ss;
        if (g == 0) nss[(i * 8 + h) * 16 + c] = ss;
    }
    __syncthreads();
    const float* gain = INP(8) + l * 512 + h * 64 + 4 * g;
#pragma unroll
    for (int i = 0; i < 4; ++i) {
        float tot = 0.f;
#pragma unroll
        for (int hh = 0; hh < 8; ++hh) tot += nss[(i * 8 + hh) * 16 + c];
        const float rstd = rsqrtf(tot * (1.0f / 512.0f) + EPS);
        const size_t tokq = (size_t)b * SEQ + (r0 + i) * 64 + 16 * j + c;
#pragma unroll
        for (int db = 0; db < 4; ++db) {
            const f32x4 gn = *(const f32x4*)(gain + 16 * db);
            u32x2 w; w.x = pk2(o[i][db][0] * rstd * gn[0], o[i][db][1] * rstd * gn[1]); w.y = pk2(o[i][db][2] * rstd * gn[2], o[i][db][3] * rstd * gn[3]);
            *(u32x2*)(MIX + tokq * 1024 + h * 64 + 16 * db + 4 * g) = w;
        }
    }
    (void)ssv;
    __syncthreads();
}

#define XB_TMO      128
#define XB_XCNT(j)  (256  + 64 * (j))
#define XB_XSUB(j)  (1280 + 64 * (j))
#define XB_XGEN(j)  (2304 + 64 * (j))
#define XB_TOP      3328
#define XB_TOPGEN   3392
#define XCD_BAR_WORDS 3456
#define XB_SPIN_CAP (1u << 18)

__device__ __forceinline__ unsigned xb_ld(unsigned* p)              { return __hip_atomic_load(p, __ATOMIC_RELAXED, __HIP_MEMORY_SCOPE_AGENT); }
__device__ __forceinline__ unsigned xb_add(unsigned* p, unsigned v) { return __hip_atomic_fetch_add(p, v, __ATOMIC_RELAXED, __HIP_MEMORY_SCOPE_AGENT); }
__device__ __forceinline__ unsigned xb_xcc_id() { return (unsigned)__builtin_amdgcn_s_getreg((3 << 11) | 20) & 0xFu; }
#define XB_SPIN(cond, bar) do { unsigned _sp = 0; while (cond) { __builtin_amdgcn_s_sleep(1); \
    if ((++_sp & 255u) == 0u) { if (xb_ld(&(bar)[XB_TMO])) break; if (_sp > XB_SPIN_CAP) { atomicAdd(&(bar)[XB_TMO], 1u); break; } } } } while (0)

struct XcdBarrier {
    unsigned* bar; unsigned x;
    volatile LAS unsigned* st;
};

__device__ __forceinline__ XcdBarrier xcd_barrier_post(unsigned* bar, volatile LAS unsigned* st) {
    XcdBarrier b; b.bar = bar; b.x = xb_xcc_id(); b.st = st;
    if (threadIdx.x == 0) (void)xb_add(&bar[XB_XCNT(b.x)], 1u);
    return b;
}
__device__ __forceinline__ void xcd_barrier_complete(unsigned* bar, unsigned x, unsigned& nloc, unsigned& nx) {
    const unsigned G = gridDim.x * gridDim.y * gridDim.z;
    unsigned sum, cnt, mine, sp = 0u;
    for (;;) {
        sum = 0u; cnt = 0u; mine = 0u;
#pragma unroll
        for (unsigned j = 0; j < 16; ++j) { const unsigned c = xb_ld(&bar[XB_XCNT(j)]); sum += c; cnt += (c > 0u) ? 1u : 0u; mine = (j == x) ? c : mine; }
        if (sum == G) break;
        __builtin_amdgcn_s_sleep(1);
        if ((++sp & 255u) == 0u) { if (xb_ld(&bar[XB_TMO])) break; if (sp > XB_SPIN_CAP) { atomicAdd(&bar[XB_TMO], 1u); break; } }
    }
    nloc = mine > 0u ? mine : 1u; nx = cnt > 0u ? cnt : 1u;
}

__device__ __forceinline__ void xcd_barrier(const XcdBarrier& b) {
    asm volatile("s_waitcnt vmcnt(0)" ::: "memory");
    __syncthreads();
    if (threadIdx.x == 0) {
        unsigned* bar = b.bar;
        __builtin_amdgcn_s_waitcnt(0);
        unsigned nloc = b.st[0], nx = b.st[1];
        if (nloc == 0u) { xcd_barrier_complete(bar, b.x, nloc, nx); b.st[0] = nloc; b.st[1] = nx; }
        const unsigned old = xb_add(&bar[XB_XSUB(b.x)], 1u);
        const unsigned gen = old / nloc;
        if (old + 1u == (gen + 1u) * nloc) {
            __builtin_amdgcn_fence(__ATOMIC_RELEASE, "agent");
            asm volatile("s_waitcnt vmcnt(0)" ::: "memory");
            const unsigned og = xb_add(&bar[XB_TOP], 1u);
            const unsigned tg = og / nx;
            if (og + 1u == (tg + 1u) * nx) xb_add(&bar[XB_TOPGEN], 1u);
            else XB_SPIN(xb_ld(&bar[XB_TOPGEN]) == tg, bar);
            __builtin_amdgcn_fence(__ATOMIC_ACQUIRE, "agent");
            xb_add(&bar[XB_XGEN(b.x)], 1u);
            asm volatile("s_waitcnt vmcnt(0)" ::: "memory");
        } else {
            XB_SPIN(xb_ld(&bar[XB_XGEN(b.x)]) == gen, bar);
            __builtin_amdgcn_fence(__ATOMIC_ACQUIRE, "agent");
            asm volatile("s_waitcnt vmcnt(0)" ::: "memory");
        }
    }
    __syncthreads();
}

#define XL_SUB(j) (3456 + 64 * (j))
#define XL_GEN(j) (4480 + 64 * (j))
__device__ __forceinline__ void xcd_local_barrier(unsigned* bar, unsigned x, unsigned nloc) {
    asm volatile("s_waitcnt vmcnt(0)" ::: "memory");
    __syncthreads();
    if (threadIdx.x == 0) {
        const unsigned old = xb_add(&bar[XL_SUB(x)], 1u); const unsigned gen = old / nloc;
        if (old + 1u == (gen + 1u) * nloc) xb_add(&bar[XL_GEN(x)], 1u);
        else XB_SPIN(xb_ld(&bar[XL_GEN(x)]) == gen, bar);
        __builtin_amdgcn_fence(__ATOMIC_ACQUIRE, "agent");
        asm volatile("s_waitcnt vmcnt(0)" ::: "memory");
    }
    __syncthreads();
}
#ifndef REP_PRO
#define REP_PRO 1
#define REP_SYNC 1
#define REP_GEMM 1
#define REP_PREP 1
#define REP_SCAN 1
#define REP_OUT 1
#define REP_NA 1
#endif
#define LAUNDER_TID int t_ = threadIdx.x; asm volatile("" : "+v"(t_)); const int tid = t_, lane = t_ & 63, wave = __builtin_amdgcn_readfirstlane(t_ >> 6); (void)tid; (void)lane; (void)wave;
#define GSYNC() do { for (int r_ = 0; r_ < REP_SYNC; ++r_) xcd_barrier(xbar); } while (0)
#define LSYNC() do { for (int r_ = 0; r_ < REP_SYNC; ++r_) { if (xl) xcd_local_barrier(xbar.bar, xbar.x, (unsigned)(G >> 3)); else xcd_barrier(xbar); } } while (0)
__global__ void __launch_bounds__(NWAVES * 64, 2) fwd_megakernel(Args A) {
    extern __shared__ __attribute__((aligned(16))) unsigned char lds[];
    cg::grid_group grid = cg::this_grid();
    const int G = gridDim.x, bx = blockIdx.x;
    LAS unsigned char* ldsg = (LAS unsigned char*)lds;
    unsigned char* ws = WSP(); unsigned char* R = ws + WS_R;
    bf16* XB = (bf16*)(ws + WS_XB); float* SSQ = (float*)(ws + WS_SSQ); float* X = OUTP();
    bf16* H = (bf16*)(R + R_H); bf16* MIX = (bf16*)(R + R_MIX);

    if (threadIdx.x < 16) ((volatile LAS unsigned*)(ldsg + (LDS_BYTES - 128)))[threadIdx.x] = 0u;
    __syncthreads();
    volatile LAS unsigned* ldsw = (volatile LAS unsigned*)(ldsg + (LDS_BYTES - 128));
    XcdBarrier xbar; xbar.bar = (unsigned*)ws; xbar.x = xb_xcc_id(); xbar.st = ldsw;
    if (threadIdx.x == 0) ldsw[4] = xb_add(&xbar.bar[XB_XCNT(xbar.x)], 1u);
    for (int rep = 0; rep < REP_PRO; ++rep) { LAUNDER_TID prologue(A, lds, wave, lane); }
    if (G > (1 << 20)) grid.sync();
    xcd_barrier(xbar);
    if (threadIdx.x == 0) {
        bool ok = (G % 8 == 0);
        for (unsigned j = 0; j < 16; ++j) { const unsigned cn = xb_ld(&xbar.bar[XB_XCNT(j)]); ok = ok && (cn == (j < 8 ? (unsigned)(G / 8) : 0u)); }
        ldsw[5] = ok ? (xbar.x + 8u * ldsw[4]) : (unsigned)bx; ldsw[6] = ok ? 1u : 0u;
    }
    __syncthreads();
    const int vcu = __builtin_amdgcn_readfirstlane((int)ldsw[5]);
    const bool xl = __builtin_amdgcn_readfirstlane((int)ldsw[6]) != 0;
    const int xq = vcu & 7, rk = vcu >> 3, nl = G >> 3;

#pragma unroll 1
    for (int l = 0; l < 2; ++l) {
        unsigned char* wb = ws + WS_W + (size_t)l * WL;
        for (int rep = 0; rep < REP_GEMM; ++rep) {
            pg8::Gemm gm{XB, (const bf16*)(wb + OW_GU1), M, 2 * DFF, DM}; pg8::StaticOrder S; S.init(M, 2 * DFF, G, vcu);
            EpiSwiGLU E{H, SSQ};
            pg8::gemm_phase<EpiSwiGLU, pg8::StaticOrder, true, true>(ldsg, gm, S, E);
        }
        LSYNC();
        for (int rep = 0; rep < REP_GEMM; ++rep) {
            pg8::Gemm gm{H, (const bf16*)(wb + OW_D1), M, DM, DFF}; pg8::StaticOrder S; S.init(M, DM, G, vcu);
            EpiResid E{(l == 0 && rep == 0) ? INP(0) : (const float*)nullptr, XB, SSQ, rep == 0 ? 0.5f : 0.f};
            pg8::gemm_phase<EpiResid, pg8::StaticOrder, true, true>(ldsg, gm, S, E);
        }
        GSYNC();
        for (int rep = 0; rep < REP_GEMM; ++rep) {
            pg8::Gemm gm{XB, (const bf16*)(wb + OW_INA), M, 2304, DM}; pg8::StaticOrder S; S.init(M, 2304, G, vcu);
            EpiProj E{(bf16*)(R + R_QKNA), (bf16*)(R + R_GQK), (bf16*)(R + R_GR), (bf16*)(R + R_CODES), SSQ};
            pg8::gemm_phase<EpiProj, pg8::StaticOrder, true, true>(ldsg, gm, S, E);
            pg8::Gemm gv{(const bf16*)(wb + OW_INB), XB, 1024, M, DM}; pg8::StaticOrder S2; S2.init(1024, M, G, vcu);
            EpiVT E2{(bf16*)(R + R_VT), SSQ};
            pg8::gemm_phase<EpiVT, pg8::StaticOrder, true, true>(ldsg, gv, S2, E2);
        }
        LSYNC();
        for (int rep = 0; rep < REP_PREP; ++rep) { LAUNDER_TID int ph_ = -1; for (int k = xl ? rk : vcu; k < (xl ? 256 : 2048); k += (xl ? nl : G)) { const int it = xl ? ((((xq << 2) | (k >> 6)) << 6) | (k & 63)) : k; const int h_ = (it >> 6) & 3; gla_prep_item(A, l, lds, it, tid, h_ != ph_); ph_ = h_; } }
        LSYNC();
        for (int rep = 0; rep < REP_SCAN; ++rep) { LAUNDER_TID for (int k = xl ? rk : vcu; k < (xl ? 32 : 256); k += (xl ? nl : G)) gla_scan_item_lds(lds, xl ? ((((k >> 4) * 32 + xq * 4 + ((k >> 2) & 3)) << 2) | (k & 3)) : k, tid, wave, lane); }
        GSYNC();
        for (int rep = 0; rep < REP_OUT; ++rep) { LAUNDER_TID gla_out_phase(l, lds, tid, wave, lane, xl, xq, xl ? rk : vcu, xl ? 128 : 1024, xl ? nl : G); }
        for (int rep = 0; rep < REP_NA; ++rep) { LAUNDER_TID na_stage_rpb(l, (float*)lds + 512, tid); if (G % 8 == 0) { for (int li = vcu >> 3; li < 64; li += (G >> 3)) na_strip(A, l, (float*)lds, (const float*)lds + 512, ((vcu & 7) << 6) | li, wave, lane); } else { for (int it = vcu; it < 512; it += G) na_strip(A, l, (float*)lds, (const float*)lds + 512, it, wave, lane); } }
        GSYNC();
        for (int rep = 0; rep < REP_GEMM; ++rep) {
            pg8::Gemm gm{MIX, (const bf16*)(wb + OW_OUT), M, DM, DM}; pg8::StaticOrder S; S.init(M, DM, G, vcu);
            EpiResid E{nullptr, XB, SSQ, rep == 0 ? 1.0f : 0.f};
            pg8::gemm_phase<EpiResid, pg8::StaticOrder, true, true>(ldsg, gm, S, E);
        }
        LSYNC();
        for (int rep = 0; rep < REP_GEMM; ++rep) {
            pg8::Gemm gm{XB, (const bf16*)(wb + OW_GU2), M, 2 * DFF, DM}; pg8::StaticOrder S; S.init(M, 2 * DFF, G, vcu);
            EpiSwiGLU E{H, SSQ};
            pg8::gemm_phase<EpiSwiGLU, pg8::StaticOrder, true, true>(ldsg, gm, S, E);
        }
        LSYNC();
        for (int rep = 0; rep < REP_GEMM; ++rep) {
            pg8::Gemm gm{H, (const bf16*)(wb + OW_D2), M, DM, DFF}; pg8::StaticOrder S; S.init(M, DM, G, vcu);
            EpiResid E{nullptr, XB, SSQ, rep == 0 ? 0.5f : 0.f};
            pg8::gemm_phase<EpiResid, pg8::StaticOrder, true, true>(ldsg, gm, S, E);
        }
        LSYNC();
    }
    {
        LAUNDER_TID
        const float* gn = INP(19);
        const int gw = vcu * NWAVES + wave, NGW = G * NWAVES;
        for (int m = xl ? xq * 4096 + rk * NWAVES + wave : gw; m < (xl ? (xq + 1) * 4096 : M); m += (xl ? nl * NWAVES : NGW)) {
            float s = lane < 16 ? SSQ[(size_t)m * 16 + lane] : 0.f; s = wave_sum(s);
            const float rstd = rsqrtf(s * (1.0f / DM) + EPS);
            f32x4* xr = (f32x4*)(X + (size_t)m * DM) + lane; const f32x4* gr = (const f32x4*)gn + lane; const u32x2* xb = (const u32x2*)(XB + (size_t)m * DM) + lane;
#pragma unroll
            for (int j = 0; j < 4; ++j) { const u32x2 bb = xb[64 * j]; const f32x4 v = {bflo(bb.x), bfhi(bb.x), bflo(bb.y), bfhi(bb.y)}; xr[64 * j] = v * rstd * gr[64 * j]; }
        }
    }
}

extern "C" void kernel_launch(void* const* d_in, const int* in_sizes, int n_in, void* d_out, int out_size, void* d_ws, size_t ws_size, hipStream_t stream) {
    static int grid = 0;
    if (grid == 0) {
        if (n_in != 20 || out_size != M * DM || ws_size < WS_END) { fprintf(stderr, "kernel_launch: unexpected shapes / workspace (n_in %d out %d ws %zu need %zu)\n", n_in, out_size, ws_size, (size_t)WS_END); grid = -1; return; }
        int dev = 0, cus = 0, per_cu = 0;
        hipGetDevice(&dev); hipDeviceGetAttribute(&cus, hipDeviceAttributeMultiprocessorCount, dev);
        hipFuncSetAttribute((const void*)fwd_megakernel, hipFuncAttributeMaxDynamicSharedMemorySize, LDS_BYTES);
        hipOccupancyMaxActiveBlocksPerMultiprocessor(&per_cu, (const void*)fwd_megakernel, NWAVES * 64, LDS_BYTES);
        if (per_cu < 1) per_cu = 1;
        grid = cus * per_cu;
        (void)hipGetLastError();
    }
    if (grid < 0) return;
    Args a{};
    for (int i = 0; i < 20; ++i) a.in[i] = (const float*)d_in[i];
    a.out = (float*)d_out; a.ws = (unsigned char*)d_ws;
    if (hipMemsetAsync(d_ws, 0, 32768, stream) != hipSuccess) { fprintf(stderr, "memset failed\n"); return; }
    void* args[] = {&a};
    hipError_t e = hipLaunchCooperativeKernel((const void*)fwd_megakernel, dim3(grid), dim3(NWAVES * 64), args, LDS_BYTES, stream);
    if (e != hipSuccess) fprintf(stderr, "cooperative launch failed: %s (grid %d)\n", hipGetErrorString(e), grid);
}
```

```cpp
#include <hip/hip_runtime.h>
#include <cstdio>
#include <cstdint>
namespace pg8 {
#define PG8_LAS __attribute__((address_space(3)))
typedef unsigned short bf16_t;
typedef short bf16x8 __attribute__((ext_vector_type(8)));
typedef float f32x4 __attribute__((ext_vector_type(4)));
typedef unsigned u32x4 __attribute__((ext_vector_type(4)));
constexpr int BM = 256, BK = 64, HALF = 128, HTB = HALF * BK * 2  , STAGE_BYTES = 8 * HTB, NXCD = 8, WGM = 8;

__host__ __device__ __forceinline__ int lds_byte(int r, int c) { const int st = (r >> 4) * 2 + (c >> 5), rr = r & 15, cc = c & 31, ob = rr * 64 + cc * 2; return st * 1024 + (ob ^ (((ob >> 9) & 1) << 5)); }
__host__ __device__ __forceinline__ void stage_rc(int b, int& R, int& C) { const int st = b / 1024, sb = b % 1024, swz = sb ^ (((sb >> 9) & 1) << 5); R = (st >> 1) * 16 + swz / 64; C = (st & 1) * 32 + (swz % 64) / 2; }
__host__ __device__ __forceinline__ int perm32(int rho) { const int n = rho >> 4, i = rho & 15; return 8 * (i >> 2) + 4 * n + (i & 3); }

struct Unit { int pm, pn; };
struct Gemm { const bf16_t* A; const bf16_t* Bt; int M, N, K; };

struct StaticOrder {
    int nM, nN, nwg, G, c;
    __host__ __device__ void init(int M, int N, int G_, int c_) { nM = M / BM; nN = N / BM; nwg = nM * nN; G = G_; c = c_; }
    __host__ __device__ bool next(int i, Unit& u) const {
        const long L = (long)i * G + c; if (L >= nwg) return false;
        int wgid = (int)L; { const int q = nwg / NXCD, r = nwg % NXCD, xcd = wgid % NXCD, off = wgid / NXCD; wgid = (xcd < r ? xcd * (q + 1) : r * (q + 1) + (xcd - r) * q) + off; }
        const int nig = WGM * nN, gid = wgid / nig, fm = gid * WGM, gsz = (nM - fm) < WGM ? (nM - fm) : WGM;
        u.pm = fm + ((wgid % nig) % gsz); u.pn = (wgid % nig) / gsz; return true;
    }
    __device__ __forceinline__ void a_ready(const Unit&) const {}
    __device__ __forceinline__ void done(const Unit&) const {}
};

typedef __bf16 bf16x2_cv_t __attribute__((ext_vector_type(2)));
typedef float f32x2_cv_t __attribute__((ext_vector_type(2)));
__device__ __forceinline__ unsigned cvt_pk_bf16(float lo, float hi) { const f32x2_cv_t v = {lo, hi}; const bf16x2_cv_t b = __builtin_convertvector(v, bf16x2_cv_t); return __builtin_bit_cast(unsigned, b); }
typedef float f32x2 __attribute__((ext_vector_type(2)));
template <class Epi, class Sched, bool ALIGN_EPI = false, bool SP2 = false>
__device__ __forceinline__ void gemm_phase(PG8_LAS unsigned char* lds, const Gemm g, const Sched& S, const Epi& E) {
    int tid_ = threadIdx.x; asm volatile("" : "+v"(tid_));
    const int tid = tid_, wid = __builtin_amdgcn_readfirstlane(tid >> 6), lane = tid & 63, wr = wid >> 2, wc = wid & 3, fr = lane & 15, fq = lane >> 4;
    const int K = g.K, nt = K / BK;
    unsigned voffA[2], voffB[2];
#pragma unroll
    for (int i = 0; i < 2; ++i) { int R, C; stage_rc(tid * 16 + i * 8192, R, C); const int Rb = Epi::PERM ? ((R & ~31) + perm32(R & 31)) : R;
        voffA[i] = (unsigned)(R * K + C) * 2u; voffB[i] = (unsigned)(Rb * K + C) * 2u; }
    const size_t kstep = (size_t)(BK * 2);
    const size_t hstep = (size_t)HALF * K * 2;
    const size_t tstep = 2 * hstep;
    const unsigned ldsw = (unsigned)wid * 1024u;
    const int aoff = lds_byte(wr * 64 + fr, fq * 8), boff = lds_byte(wc * 32 + fr, fq * 8);
#define PG8_SA(b, h) (((b) * 2 + (h)) * HTB)
#define PG8_SB(b, h) ((4 + (b) * 2 + (h)) * HTB)
#define PG8_STAGE(bufoff, gbase, voff) do { _Pragma("unroll") for (int _i = 0; _i < 2; ++_i) \
        __builtin_amdgcn_global_load_lds((const unsigned*)((const char*)(gbase) + (voff)[_i]), (PG8_LAS unsigned*)(lds + (bufoff) + ldsw + _i * 8192), 16, 0, 0); } while (0)
#define PG8_LDA(dst, b, h) do { _Pragma("unroll") for (int m = 0; m < 4; ++m) _Pragma("unroll") for (int k = 0; k < 2; ++k) dst[m][k] = *(const PG8_LAS bf16x8*)(lds + PG8_SA(b, h) + aoff + m * 2048 + k * 1024); } while (0)
#define PG8_LDB(dst, b, h) do { _Pragma("unroll") for (int n = 0; n < 2; ++n) _Pragma("unroll") for (int k = 0; k < 2; ++k) dst[n][k] = *(const PG8_LAS bf16x8*)(lds + PG8_SB(b, h) + boff + n * 2048 + k * 1024); } while (0)
#define PG8_MMA(ai, bj, At, Bt) do { __builtin_amdgcn_s_setprio(1); _Pragma("unroll") for (int m = 0; m < 4; ++m) _Pragma("unroll") for (int n = 0; n < 2; ++n) _Pragma("unroll") for (int k = 0; k < 2; ++k) \
        acc[ai][bj][m][n] = __builtin_amdgcn_mfma_f32_16x16x32_bf16(Bt[n][k], At[m][k], acc[ai][bj][m][n], 0, 0, 0); __builtin_amdgcn_s_setprio(0); } while (0)
#define PG8_WAIT_V(n) asm volatile("s_waitcnt vmcnt(" #n ")" ::: "memory")
#define PG8_WAIT_L(n) asm volatile("s_waitcnt lgkmcnt(" #n ")" ::: "memory")
#define PG8_BAR __builtin_amdgcn_s_barrier()
#define PG8_SCHED __builtin_amdgcn_sched_barrier(0)
    Unit cur, nxt; int ui = 0;
    if (!S.next(0, cur)) return;
    f32x4 acc[2][2][4][2];
#pragma unroll
    for (int a = 0; a < 2; ++a)
#pragma unroll
        for (int b = 0; b < 2; ++b)
#pragma unroll
            for (int m = 0; m < 4; ++m)
#pragma unroll
                for (int n = 0; n < 2; ++n) acc[a][b][m][n] = (f32x4){0.f, 0.f, 0.f, 0.f};
    bf16x8 At[4][2], B0[2][2], B1[2][2];
    const char* cA = (const char*)g.A + (size_t)cur.pm * tstep; const char* cB = (const char*)g.Bt + (size_t)cur.pn * tstep;
    S.a_ready(cur);
    if constexpr (SP2) {
        PG8_STAGE(PG8_SB(0, 0), cB, voffB); PG8_STAGE(PG8_SB(0, 1), cB + hstep, voffB); PG8_STAGE(PG8_SA(0, 0), cA, voffA); PG8_STAGE(PG8_SA(0, 1), cA + hstep, voffA);
        if (wr == 1) PG8_BAR;
        PG8_WAIT_V(2); PG8_BAR;
        PG8_STAGE(PG8_SB(1, 0), cB + kstep, voffB); PG8_STAGE(PG8_SA(1, 0), cA + kstep, voffA); PG8_STAGE(PG8_SB(1, 1), cB + hstep + kstep, voffB);
        PG8_WAIT_V(6); PG8_BAR;
    } else {
        PG8_STAGE(PG8_SB(0, 0), cB, voffB); PG8_STAGE(PG8_SA(0, 0), cA, voffA); PG8_STAGE(PG8_SB(0, 1), cB + hstep, voffB); PG8_STAGE(PG8_SA(0, 1), cA + hstep, voffA);
        if (wr == 1) PG8_BAR;
        PG8_WAIT_V(4); PG8_BAR;
        PG8_STAGE(PG8_SB(1, 0), cB + kstep, voffB); PG8_STAGE(PG8_SA(1, 0), cA + kstep, voffA); PG8_STAGE(PG8_SB(1, 1), cB + hstep + kstep, voffB);
        PG8_WAIT_V(6); PG8_BAR;
    }
    for (;;) {
        const bool has_next = S.next(ui + 1, nxt);
        const char* nA = has_next ? (const char*)g.A + (size_t)nxt.pm * tstep : cA; const char* nB = has_next ? (const char*)g.Bt + (size_t)nxt.pn * tstep : cB;
        for (int t = 0; t < nt; t += 2) {
            const bool last = (t == nt - 2);
            const char* a1 = cA + (size_t)(t + 1) * kstep;
            const char* a2 = last ? nA : cA + (size_t)(t + 2) * kstep; const char* b2 = last ? nB : cB + (size_t)(t + 2) * kstep;
            const char* a3 = a2 + kstep; const char* b3 = b2 + kstep;
            if (last && has_next) S.a_ready(nxt);
            if constexpr (SP2) {
            PG8_LDB(B0, 0, 0); PG8_LDB(B1, 0, 1); PG8_SCHED; PG8_LDA(At, 0, 0); PG8_STAGE(PG8_SA(1, 1), a1 + hstep, voffA);
            PG8_WAIT_V(8); PG8_WAIT_L(0); PG8_BAR; PG8_MMA(0, 0, At, B0); PG8_MMA(0, 1, At, B1); PG8_BAR; PG8_SCHED;
            PG8_LDA(At, 0, 1); PG8_STAGE(PG8_SB(0, 0), b2, voffB); PG8_STAGE(PG8_SB(0, 1), b2 + hstep, voffB); PG8_STAGE(PG8_SA(0, 0), a2, voffA);
            PG8_WAIT_V(8); PG8_WAIT_L(0); PG8_BAR; PG8_MMA(1, 0, At, B0); PG8_MMA(1, 1, At, B1); PG8_BAR; PG8_SCHED;
            PG8_LDB(B0, 1, 0); PG8_LDB(B1, 1, 1); PG8_SCHED; PG8_LDA(At, 1, 0); PG8_STAGE(PG8_SA(0, 1), a2 + hstep, voffA);
            PG8_WAIT_V(8); PG8_WAIT_L(0); PG8_BAR; PG8_MMA(0, 0, At, B0); PG8_MMA(0, 1, At, B1); PG8_BAR; PG8_SCHED;
            PG8_LDA(At, 1, 1); PG8_STAGE(PG8_SB(1, 0), b3, voffB); PG8_STAGE(PG8_SB(1, 1), b3 + hstep, voffB); PG8_STAGE(PG8_SA(1, 0), a3, voffA);
            PG8_WAIT_V(8); PG8_WAIT_L(0); PG8_BAR; PG8_MMA(1, 0, At, B0); PG8_MMA(1, 1, At, B1); PG8_BAR; PG8_SCHED;
            } else {
            PG8_LDB(B0, 0, 0); PG8_SCHED; PG8_LDA(At, 0, 0); PG8_STAGE(PG8_SA(1, 1), a1 + hstep, voffA);
            PG8_WAIT_L(8); PG8_BAR; PG8_WAIT_L(0); PG8_MMA(0, 0, At, B0); PG8_BAR; PG8_SCHED;
            PG8_LDB(B1, 0, 1); PG8_STAGE(PG8_SB(0, 0), b2, voffB);
            PG8_BAR; PG8_WAIT_L(0); PG8_MMA(0, 1, At, B1); PG8_BAR;
            PG8_LDA(At, 0, 1); PG8_STAGE(PG8_SA(0, 0), a2, voffA);
            PG8_BAR; PG8_WAIT_L(0); PG8_MMA(1, 0, At, B0); PG8_BAR; PG8_SCHED;
            PG8_STAGE(PG8_SB(0, 1), b2 + hstep, voffB);
            PG8_WAIT_V(6); PG8_BAR; PG8_MMA(1, 1, At, B1); PG8_BAR;
            PG8_LDB(B0, 1, 0); PG8_SCHED; PG8_LDA(At, 1, 0); PG8_STAGE(PG8_SA(0, 1), a2 + hstep, voffA);
            PG8_WAIT_L(8); PG8_BAR; PG8_WAIT_L(0); PG8_MMA(0, 0, At, B0); PG8_BAR; PG8_SCHED;
            PG8_LDB(B1, 1, 1); PG8_STAGE(PG8_SB(1, 0), b3, voffB);
            PG8_BAR; PG8_WAIT_L(0); PG8_MMA(0, 1, At, B1); PG8_BAR;
            PG8_LDA(At, 1, 1); PG8_STAGE(PG8_SA(1, 0), a3, voffA);
            PG8_BAR; PG8_WAIT_L(0); PG8_MMA(1, 0, At, B0); PG8_BAR; PG8_SCHED;
            PG8_STAGE(PG8_SB(1, 1), b3 + hstep, voffB);
            PG8_WAIT_V(6); PG8_BAR; PG8_MMA(1, 1, At, B1); PG8_BAR;
            }
        }
        if constexpr (ALIGN_EPI) { if (wr == 0) PG8_BAR; }
        if constexpr (!Epi::AFTER_DRAIN) { E(acc, cur, wr, wc, fr, fq); S.done(cur); }
        if (!has_next) break;
#pragma unroll
        for (int a = 0; a < 2; ++a)
#pragma unroll
            for (int b = 0; b < 2; ++b)
#pragma unroll
                for (int m = 0; m < 4; ++m)
#pragma unroll
                    for (int n = 0; n < 2; ++n) acc[a][b][m][n] = (f32x4){0.f, 0.f, 0.f, 0.f};
        cur = nxt; cA = nA; cB = nB; ++ui;
        if constexpr (ALIGN_EPI) { if (wr == 1) PG8_BAR; }
    }
    PG8_WAIT_V(0);
    if constexpr (!ALIGN_EPI) { if (wr == 0) PG8_BAR; }
    PG8_BAR;
    if constexpr (Epi::AFTER_DRAIN) { E.fused(acc, cur, wr, wc, fr, fq, lds, wid, lane); S.done(cur); }
#undef PG8_SA
#undef PG8_SB
#undef PG8_STAGE
#undef PG8_LDA
#undef PG8_LDB
#undef PG8_MMA
#undef PG8_WAIT_V
#undef PG8_WAIT_L
#undef PG8_BAR
#undef PG8_SCHED
}
}
#include <hip/hip_cooperative_groups.h>
namespace cg = cooperative_groups;
#define DI __device__ __forceinline__
typedef unsigned short bf16;
typedef float f32x4 __attribute__((ext_vector_type(4)));
typedef short bf16x8 __attribute__((ext_vector_type(8)));
typedef unsigned u32x4 __attribute__((ext_vector_type(4)));
typedef unsigned u32x2 __attribute__((ext_vector_type(2)));
#define LAS __attribute__((address_space(3)))

constexpr int M = 32768, DM = 1024, DFF = 2816, SEQ = 4096;
constexpr float EPS = 1e-6f;
constexpr size_t HM = 512u * 1024u;
constexpr size_t WS_W = 2 * HM, WL = 83 * HM;
constexpr size_t OW_GU1 = 0, OW_D1 = 22 * HM, OW_INA = 33 * HM, OW_INB = 42 * HM, OW_OUT = 46 * HM, OW_GU2 = 50 * HM, OW_D2 = 72 * HM;
constexpr size_t WS_XB = WS_W + 2 * WL, WS_SSQ = WS_XB + 128 * HM, WS_R = WS_SSQ + 4 * HM;
constexpr size_t R_QKNA = 0, R_VT = 128 * HM, R_GR = 256 * HM, R_GP = 320 * HM, R_SBEF = 448 * HM, R_GQK = 576 * HM, R_KT = 640 * HM, R_CODES = 704 * HM, R_DEC = 708 * HM, R_END = 710 * HM;
constexpr size_t R_MIX = 576 * HM, R_H = 0;
constexpr size_t WS_END = WS_R + R_END;
constexpr int LDS_BYTES = 147456;
constexpr int NWAVES = 8;

DI unsigned pk2(float lo, float hi) { return pg8::cvt_pk_bf16(lo, hi); }
DI float bflo(unsigned w) { return __uint_as_float(w << 16); }
DI float bfhi(unsigned w) { return __uint_as_float(w & 0xffff0000u); }
DI bf16x8 ld16(const bf16* p) { return *(const bf16x8*)p; }
DI bf16x8 ld8x2(const bf16* p0, const bf16* p1) { const u32x2 a = *(const u32x2*)p0, b = *(const u32x2*)p1; u32x4 v; v.x = a.x; v.y = a.y; v.z = b.x; v.w = b.y; return __builtin_bit_cast(bf16x8, v); }
DI f32x4 mfma16(bf16x8 a, bf16x8 b, f32x4 c) { return __builtin_amdgcn_mfma_f32_16x16x32_bf16(a, b, c, 0, 0, 0); }
DI bf16x8 pack8(f32x4 a, f32x4 b) { u32x4 v; v.x = pk2(a[0], a[1]); v.y = pk2(a[2], a[3]); v.z = pk2(b[0], b[1]); v.w = pk2(b[2], b[3]); return __builtin_bit_cast(bf16x8, v); }
DI float silu_f(float x) { return x * __builtin_amdgcn_rcpf(1.0f + __expf(-x)); }
DI float wave_sum(float v) {
#pragma unroll
    for (int o = 1; o < 64; o <<= 1) v += __shfl_xor(v, o);
    return v;
}

DI void row_rstd(const float* ssq, int row0, int fq, float (&rs)[2][4]) {
#pragma unroll
    for (int ai = 0; ai < 2; ++ai)
#pragma unroll
        for (int m = 0; m < 4; ++m) {
            const f32x4 v = *(const f32x4*)(ssq + (size_t)(row0 + ai * 128 + m * 16) * 16 + 4 * fq);
            float s = (v[0] + v[1]) + (v[2] + v[3]);
            s += __shfl_xor(s, 16); s += __shfl_xor(s, 32);
            rs[ai][m] = rsqrtf(s * (1.0f / DM) + EPS);
        }
}
struct EpiSwiGLU {
    static constexpr bool PERM = true, AFTER_DRAIN = false;
    bf16* H; const float* ssq;
    DI void operator()(const f32x4 (&acc)[2][2][4][2], const pg8::Unit& u, int wr, int wc, int fr, int fq) const {
        const int row0 = u.pm * 256 + wr * 64 + fr, col0 = u.pn * 128 + wc * 32 + 8 * fq;
        float rs[2][4]; row_rstd(ssq, row0, fq, rs);
#pragma unroll
        for (int ai = 0; ai < 2; ++ai)
#pragma unroll
            for (int m = 0; m < 4; ++m) {
                typedef float f32x2 __attribute__((ext_vector_type(2)));
                const float r = rs[ai][m]; const float r2s = r * r, rls = r * -1.44269504f; const f32x2 r2 = {r2s, r2s}, rl = {rls, rls};
                unsigned hw[4];
#pragma unroll
                for (int q = 0; q < 4; ++q) {
                    const f32x4 gq = acc[ai][0][m][q >> 1], uq = acc[ai][1][m][q >> 1];
                    const f32x2 g2 = {gq[2 * (q & 1)], gq[2 * (q & 1) + 1]}, u2 = {uq[2 * (q & 1)], uq[2 * (q & 1) + 1]};
                    const f32x2 t = g2 * rl; f32x2 e; e.x = __builtin_amdgcn_exp2f(t.x); e.y = __builtin_amdgcn_exp2f(t.y);
                    const f32x2 d = e + 1.0f; f32x2 rc; rc.x = __builtin_amdgcn_rcpf(d.x); rc.y = __builtin_amdgcn_rcpf(d.y);
                    const f32x2 hv = ((g2 * u2) * r2) * rc;
                    hw[q] = pk2(hv.x, hv.y);
                }
                u32x4 w; w.x = hw[0]; w.y = hw[1]; w.z = hw[2]; w.w = hw[3];
                *(u32x4*)(H + (size_t)(row0 + ai * 128 + m * 16) * DFF + col0) = w;
            }
    }
};
struct EpiResid {
    static constexpr bool PERM = true, AFTER_DRAIN = false;
    const float* base32; bf16* XB; float* ssq; float alpha;
    DI void operator()(const f32x4 (&acc)[2][2][4][2], const pg8::Unit& u, int wr, int wc, int fr, int fq) const {
        const int row0 = u.pm * 256 + wr * 64 + fr, col0 = u.pn * 256 + wc * 32 + 8 * fq;
#pragma unroll
        for (int ai = 0; ai < 2; ++ai)
#pragma unroll
            for (int m = 0; m < 4; ++m) {
                const int row = row0 + ai * 128 + m * 16; float ss = 0.f;
#pragma unroll
                for (int bj = 0; bj < 2; ++bj) {
                    const size_t off = (size_t)row * DM + col0 + bj * 128;
                    f32x4 b0, b1;
                    if (base32) { b0 = *(const f32x4*)(base32 + off); b1 = *(const f32x4*)(base32 + off + 4); }
                    else { const u32x4 bb = *(const u32x4*)(XB + off); b0 = (f32x4){bflo(bb.x), bfhi(bb.x), bflo(bb.y), bfhi(bb.y)}; b1 = (f32x4){bflo(bb.z), bfhi(bb.z), bflo(bb.w), bfhi(bb.w)}; }
                    const f32x4 v0 = b0 + acc[ai][bj][m][0] * alpha, v1 = b1 + acc[ai][bj][m][1] * alpha;
                    ss += ((v0[0] * v0[0] + v0[1] * v0[1]) + (v0[2] * v0[2] + v0[3] * v0[3])) + ((v1[0] * v1[0] + v1[1] * v1[1]) + (v1[2] * v1[2] + v1[3] * v1[3]));
                    u32x4 w; w.x = pk2(v0[0], v0[1]); w.y = pk2(v0[2], v0[3]); w.z = pk2(v1[0], v1[1]); w.w = pk2(v1[2], v1[3]);
                    *(u32x4*)(XB + off) = w;
                }
                ss += __shfl_xor(ss, 16); ss += __shfl_xor(ss, 32);
                if (fq == 0) ssq[(size_t)row * 16 + u.pn * 4 + wc] = ss;
                asm volatile("" ::: "memory");
            }
    }
};
struct EpiProj {
    static constexpr bool PERM = true, AFTER_DRAIN = false;
    bf16* QKNA; bf16* GQK; bf16* GR; bf16* CODES; const float* ssq;
    DI void operator()(const f32x4 (&acc)[2][2][4][2], const pg8::Unit& u, int wr, int wc, int fr, int fq) const {
        const int row0 = u.pm * 256 + wr * 64 + fr; const int pn = u.pn;
        float rs[2][4]; row_rstd(ssq, row0, fq, rs);
        bf16* dst; int ld, cb;
        if (pn < 4) { dst = QKNA; ld = 1024; cb = 256 * pn; } else if (pn < 6) { dst = GQK; ld = 512; cb = 256 * (pn - 4); } else if (pn < 8) { dst = GR; ld = 512; cb = 256 * (pn - 6); } else { dst = CODES; ld = 32; cb = 0; }
        const int col0 = cb + wc * 32 + 8 * fq;
#pragma unroll
        for (int ai = 0; ai < 2; ++ai)
#pragma unroll
            for (int m = 0; m < 4; ++m) {
                const float r = rs[ai][m];
#pragma unroll
                for (int bj = 0; bj < 2; ++bj) {
                    const f32x4 a = acc[ai][bj][m][0] * r, b = acc[ai][bj][m][1] * r;
                    u32x4 w; w.x = pk2(a[0], a[1]); w.y = pk2(a[2], a[3]); w.z = pk2(b[0], b[1]); w.w = pk2(b[2], b[3]);
                    if (pn < 8 || (bj == 0 && wc == 0)) *(u32x4*)(dst + (size_t)(row0 + ai * 128 + m * 16) * ld + col0 + bj * 128) = w;
                }
            }
    }
};
struct EpiVT {
    static constexpr bool PERM = true, AFTER_DRAIN = false;
    bf16* VT; const float* ssq;
    DI void operator()(const f32x4 (&acc)[2][2][4][2], const pg8::Unit& u, int wr, int wc, int fr, int fq) const {
        const int row0 = u.pm * 256 + wr * 64 + fr, tok0 = u.pn * 256 + wc * 32 + 8 * fq;
#pragma unroll
        for (int bj = 0; bj < 2; ++bj) {
            float rs[8];
#pragma unroll
            for (int j = 0; j < 8; ++j) {
                float s = ssq[(size_t)(tok0 + bj * 128 + j) * 16 + fr];
                s += __shfl_xor(s, 1); s += __shfl_xor(s, 2); s += __shfl_xor(s, 4); s += __shfl_xor(s, 8);
                rs[j] = rsqrtf(s * (1.0f / DM) + EPS);
            }
#pragma unroll
            for (int ai = 0; ai < 2; ++ai)
#pragma unroll
                for (int m = 0; m < 4; ++m) {
                    const f32x4 a = acc[ai][bj][m][0], b = acc[ai][bj][m][1];
                    u32x4 w; w.x = pk2(a[0] * rs[0], a[1] * rs[1]); w.y = pk2(a[2] * rs[2], a[3] * rs[3]); w.z = pk2(b[0] * rs[4], b[1] * rs[5]); w.w = pk2(b[2] * rs[6], b[3] * rs[7]);
                    *(u32x4*)(VT + ((size_t)((tok0 + bj * 128) >> 3) * 1024 + (row0 + ai * 128 + m * 16)) * 8) = w;
                }
        }
    }
};

DI void conv_item(const float* W, int K, int N, int kb, int n0, bf16* dst  , const float* gain, float* scr, int lane) {
    const int k0 = 64 * kb;
#pragma unroll
    for (int i = 0; i < 8; ++i) {
        const int kk = 8 * i + (lane >> 3), cc = 4 * (lane & 7);
        f32x4 v = *(const f32x4*)(W + (size_t)(k0 + kk) * N + n0 + cc); if (gain) v = v * gain[k0 + kk];
        scr[kk * 33 + cc] = v[0]; scr[kk * 33 + cc + 1] = v[1]; scr[kk * 33 + cc + 2] = v[2]; scr[kk * 33 + cc + 3] = v[3];
    }
    asm volatile("s_waitcnt lgkmcnt(0)" ::: "memory");
    const int c = lane & 7;
#pragma unroll
    for (int j = 0; j < 4; ++j) { const int n = (lane >> 3) + 8 * j; const float* s = scr + (8 * c) * 33 + n;
        u32x4 o; o.x = pk2(s[0 * 33], s[1 * 33]); o.y = pk2(s[2 * 33], s[3 * 33]); o.z = pk2(s[4 * 33], s[5 * 33]); o.w = pk2(s[6 * 33], s[7 * 33]);
        *(u32x4*)(dst + (size_t)n * K + k0 + 8 * c) = o; }
    asm volatile("s_waitcnt lgkmcnt(0)" ::: "memory");
}
struct Args { const float* in[20]; float* out; unsigned char* ws; };
#define INP(i) ((const float*)karg(8 * (i)))
#define WSP() ((unsigned char*)karg(168))
#define OUTP() ((float*)karg(160))
typedef const char __attribute__((address_space(4)))* kaptr_t;
DI const void* karg(int off) { asm volatile("" : "+s"(off)); kaptr_t ka = (kaptr_t)__builtin_amdgcn_kernarg_segment_ptr(); return *(const void* const __attribute__((address_space(4)))*)(ka + off); }
struct KA { DI const float* inp(int i) const { return (const float*)karg(8 * i); } };

DI void prologue(const Args& A, unsigned char* lds, int wave, int lane) {
    float* scr = (float*)(lds + wave * 16384);
    const int gw = blockIdx.x * NWAVES + wave, NGW = gridDim.x * NWAVES;
    constexpr int I_GU = 16 * 88, I_D = 44 * 32, I_IN = 16 * 97, I_OUT = 16 * 32, PER_L = 6 * I_GU + I_IN + I_OUT;
    static_assert(I_GU == I_D, "");
    for (int it = gw; it < 2 * PER_L; it += NGW) {
        const int l = it / PER_L; int r = it % PER_L;
        unsigned char* wb = WSP() + WS_W + (size_t)l * WL;
        const int seg = r < 6 * I_GU ? r / I_GU : (r < 6 * I_GU + I_IN ? 6 : 7);
        if (seg < 6) {
            r -= seg * I_GU;
            const int ffn = seg / 3, kind = seg % 3;
            if (kind < 2) {
                const float* W = INP((ffn ? 16 : 2) + kind) + (size_t)l * DM * DFF; const float* gn = INP(ffn ? 15 : 1) + l * DM;
                const int kb = r / 88, nb = r % 88, n0 = 32 * nb;
                bf16* dst = (bf16*)(wb + (ffn ? OW_GU2 : OW_GU1)) + (size_t)((n0 >> 7) * 256 + kind * 128 + (n0 & 127)) * DM;
                conv_item(W, DM, DFF, kb, n0, dst, gn, scr, lane);
            } else {
                const float* W = INP(ffn ? 18 : 4) + (size_t)l * DM * DFF;
                const int kb = r / 32, nb = r % 32, n0 = 32 * nb;
                bf16* dst = (bf16*)(wb + (ffn ? OW_D2 : OW_D1)) + (size_t)n0 * DFF;
                conv_item(W, DFF, DM, kb, n0, dst, nullptr, scr, lane);
            }
        } else if (seg == 6) {
            r -= 6 * I_GU;
            const float* W = INP(6) + (size_t)l * DM * 3104; const float* gn = INP(5) + l * DM;
            const int kb = r / 97, nb = r % 97, n0 = 32 * nb;
            bf16* wa = (bf16*)(wb + OW_INA); bf16* wv = (bf16*)(wb + OW_INB); bf16* dst;
            if (n0 < 1024) dst = wa + (size_t)n0 * DM;
            else if (n0 < 1536) dst = wv + (size_t)(n0 - 1024) * DM;
            else if (n0 < 2048) dst = wa + (size_t)(n0 - 512) * DM;
            else if (n0 < 2560) dst = wv + (size_t)(n0 - 1536) * DM;
            else if (n0 < 3072) dst = wa + (size_t)(n0 - 1024) * DM;
            else dst = wa + (size_t)2048 * DM;
            conv_item(W, DM, 3104, kb, n0, dst, gn, scr, lane);
        } else {
            r -= 6 * I_GU + I_IN;
            const float* W = INP(14) + (size_t)l * DM * DM;
            const int kb = r / 32, nb = r % 32, n0 = 32 * nb;
            conv_item(W, DM, DM, kb, n0, (bf16*)(wb + OW_OUT) + (size_t)n0 * DM, nullptr, scr, lane);
        }
    }
    const float* x = INP(0); bf16* XB = (bf16*)(WSP() + WS_XB); float* ssq = (float*)(WSP() + WS_SSQ);
    for (int m = gw; m < M; m += NGW) {
        const f32x4* xr = (const f32x4*)(x + (size_t)m * DM) + lane; f32x4 v[4]; float s = 0.f;
#pragma unroll
        for (int j = 0; j < 4; ++j) { v[j] = xr[64 * j]; s += (v[j][0] * v[j][0] + v[j][1] * v[j][1]) + (v[j][2] * v[j][2] + v[j][3] * v[j][3]); }
        s = wave_sum(s);
        u32x2* o = (u32x2*)(XB + (size_t)m * DM) + lane;
#pragma unroll
        for (int j = 0; j < 4; ++j) { u32x2 w; w.x = pk2(v[j][0], v[j][1]); w.y = pk2(v[j][2], v[j][3]); o[64 * j] = w; }
        if (lane < 16) ssq[(size_t)m * 16 + lane] = lane == 0 ? s : 0.f;
    }
}
#define SCHED_FENCE() __builtin_amdgcn_sched_barrier(0)
DI float log_sigmoid_f(float z) { return fminf(z, 0.f) - __logf(1.0f + __expf(-fabsf(z))); }
DI void gla_prep_item(const Args& A, int l, unsigned char* ldsb, int item, int tid, bool stage) {
    float* gl = (float*)ldsb; float* tot = gl + 2 * 64 * 65; float* wg = tot + 512; float* bg = wg + 2048; bf16* T = (bf16*)(bg + 128);
    unsigned char* R = WSP() + WS_R;
    const bf16* CODES = (const bf16*)(R + R_CODES); const bf16* GQK = (const bf16*)(R + R_GQK);
    bf16* GP = (bf16*)(R + R_GP); bf16* KT = (bf16*)(R + R_KT); float* DEC = (float*)(R + R_DEC);
    const int c = item & 63, bh = item >> 6, h = bh & 3, b = bh >> 2;
    const size_t tok0 = (size_t)b * SEQ + c * 64;
    const int t = tid >> 3, dg = tid & 7;
    const u32x4* cp = (const u32x4*)(CODES + (tok0 + t) * 32);
    const u32x4 cq0 = cp[0], cq1 = cp[1], cq2 = cp[2], cq3 = cp[3];
    const u32x4 qv = *(const u32x4*)(GQK + (tok0 + t) * 512 + h * 64 + 8 * dg), kv = *(const u32x4*)(GQK + (tok0 + t) * 512 + 256 + h * 64 + 8 * dg);
    if (stage) {
        const int idx = tid * 4, dir = idx >> 10, r = (idx >> 6) & 15, d = idx & 63;
        const float* w = (dir ? INP(11) : INP(9)) + (size_t)l * 16 * 256 + r * 256 + h * 64 + d;
        *(f32x4*)(wg + idx) = *(const f32x4*)w;
        if (tid < 128) { const int dr = tid >> 6, dd = tid & 63; bg[tid] = (dr ? INP(12) : INP(10))[l * 256 + h * 64 + dd]; }
        __syncthreads();
    }
    {
        float cf[32];
#pragma unroll
        for (int j = 0; j < 4; ++j) { const u32x4 v = j == 0 ? cq0 : (j == 1 ? cq1 : (j == 2 ? cq2 : cq3)); cf[8 * j + 0] = bflo(v.x); cf[8 * j + 1] = bfhi(v.x); cf[8 * j + 2] = bflo(v.y); cf[8 * j + 3] = bfhi(v.y); cf[8 * j + 4] = bflo(v.z); cf[8 * j + 5] = bfhi(v.z); cf[8 * j + 6] = bflo(v.w); cf[8 * j + 7] = bfhi(v.w); }
#pragma unroll
        for (int dir = 0; dir < 2; ++dir) {
            float z[8];
#pragma unroll
            for (int dd = 0; dd < 8; ++dd) z[dd] = bg[dir * 64 + 8 * dg + dd];
#pragma unroll
            for (int r = 0; r < 16; ++r) {
                const f32x4 w0 = *(const f32x4*)(wg + dir * 1024 + r * 64 + 8 * dg), w1 = *(const f32x4*)(wg + dir * 1024 + r * 64 + 8 * dg + 4);
                const float cv = cf[dir * 16 + r];
                z[0] += cv * w0[0]; z[1] += cv * w0[1]; z[2] += cv * w0[2]; z[3] += cv * w0[3]; z[4] += cv * w1[0]; z[5] += cv * w1[1]; z[6] += cv * w1[2]; z[7] += cv * w1[3];
            }
#pragma unroll
            for (int dd = 0; dd < 8; ++dd) gl[(dir * 64 + t) * 65 + 8 * dg + dd] = log_sigmoid_f(z[dd]) * (1.0f / 16.0f);
        }
    }
    __syncthreads();
    {
        const int dir = tid >> 8, seg = (tid >> 6) & 3, d = tid & 63;
        float* gp = gl + (dir * 64 + 16 * seg) * 65 + d; float v[16];
#pragma unroll
        for (int tt = 0; tt < 16; ++tt) v[tt] = gp[tt * 65];
        if (dir == 0) {
#pragma unroll
            for (int tt = 1; tt < 16; ++tt) v[tt] += v[tt - 1];
        } else {
#pragma unroll
            for (int tt = 14; tt >= 0; --tt) v[tt] += v[tt + 1];
        }
        tot[(dir * 4 + seg) * 64 + d] = dir == 0 ? v[15] : v[0];
        __syncthreads();
        float off = 0.f;
        if (dir == 0) { for (int s2 = 0; s2 < 4; ++s2) if (s2 < seg) off += tot[s2 * 64 + d]; }
        else { for (int s2 = 0; s2 < 4; ++s2) if (s2 > seg) off += tot[(4 + s2) * 64 + d]; }
#pragma unroll
        for (int tt = 0; tt < 16; ++tt) gp[tt * 65] = v[tt] + off;
    }
    __syncthreads();
    {
        float q[8], k[8];
        q[0] = bflo(qv.x); q[1] = bfhi(qv.x); q[2] = bflo(qv.y); q[3] = bfhi(qv.y); q[4] = bflo(qv.z); q[5] = bfhi(qv.z); q[6] = bflo(qv.w); q[7] = bfhi(qv.w);
        k[0] = bflo(kv.x); k[1] = bfhi(kv.x); k[2] = bflo(kv.y); k[3] = bfhi(kv.y); k[4] = bflo(kv.z); k[5] = bfhi(kv.z); k[6] = bflo(kv.w); k[7] = bfhi(kv.w);
        float qf[8], kf[8], qb[8], kb[8];
#pragma unroll
        for (int dd = 0; dd < 8; ++dd) {
            const int d = 8 * dg + dd;
            const float bf = gl[t * 65 + d], bb = gl[(64 + t) * 65 + d], bfl = gl[63 * 65 + d], bb0 = gl[64 * 65 + d];
            qf[dd] = q[dd] * 0.125f * __expf(bf); kf[dd] = k[dd] * __expf(-bf);
            qb[dd] = q[dd] * 0.125f * __expf(bb); kb[dd] = k[dd] * __expf(-bb);
            T[d * 72 + t] = (bf16)(pk2(k[dd] * __expf(bfl - bf), 0.f) & 0xffffu);
            T[(64 + d) * 72 + t] = (bf16)(pk2(k[dd] * __expf(bb0 - bb), 0.f) & 0xffffu);
        }
        const size_t go = (tok0 + t) * 256 + h * 64 + 8 * dg; const size_t AS = (size_t)M * 256;
        u32x4 w;
        w.x = pk2(qf[0], qf[1]); w.y = pk2(qf[2], qf[3]); w.z = pk2(qf[4], qf[5]); w.w = pk2(qf[6], qf[7]); *(u32x4*)(GP + go) = w;
        w.x = pk2(kf[0], kf[1]); w.y = pk2(kf[2], kf[3]); w.z = pk2(kf[4], kf[5]); w.w = pk2(kf[6], kf[7]); *(u32x4*)(GP + AS + go) = w;
        w.x = pk2(qb[0], qb[1]); w.y = pk2(qb[2], qb[3]); w.z = pk2(qb[4], qb[5]); w.w = pk2(qb[6], qb[7]); *(u32x4*)(GP + 2 * AS + go) = w;
        w.x = pk2(kb[0], kb[1]); w.y = pk2(kb[2], kb[3]); w.z = pk2(kb[4], kb[5]); w.w = pk2(kb[6], kb[7]); *(u32x4*)(GP + 3 * AS + go) = w;
        if (tid < 128) { const int dir = tid >> 6, d = tid & 63; DEC[((size_t)(dir * 32 + bh) * 64 + c) * 64 + d] = __expf(dir ? gl[64 * 65 + d] : gl[63 * 65 + d]); }
    }
    __syncthreads();
#pragma unroll
    for (int i = 0; i < 2; ++i) {
        const int u = tid + 512 * i, dir = u >> 9, d = (u >> 3) & 63, j = u & 7;
        *(u32x4*)(KT + ((size_t)((tok0 >> 3) + j) * 512 + dir * 256 + h * 64 + d) * 8) = *(const u32x4*)(T + (dir * 64 + d) * 72 + 8 * j);
    }
    __syncthreads();
}

DI void gla_scan_item(const Args& A, int item, int wave, int lane) {
    unsigned char* R = WSP() + WS_R;
    const bf16* VT = (const bf16*)(R + R_VT); const bf16* KT = (const bf16*)(R + R_KT); const float* DEC = (const float*)(R + R_DEC); bf16* SBEF = (bf16*)(R + R_SBEF);
    const int es = item & 3, chain = item >> 2, dir = chain >> 5, bh = chain & 31, h = bh & 3, b = bh >> 2;
    const int c = lane & 15, g = lane >> 4, ebl = wave >> 2, db = wave & 3, e0 = 32 * es + 16 * ebl;
    const bf16* kp = KT + ((size_t)(b * 512 + g) * 512 + dir * 256 + h * 64 + 16 * db + c) * 8;
    const bf16* vp = VT + ((size_t)(b * 512 + g) * 1024 + 512 + h * 128 + e0 + c) * 8;
    const float* dp = DEC + (size_t)chain * 64 * 64 + 16 * db + 4 * g;
    bf16* sp = SBEF + ((size_t)chain * 64 * 128 + e0 + c) * 64 + 16 * db + 4 * g;
    f32x4 S = {0.f, 0.f, 0.f, 0.f};
#define SC_CH(n) (dir ? 63 - (n) : (n))
#define SC_LOAD(k, n) do { const int c_ = SC_CH((n) < 63 ? (n) : 63); a0##k = ld16(kp + (size_t)c_ * 32768); a1##k = ld16(kp + (size_t)c_ * 32768 + 16384); b0##k = ld16(vp + (size_t)c_ * 65536); b1##k = ld16(vp + (size_t)c_ * 65536 + 32768); dc##k = *(const f32x4*)(dp + c_ * 64); } while (0)
#define SC_STEP(k, n) do { u32x2 w_; w_.x = pk2(S[0], S[1]); w_.y = pk2(S[2], S[3]); *(u32x2*)(sp + (size_t)SC_CH(n) * 128 * 64) = w_; S = S * dc##k; S = mfma16(a0##k, b0##k, S); S = mfma16(a1##k, b1##k, S); } while (0)
    bf16x8 a00, a10, b00, b10, a01, a11, b01, b11, a02, a12, b02, b12, a03, a13, b03, b13; f32x4 dc0, dc1, dc2, dc3;
    SC_LOAD(0, 0); SC_LOAD(1, 1); SC_LOAD(2, 2); SC_LOAD(3, 3);
#pragma unroll 1
    for (int n = 0; n < 64; n += 4) {
        SC_STEP(0, n); SC_LOAD(0, n + 4);
        SC_STEP(1, n + 1); SC_LOAD(1, n + 5);
        SC_STEP(2, n + 2); SC_LOAD(2, n + 6);
        SC_STEP(3, n + 3); SC_LOAD(3, n + 7);
    }
#undef SC_CH
#undef SC_LOAD
#undef SC_STEP
}

constexpr int SC_STEP_B = 12544, SC_BATCH_B = 4 * SC_STEP_B;
struct ScStage { u32x4 k[4]; u32x4 x[4]; };
DI void sc_gload(ScStage& st, int item, int batch, int tid) {
    unsigned char* R = WSP() + WS_R;
    const bf16* VT = (const bf16*)(R + R_VT); const bf16* KT = (const bf16*)(R + R_KT); const float* DEC = (const float*)(R + R_DEC);
    const int es = item & 3, chain = item >> 2, dir = chain >> 5, bh = chain & 31, h = bh & 3, b = bh >> 2;
#pragma unroll
    for (int s4 = 0; s4 < 4; ++s4) {
        const int n = 4 * batch + s4, cc = dir ? 63 - n : n;
        st.k[s4] = *(const u32x4*)(KT + ((size_t)(b * 512 + cc * 8 + (tid >> 6)) * 512 + dir * 256 + h * 64 + (tid & 63)) * 8);
        if (tid < 256) st.x[s4] = *(const u32x4*)(VT + ((size_t)(b * 512 + cc * 8 + (tid >> 5)) * 1024 + 512 + h * 128 + 32 * es + (tid & 31)) * 8);
        else if (tid < 272) st.x[s4] = *(const u32x4*)(DEC + ((size_t)chain * 64 + cc) * 64 + (tid - 256) * 4);
    }
}
DI void sc_lwrite(const ScStage& st, unsigned char* buf, int tid) {
#pragma unroll
    for (int s4 = 0; s4 < 4; ++s4) {
        *(u32x4*)(buf + s4 * SC_STEP_B + tid * 16) = st.k[s4];
        if (tid < 256) *(u32x4*)(buf + s4 * SC_STEP_B + 8192 + tid * 16) = st.x[s4];
        else if (tid < 272) *(u32x4*)(buf + s4 * SC_STEP_B + 12288 + (tid - 256) * 16) = st.x[s4];
    }
}
DI void gla_scan_item_lds(unsigned char* ldsb, int item, int tid, int wave, int lane) {
    unsigned char* R = WSP() + WS_R; bf16* SBEF = (bf16*)(R + R_SBEF);
    const int es = item & 3, chain = item >> 2, dir = chain >> 5;
    const int c = lane & 15, g = lane >> 4, ebl = wave >> 2, db = wave & 3, e0 = 32 * es + 16 * ebl;
    bf16* sp = SBEF + ((size_t)chain * 64 * 128 + e0 + c) * 64 + 16 * db + 4 * g;
    const int ao = g * 1024 + (16 * db + c) * 16, bo = 8192 + g * 512 + (16 * ebl + c) * 16, dco = 12288 + (16 * db + 4 * g) * 4;
    f32x4 S = {0.f, 0.f, 0.f, 0.f};
    ScStage st; sc_gload(st, item, 0, tid); sc_lwrite(st, ldsb, tid); sc_gload(st, item, 1, tid);
    __syncthreads();
#pragma unroll 1
    for (int m = 0; m < 16; ++m) {
        const unsigned char* buf = ldsb + (m & 1) * SC_BATCH_B;
#pragma unroll
        for (int s4 = 0; s4 < 4; ++s4) {
            const int n = 4 * m + s4, cc = dir ? 63 - n : n; const unsigned char* sb = buf + s4 * SC_STEP_B;
            u32x2 w_; w_.x = pk2(S[0], S[1]); w_.y = pk2(S[2], S[3]); *(u32x2*)(sp + (size_t)cc * 128 * 64) = w_;
            const f32x4 dc = *(const f32x4*)(sb + dco);
            S = S * dc;
            S = mfma16(*(const bf16x8*)(sb + ao), *(const bf16x8*)(sb + bo), S);
            S = mfma16(*(const bf16x8*)(sb + ao + 4096), *(const bf16x8*)(sb + bo + 2048), S);
        }
        if (m < 15) sc_lwrite(st, ldsb + ((m + 1) & 1) * SC_BATCH_B, tid);
        if (m < 14) sc_gload(st, item, m + 2, tid);
        __syncthreads();
    }
}

DI void gla_out_item(const Args& A, int l, int item, int tb, int lane) {
    unsigned char* R = WSP() + WS_R;
    const bf16* VT = (const bf16*)(R + R_VT); const bf16* GP = (const bf16*)(R + R_GP); const bf16* SBEF = (const bf16*)(R + R_SBEF); const bf16* GR = (const bf16*)(R + R_GR); bf16* MIX = (bf16*)(R + R_MIX);
    const size_t AS = (size_t)M * 256;
    const int ck = item & 63, bh = item >> 6, h = bh & 3, b = bh >> 2, c = lane & 15, g = lane >> 4;
    const size_t tok0 = (size_t)b * SEQ + ck * 64;
    const size_t qo = (tok0 + 16 * tb + c) * 256 + h * 64 + 8 * g;
    const bf16x8 qf0 = ld16(GP + qo), qf1 = ld16(GP + qo + 32), qb0 = ld16(GP + 2 * AS + qo), qb1 = ld16(GP + 2 * AS + qo + 32);
    bf16x8 kfr[8], kbr[8];
#pragma unroll
    for (int i = 0; i < 8; ++i) {
        const size_t ko = (tok0 + 16 * (i >> 1) + c) * 256 + h * 64 + 8 * g + 32 * (i & 1);
        kfr[i] = ld16(GP + AS + ko); kbr[i] = ld16(GP + 3 * AS + ko);
    }
    const bf16* sf = SBEF + ((size_t)(bh * 64 + ck) * 128 + c) * 64 + 8 * g;
    const bf16* sbk = SBEF + ((size_t)((32 + bh) * 64 + ck) * 128 + c) * 64 + 8 * g;
    const bf16* vt = VT + ((size_t)((tok0 >> 3) + (g >> 1)) * 1024 + 512 + h * 128 + c) * 8 + 4 * (g & 1);
    u32x2 vv[2][8]; bf16x8 sv[2][8];
#define GO_LOAD(buf, eb0) do { _Pragma("unroll") for (int e_ = 0; e_ < 2; ++e_) { const bf16* v_ = vt + 128 * ((eb0) + e_); \
        vv[buf][4 * e_ + 0] = *(const u32x2*)(v_); vv[buf][4 * e_ + 1] = *(const u32x2*)(v_ + 16384); vv[buf][4 * e_ + 2] = *(const u32x2*)(v_ + 32768); vv[buf][4 * e_ + 3] = *(const u32x2*)(v_ + 49152); \
        sv[buf][4 * e_ + 0] = ld16(sf + ((eb0) + e_) * 1024); sv[buf][4 * e_ + 1] = ld16(sf + ((eb0) + e_) * 1024 + 32); sv[buf][4 * e_ + 2] = ld16(sbk + ((eb0) + e_) * 1024); sv[buf][4 * e_ + 3] = ld16(sbk + ((eb0) + e_) * 1024 + 32); } } while (0)
    GO_LOAD(0, 0);
    SCHED_FENCE();
    f32x4 at[4];
#pragma unroll
    for (int sb = 0; sb < 4; ++sb) {
        f32x4 f = {0.f, 0.f, 0.f, 0.f}, bk = {0.f, 0.f, 0.f, 0.f};
        f = mfma16(kfr[2 * sb], qf0, f); f = mfma16(kfr[2 * sb + 1], qf1, f);
        bk = mfma16(kbr[2 * sb], qb0, bk); bk = mfma16(kbr[2 * sb + 1], qb1, bk);
#pragma unroll
        for (int i = 0; i < 4; ++i) at[sb][i] = (16 * sb + 4 * g + i <= 16 * tb + c) ? f[i] : bk[i];
    }
    const bf16x8 p0 = pack8(at[0], at[1]), p1 = pack8(at[2], at[3]);
    SCHED_FENCE();
    f32x4 o[8]; float ss = 0.f;
#pragma unroll
    for (int bp = 0; bp < 4; ++bp) {
        if (bp < 3) GO_LOAD((bp + 1) & 1, 2 * bp + 2);
        SCHED_FENCE();
#pragma unroll
        for (int e = 0; e < 2; ++e) {
            f32x4 acc = {0.f, 0.f, 0.f, 0.f};
            const u32x2 v0 = vv[bp & 1][4 * e], v1 = vv[bp & 1][4 * e + 1], v2 = vv[bp & 1][4 * e + 2], v3 = vv[bp & 1][4 * e + 3];
            u32x4 a0; a0.x = v0.x; a0.y = v0.y; a0.z = v1.x; a0.w = v1.y; u32x4 a1; a1.x = v2.x; a1.y = v2.y; a1.z = v3.x; a1.w = v3.y;
            acc = mfma16(__builtin_bit_cast(bf16x8, a0), p0, acc); acc = mfma16(__builtin_bit_cast(bf16x8, a1), p1, acc);
            acc = mfma16(sv[bp & 1][4 * e], qf0, acc); acc = mfma16(sv[bp & 1][4 * e + 1], qf1, acc);
            acc = mfma16(sv[bp & 1][4 * e + 2], qb0, acc); acc = mfma16(sv[bp & 1][4 * e + 3], qb1, acc);
            o[2 * bp + e] = acc; ss += (acc[0] * acc[0] + acc[1] * acc[1]) + (acc[2] * acc[2] + acc[3] * acc[3]);
        }
        SCHED_FENCE();
    }
#undef GO_LOAD
    ss += __shfl_xor(ss, 16); ss += __shfl_xor(ss, 32);
    const float rstd = rsqrtf(ss * (1.0f / 128.0f) + EPS);
    const float* gain = INP(13) + l * 128 + 4 * g;
    const size_t tok = tok0 + 16 * tb + c;
#pragma unroll
    for (int eb = 0; eb < 8; ++eb) {
        const f32x4 gn = *(const f32x4*)(gain + 16 * eb);
        const u32x2 gr = *(const u32x2*)(GR + tok * 512 + h * 128 + 16 * eb + 4 * g);
        const float r0 = bflo(gr.x), r1 = bfhi(gr.x), r2 = bflo(gr.y), r3 = bfhi(gr.y);
        u32x2 w; w.x = pk2(o[eb][0] * rstd * gn[0] * silu_f(r0), o[eb][1] * rstd * gn[1] * silu_f(r1)); w.y = pk2(o[eb][2] * rstd * gn[2] * silu_f(r2), o[eb][3] * rstd * gn[3] * silu_f(r3));
        *(u32x2*)(MIX + tok * 1024 + 512 + h * 128 + 16 * eb + 4 * g) = w;
    }
}

constexpr int GO_KF = 0, GO_KB = 9216, GO_VT = 18432, GO_SF = 34816, GO_SB = 53248, GO_ITEM = 71680;
struct GoStage { u32x4 r[16]; bf16x8 q[4]; };
DI void go_gload(GoStage& st, int item, int t256, int tb, int lane) {
    unsigned char* R = WSP() + WS_R;
    const bf16* VT = (const bf16*)(R + R_VT); const bf16* GP = (const bf16*)(R + R_GP); const bf16* SBEF = (const bf16*)(R + R_SBEF);
    const size_t AS = (size_t)M * 256;
    const int ck = item & 63, bh = item >> 6, h = bh & 3, b = bh >> 2;
    const size_t tok0 = (size_t)b * SEQ + ck * 64;
#pragma unroll
    for (int j = 0; j < 16; ++j) {
        const int q = t256 + 256 * (j & 3);
        const bf16* src;
        if (j < 2)       { const int qq = t256 + 256 * j;       src = GP + AS + (tok0 + (qq >> 3)) * 256 + h * 64 + (qq & 7) * 8; }
        else if (j < 4)  { const int qq = t256 + 256 * (j - 2); src = GP + 3 * AS + (tok0 + (qq >> 3)) * 256 + h * 64 + (qq & 7) * 8; }
        else if (j < 8)  { src = VT + ((size_t)((tok0 >> 3) + (q >> 7)) * 1024 + 512 + h * 128 + (q & 127)) * 8; }
        else if (j < 12) { src = SBEF + (size_t)(bh * 64 + ck) * 8192 + q * 8; }
        else             { src = SBEF + (size_t)((32 + bh) * 64 + ck) * 8192 + q * 8; }
        st.r[j] = *(const u32x4*)src;
    }
    const size_t qo = (tok0 + 16 * tb + (lane & 15)) * 256 + h * 64 + 8 * (lane >> 4);
    st.q[0] = ld16(GP + qo); st.q[1] = ld16(GP + qo + 32); st.q[2] = ld16(GP + 2 * AS + qo); st.q[3] = ld16(GP + 2 * AS + qo + 32);
}
DI void go_lwrite(const GoStage& st, unsigned char* base, int t256) {
#pragma unroll
    for (int j = 0; j < 16; ++j) {
        const int q = t256 + 256 * (j & 3); unsigned char* dst;
        if (j < 2)       { const int qq = t256 + 256 * j;       dst = base + GO_KF + (qq >> 3) * 144 + (qq & 7) * 16; }
        else if (j < 4)  { const int qq = t256 + 256 * (j - 2); dst = base + GO_KB + (qq >> 3) * 144 + (qq & 7) * 16; }
        else if (j < 8)  { dst = base + GO_VT + q * 16; }
        else if (j < 12) { dst = base + GO_SF + (q >> 3) * 144 + (q & 7) * 16; }
        else             { dst = base + GO_SB + (q >> 3) * 144 + (q & 7) * 16; }
        *(u32x4*)dst = st.r[j];
    }
}
DI void go_compute(int l, const unsigned char* base, const bf16x8 (&qq)[4], int item, int tb, int lane) {
    unsigned char* R = WSP() + WS_R;
    const bf16* GR = (const bf16*)(R + R_GR); bf16* MIX = (bf16*)(R + R_MIX);
    const int ck = item & 63, bh = item >> 6, h = bh & 3, b = bh >> 2, c = lane & 15, g = lane >> 4;
    const size_t tok0 = (size_t)b * SEQ + ck * 64;
    const bf16x8 qf0 = qq[0], qf1 = qq[1], qb0 = qq[2], qb1 = qq[3];
    f32x4 at[4];
#pragma unroll
    for (int sb = 0; sb < 4; ++sb) {
        const unsigned char* kf = base + GO_KF + (16 * sb + c) * 144 + g * 16; const unsigned char* kb = base + GO_KB + (16 * sb + c) * 144 + g * 16;
        f32x4 f = {0.f, 0.f, 0.f, 0.f}, bk = {0.f, 0.f, 0.f, 0.f};
        f = mfma16(*(const bf16x8*)kf, qf0, f); f = mfma16(*(const bf16x8*)(kf + 64), qf1, f);
        bk = mfma16(*(const bf16x8*)kb, qb0, bk); bk = mfma16(*(const bf16x8*)(kb + 64), qb1, bk);
#pragma unroll
        for (int i = 0; i < 4; ++i) at[sb][i] = (16 * sb + 4 * g + i <= 16 * tb + c) ? f[i] : bk[i];
    }
    const bf16x8 p0 = pack8(at[0], at[1]), p1 = pack8(at[2], at[3]);
    f32x4 o[8]; float ss = 0.f;
#pragma unroll
    for (int eb = 0; eb < 8; ++eb) {
        const unsigned char* vp = base + GO_VT + (g >> 1) * 2048 + (16 * eb + c) * 16 + (g & 1) * 8;
        const u32x2 v0 = *(const u32x2*)vp, v1 = *(const u32x2*)(vp + 4096), v2 = *(const u32x2*)(vp + 8192), v3 = *(const u32x2*)(vp + 12288);
        u32x4 a0; a0.x = v0.x; a0.y = v0.y; a0.z = v1.x; a0.w = v1.y; u32x4 a1; a1.x = v2.x; a1.y = v2.y; a1.z = v3.x; a1.w = v3.y;
        const unsigned char* sfp = base + GO_SF + (16 * eb + c) * 144 + g * 16; const unsigned char* sbp = base + GO_SB + (16 * eb + c) * 144 + g * 16;
        f32x4 acc = {0.f, 0.f, 0.f, 0.f};
        acc = mfma16(__builtin_bit_cast(bf16x8, a0), p0, acc); acc = mfma16(__builtin_bit_cast(bf16x8, a1), p1, acc);
        acc = mfma16(*(const bf16x8*)sfp, qf0, acc); acc = mfma16(*(const bf16x8*)(sfp + 64), qf1, acc);
        acc = mfma16(*(const bf16x8*)sbp, qb0, acc); acc = mfma16(*(const bf16x8*)(sbp + 64), qb1, acc);
        o[eb] = acc; ss += (acc[0] * acc[0] + acc[1] * acc[1]) + (acc[2] * acc[2] + acc[3] * acc[3]);
    }
    ss += __shfl_xor(ss, 16); ss += __shfl_xor(ss, 32);
    const float rstd = rsqrtf(ss * (1.0f / 128.0f) + EPS);
    const float* gain = INP(13) + l * 128 + 4 * g;
    const size_t tok = tok0 + 16 * tb + c;
#pragma unroll
    for (int eb = 0; eb < 8; ++eb) {
        const f32x4 gn = *(const f32x4*)(gain + 16 * eb);
        const u32x2 gr = *(const u32x2*)(GR + tok * 512 + h * 128 + 16 * eb + 4 * g);
        const float r0 = bflo(gr.x), r1 = bfhi(gr.x), r2 = bflo(gr.y), r3 = bfhi(gr.y);
        u32x2 w; w.x = pk2(o[eb][0] * rstd * gn[0] * silu_f(r0), o[eb][1] * rstd * gn[1] * silu_f(r1)); w.y = pk2(o[eb][2] * rstd * gn[2] * silu_f(r2), o[eb][3] * rstd * gn[3] * silu_f(r3));
        *(u32x2*)(MIX + tok * 1024 + 512 + h * 128 + 16 * eb + 4 * g) = w;
    }
}
DI int go_item(bool xl, int xq, int k, int half) { const int idx = 2 * k + half; return xl ? ((((xq << 2) | (idx >> 6)) << 6) | (idx & 63)) : idx; }
DI void gla_out_phase(int l, unsigned char* ldsb, int tid, int wave, int lane, bool xl, int xq, int k0, int kend, int kstep) {
    const int half = wave >> 2, tb = wave & 3, t256 = tid & 255;
    unsigned char* base = ldsb + half * GO_ITEM;
    if (k0 >= kend) return;
    GoStage st; go_gload(st, go_item(xl, xq, k0, half), t256, tb, lane);
    for (int k = k0; k < kend; k += kstep) {
        go_lwrite(st, base, t256);
        bf16x8 qq[4] = {st.q[0], st.q[1], st.q[2], st.q[3]};
        __syncthreads();
        if (k + kstep < kend) go_gload(st, go_item(xl, xq, k + kstep, half), t256, tb, lane);
        SCHED_FENCE();
        go_compute(l, base, qq, go_item(xl, xq, k, half), tb, lane);
        __syncthreads();
    }
}

DI void na_stage_rpb(int l, float* rpbs, int tid) {
    const float* rpb = INP(7) + (size_t)l * 8 * 465;
    for (int i = tid; i < 8 * 465; i += NWAVES * 64) rpbs[i] = rpb[i];
    __syncthreads();
}
DI void na_item(const Args& A, int l, float* nss, const float* rpbs, int item, int h, int lane) {
    unsigned char* R = WSP() + WS_R;
    const bf16* QK = (const bf16*)(R + R_QKNA); const bf16* VT = (const bf16*)(R + R_VT); bf16* MIX = (bf16*)(R + R_MIX);
    const float* rpb = rpbs + h * 465;
    const int c = lane & 15, g = lane >> 4;
    const int j = item & 3, r = (item >> 2) & 63, b = item >> 8;
    const int rs = min(max(r - 4, 0), 56), c0 = min(max(16 * j - 8, 0), 32);
    const size_t tokq = (size_t)b * SEQ + r * 64 + 16 * j + c;
    const bf16x8 q0 = ld16(QK + tokq * 1024 + h * 64 + 8 * g), q1 = ld16(QK + tokq * 1024 + h * 64 + 32 + 8 * g);
    const bf16* kbase = QK + ((size_t)b * SEQ + rs * 64 + c0 + c) * 1024 + 512 + h * 64 + 8 * g;
    const bf16* vbase = VT + ((size_t)((b * SEQ + rs * 64 + c0 + 4 * g) >> 3) * 1024 + h * 64 + c) * 8 + 4 * (g & 1);
    f32x4 st[8][2];
    bf16x8 kf[2][16];
#pragma unroll
    for (int bb = 0; bb < 2; ++bb)
#pragma unroll
        for (int i = 0; i < 16; ++i) kf[bb][i] = ld16(kbase + (size_t)(4 * bb + (i >> 2)) * 65536 + ((i >> 1) & 1) * 16384 + (i & 1) * 32);
    SCHED_FENCE();
    u32x2 vf[2][16];
#pragma unroll
    for (int bb = 0; bb < 2; ++bb) {
#pragma unroll
        for (int t = 0; t < 8; ++t) {
            f32x4 s = {0.f, 0.f, 0.f, 0.f}; s = mfma16(kf[bb][2 * t], q0, s); s = mfma16(kf[bb][2 * t + 1], q1, s); st[4 * bb + (t >> 1)][t & 1] = s;
        }
        SCHED_FENCE();
        if (bb == 0) {
#pragma unroll
            for (int i = 0; i < 16; ++i) vf[0][i] = *(const u32x2*)(vbase + (size_t)(i >> 3) * 65536 + 128 * ((i >> 1) & 3) + (i & 1) * 16384);
            SCHED_FENCE();
        }
    }
    const int qc = 16 * j + c, cs = min(max(qc - 8, 0), 48);
    float mx = -3.0e38f;
#pragma unroll
    for (int w = 0; w < 8; ++w) {
        const float* rp = rpb + (rs + w - r + 7) * 31;
#pragma unroll
        for (int hf = 0; hf < 2; ++hf)
#pragma unroll
            for (int i = 0; i < 4; ++i) {
                const int kc = c0 + 16 * hf + 4 * g + i; const bool valid = (kc >= cs) && (kc < cs + 16);
                const int dc = min(max(kc - qc + 15, 0), 30);
                const float bv = rp[dc];
                const float s = valid ? st[w][hf][i] * 0.125f + bv : -1.0e30f;
                st[w][hf][i] = s; mx = fmaxf(mx, s);
            }
    }
    mx = fmaxf(mx, __shfl_xor(mx, 16)); mx = fmaxf(mx, __shfl_xor(mx, 32));
    float sum = 0.f;
#pragma unroll
    for (int w = 0; w < 8; ++w)
#pragma unroll
        for (int hf = 0; hf < 2; ++hf)
#pragma unroll
            for (int i = 0; i < 4; ++i) { const float p = __expf(st[w][hf][i] - mx); st[w][hf][i] = p; sum += p; }
    sum += __shfl_xor(sum, 16); sum += __shfl_xor(sum, 32);
    f32x4 o[4];
#pragma unroll
    for (int db = 0; db < 4; ++db) o[db] = (f32x4){0.f, 0.f, 0.f, 0.f};
#pragma unroll
    for (int wp = 0; wp < 4; ++wp) {
        if (wp < 3) {
#pragma unroll
            for (int i = 0; i < 16; ++i) vf[(wp + 1) & 1][i] = *(const u32x2*)(vbase + (size_t)(2 * wp + 2 + (i >> 3)) * 65536 + 128 * ((i >> 1) & 3) + (i & 1) * 16384);
        }
        SCHED_FENCE();
#pragma unroll
        for (int ww = 0; ww < 2; ++ww) {
            const bf16x8 p = pack8(st[2 * wp + ww][0], st[2 * wp + ww][1]);
#pragma unroll
            for (int db = 0; db < 4; ++db) {
                const u32x2 lo = vf[wp & 1][8 * ww + 2 * db], hi = vf[wp & 1][8 * ww + 2 * db + 1];
                u32x4 v; v.x = lo.x; v.y = lo.y; v.z = hi.x; v.w = hi.y;
                o[db] = mfma16(__builtin_bit_cast(bf16x8, v), p, o[db]);
            }
        }
        SCHED_FENCE();
    }
    const float inv = 1.0f / sum; float ss = 0.f;
#pragma unroll
    for (int db = 0; db < 4; ++db) { o[db] = o[db] * inv; ss += (o[db][0] * o[db][0] + o[db][1] * o[db][1]) + (o[db][2] * o[db][2] + o[db][3] * o[db][3]); }
    ss += __shfl_xor(ss, 16); ss += __shfl_xor(ss, 32);
    if (g == 0) nss[h * 16 + c] = ss;
    __syncthreads();
    float tot = 0.f;
#pragma unroll
    for (int hh = 0; hh < 8; ++hh) tot += nss[hh * 16 + c];
    const float rstd = rsqrtf(tot * (1.0f / 512.0f) + EPS);
    const float* gain = INP(8) + l * 512 + h * 64 + 4 * g;
#pragma unroll
    for (int db = 0; db < 4; ++db) {
        const f32x4 gn = *(const f32x4*)(gain + 16 * db);
        u32x2 w; w.x = pk2(o[db][0] * rstd * gn[0], o[db][1] * rstd * gn[1]); w.y = pk2(o[db][2] * rstd * gn[2], o[db][3] * rstd * gn[3]);
        *(u32x2*)(MIX + tokq * 1024 + h * 64 + 16 * db + 4 * g) = w;
    }
    __syncthreads();
}

struct NaKV { bf16x8 k[4]; u32x2 v[8]; };
DI NaKV na_load_kv(const bf16* kbase, const bf16* vbase, int krel) {
    NaKV f;
#pragma unroll
    for (int i = 0; i < 4; ++i) f.k[i] = ld16(kbase + (size_t)krel * 65536 + (i >> 1) * 16384 + (i & 1) * 32);
#pragma unroll
    for (int i = 0; i < 8; ++i) f.v[i] = *(const u32x2*)(vbase + (size_t)krel * 65536 + 128 * (i >> 1) + (i & 1) * 16384);
    return f;
}
DI void na_pair(const NaKV& f, bf16x8 q0, bf16x8 q1, const float* rp  , const int (&dcv)[8], unsigned vmask, float& m, float& l, f32x4 (&o)[4]) {
    f32x4 s0 = {0.f, 0.f, 0.f, 0.f}, s1 = {0.f, 0.f, 0.f, 0.f};
    s0 = mfma16(f.k[0], q0, s0); s0 = mfma16(f.k[1], q1, s0);
    s1 = mfma16(f.k[2], q0, s1); s1 = mfma16(f.k[3], q1, s1);
    float sv[8]; float mx = -1.0e30f;
#pragma unroll
    for (int e = 0; e < 8; ++e) {
        const float raw = e < 4 ? s0[e] : s1[e - 4];
        const float bv = rp[dcv[e]];
        sv[e] = ((vmask >> e) & 1u) ? raw * 0.125f + bv : -1.0e30f;
        mx = fmaxf(mx, sv[e]);
    }
    mx = fmaxf(mx, __shfl_xor(mx, 16)); mx = fmaxf(mx, __shfl_xor(mx, 32));
    const float mn = fmaxf(m, mx), alpha = __expf(m - mn); m = mn;
    float ps = 0.f; f32x4 p0, p1;
#pragma unroll
    for (int e = 0; e < 4; ++e) { p0[e] = __expf(sv[e] - mn); p1[e] = __expf(sv[4 + e] - mn); ps += p0[e] + p1[e]; }
    l = l * alpha + ps;
    const bf16x8 p = pack8(p0, p1);
#pragma unroll
    for (int db = 0; db < 4; ++db) {
        u32x4 v; v.x = f.v[2 * db].x; v.y = f.v[2 * db].y; v.z = f.v[2 * db + 1].x; v.w = f.v[2 * db + 1].y;
        o[db] = mfma16(__builtin_bit_cast(bf16x8, v), p, o[db] * alpha);
    }
}
DI void na_stage_rpb2(int l, float* rpbs, int tid) {
    const float* rpb = INP(7) + (size_t)l * 8 * 465;
    for (int i = tid; i < 8 * 15 * 32; i += NWAVES * 64) { const int col = i & 31, hr = i >> 5; rpbs[i] = col < 31 ? rpb[hr * 31 + col] * 1.44269504f : -1.0e30f; }
    __syncthreads();
}
DI void na_pair2(const NaKV& f, bf16x8 q0, bf16x8 q1, const float* rp  , const int (&dcv)[8], float& m, float& l, f32x4 (&o)[4]) {
    f32x4 s0 = {0.f, 0.f, 0.f, 0.f}, s1 = {0.f, 0.f, 0.f, 0.f};
    s0 = mfma16(f.k[0], q0, s0); s0 = mfma16(f.k[1], q1, s0);
    s1 = mfma16(f.k[2], q0, s1); s1 = mfma16(f.k[3], q1, s1);
    float sv[8];
#pragma unroll
    for (int e = 0; e < 8; ++e) sv[e] = (e < 4 ? s0[e] : s1[e - 4]) * (0.125f * 1.44269504f) + rp[dcv[e]];
    float mx = fmaxf(fmaxf(sv[0], sv[1]), fmaxf(sv[2], sv[3])); mx = fmaxf(mx, fmaxf(fmaxf(sv[4], sv[5]), fmaxf(sv[6], sv[7])));
    mx = fmaxf(mx, __shfl_xor(mx, 16)); mx = fmaxf(mx, __shfl_xor(mx, 32));
    const float mn = fmaxf(m, mx), alpha = __builtin_amdgcn_exp2f(m - mn); m = mn;
    float ps = 0.f; f32x4 p0, p1;
#pragma unroll
    for (int e = 0; e < 4; ++e) { p0[e] = __builtin_amdgcn_exp2f(sv[e] - mn); p1[e] = __builtin_amdgcn_exp2f(sv[4 + e] - mn); ps += p0[e] + p1[e]; }
    l = l * alpha + ps;
    const bf16x8 p = pack8(p0, p1);
#pragma unroll
    for (int db = 0; db < 4; ++db) {
        u32x4 v; v.x = f.v[2 * db].x; v.y = f.v[2 * db].y; v.z = f.v[2 * db + 1].x; v.w = f.v[2 * db + 1].y;
        o[db] = mfma16(__builtin_bit_cast(bf16x8, v), p, o[db] * alpha);
    }
}
DI void na_strip(const Args& A, int l, float* nss, const float* rpbs, int item, int h, int lane) {
    unsigned char* R = WSP() + WS_R;
    const bf16* QK = (const bf16*)(R + R_QKNA); const bf16* VT = (const bf16*)(R + R_VT); bf16* MIX = (bf16*)(R + R_MIX);
    const float* rpb = rpbs + h * 480;
    const int c = lane & 15, g = lane >> 4;
    const int j = item & 3, r0 = ((item >> 2) & 15) * 4, b = item >> 6;
    const int c0 = min(max(16 * j - 8, 0), 32);
    const int kmin = min(max(r0 - 4, 0), 56), kmax = min(max(r0 + 3 - 4, 0), 56) + 7, nrows = kmax - kmin + 1;
    const int qc = 16 * j + c, cs = min(max(qc - 8, 0), 48);
    int dcv[8];
#pragma unroll
    for (int e = 0; e < 8; ++e) { const int kc = c0 + 16 * (e >> 2) + 4 * g + (e & 3); dcv[e] = (kc >= cs && kc < cs + 16) ? min(max(kc - qc + 15, 0), 30) : 31; }
    bf16x8 q0[4], q1[4];
#pragma unroll
    for (int i = 0; i < 4; ++i) { const bf16* qp = QK + ((size_t)b * SEQ + (r0 + i) * 64 + 16 * j + c) * 1024 + h * 64 + 8 * g; q0[i] = ld16(qp); q1[i] = ld16(qp + 32); }
    const bf16* kbase = QK + ((size_t)b * SEQ + kmin * 64 + c0 + c) * 1024 + 512 + h * 64 + 8 * g;
    const bf16* vbase = VT + ((size_t)((b * SEQ + kmin * 64 + c0 + 4 * g) >> 3) * 1024 + h * 64 + c) * 8 + 4 * (g & 1);
    float m[4], ls[4]; f32x4 o[4][4];
#pragma unroll
    for (int i = 0; i < 4; ++i) { m[i] = -1.0e30f; ls[i] = 0.f;
#pragma unroll
        for (int db = 0; db < 4; ++db) o[i][db] = (f32x4){0.f, 0.f, 0.f, 0.f}; }
    int rs[4];
#pragma unroll
    for (int i = 0; i < 4; ++i) rs[i] = min(max(r0 + i - 4, 0), 56);
#define NA_ROW(F, KR) do { _Pragma("unroll") for (int i_ = 0; i_ < 4; ++i_) { if ((KR) >= rs[i_] && (KR) <= rs[i_] + 7) na_pair2(F, q0[i_], q1[i_], rpb + ((KR) - (r0 + i_) + 7) * 32, dcv, m[i_], ls[i_], o[i_]); } } while (0)
    NaKV fa = na_load_kv(kbase, vbase, 0), fb;
#pragma unroll 1
    for (int t = 0; t < nrows; t += 2) {
        fb = na_load_kv(kbase, vbase, min(t + 1, nrows - 1));
        SCHED_FENCE();
        NA_ROW(fa, kmin + t);
        SCHED_FENCE();
        fa = na_load_kv(kbase, vbase, min(t + 2, nrows - 1));
        SCHED_FENCE();
        if (t + 1 < nrows) NA_ROW(fb, kmin + t + 1);
        SCHED_FENCE();
    }
#undef NA_ROW
    float ssv[4];
#pragma unroll
    for (int i = 0; i < 4; ++i) {
        float lt = ls[i]; lt += __shfl_xor(lt, 16); lt += __shfl_xor(lt, 32);
        const float inv = 1.0f / lt; float ss = 0.f;
#pragma unroll
        for (int db = 0; db < 4; ++db) { o[i][db] = o[i][db] * inv; ss += (o[i][db][0] * o[i][db][0] + o[i][db][1] * o[i][db][1]) + (o[i][db][2] * o[i][db][2] + o[i][db][3] * o[i][db][3]); }
        ss += __shfl_xor(ss, 16); ss += __shfl_xor(ss, 32);
        ssv[i] = ss;
        if (g == 0) nss[(i * 8 + h) * 16 + c] = ss;
    }
    __syncthreads();
    const float* gain = INP(8) + l * 512 + h * 64 + 4 * g;
#pragma unroll
    for (int i = 0; i < 4; ++i) {
        float tot = 0.f;
#pragma unroll
        for (int hh = 0; hh < 8; ++hh) tot += nss[(i * 8 + hh) * 16 + c];
        const float rstd = rsqrtf(tot * (1.0f / 512.0f) + EPS);
        const size_t tokq = (size_t)b * SEQ + (r0 + i) * 64 + 16 * j + c;
#pragma unroll
        for (int db = 0; db < 4; ++db) {
            const f32x4 gn = *(const f32x4*)(gain + 16 * db);
            u32x2 w; w.x = pk2(o[i][db][0] * rstd * gn[0], o[i][db][1] * rstd * gn[1]); w.y = pk2(o[i][db][2] * rstd * gn[2], o[i][db][3] * rstd * gn[3]);
            *(u32x2*)(MIX + tokq * 1024 + h * 64 + 16 * db + 4 * g) = w;
        }
    }
    (void)ssv;
    __syncthreads();
}

#define XB_TMO      128
#define XB_XCNT(j)  (256  + 64 * (j))
#define XB_XSUB(j)  (1280 + 64 * (j))
#define XB_XGEN(j)  (2304 + 64 * (j))
#define XB_TOP      3328
#define XB_TOPGEN   3392
#define XCD_BAR_WORDS 3456
#define XB_SPIN_CAP (1u << 18)

__device__ __forceinline__ unsigned xb_ld(unsigned* p)              { return __hip_atomic_load(p, __ATOMIC_RELAXED, __HIP_MEMORY_SCOPE_AGENT); }
__device__ __forceinline__ unsigned xb_add(unsigned* p, unsigned v) { return __hip_atomic_fetch_add(p, v, __ATOMIC_RELAXED, __HIP_MEMORY_SCOPE_AGENT); }
__device__ __forceinline__ unsigned xb_xcc_id() { return (unsigned)__builtin_amdgcn_s_getreg((3 << 11) | 20) & 0xFu; }
#define XB_SPIN(cond, bar) do { unsigned _sp = 0; while (cond) { __builtin_amdgcn_s_sleep(1); \
    if ((++_sp & 255u) == 0u) { if (xb_ld(&(bar)[XB_TMO])) break; if (_sp > XB_SPIN_CAP) { atomicAdd(&(bar)[XB_TMO], 1u); break; } } } } while (0)

struct XcdBarrier {
    unsigned* bar; unsigned x;
    volatile LAS unsigned* st;
};

__device__ __forceinline__ XcdBarrier xcd_barrier_post(unsigned* bar, volatile LAS unsigned* st) {
    XcdBarrier b; b.bar = bar; b.x = xb_xcc_id(); b.st = st;
    if (threadIdx.x == 0) (void)xb_add(&bar[XB_XCNT(b.x)], 1u);
    return b;
}
__device__ __forceinline__ void xcd_barrier_complete(unsigned* bar, unsigned x, unsigned& nloc, unsigned& nx) {
    const unsigned G = gridDim.x * gridDim.y * gridDim.z;
    unsigned sum, cnt, mine, sp = 0u;
    for (;;) {
        sum = 0u; cnt = 0u; mine = 0u;
#pragma unroll
        for (unsigned j = 0; j < 16; ++j) { const unsigned c = xb_ld(&bar[XB_XCNT(j)]); sum += c; cnt += (c > 0u) ? 1u : 0u; mine = (j == x) ? c : mine; }
        if (sum == G) break;
        __builtin_amdgcn_s_sleep(1);
        if ((++sp & 255u) == 0u) { if (xb_ld(&bar[XB_TMO])) break; if (sp > XB_SPIN_CAP) { atomicAdd(&bar[XB_TMO], 1u); break; } }
    }
    nloc = mine > 0u ? mine : 1u; nx = cnt > 0u ? cnt : 1u;
}

__device__ __forceinline__ void xcd_barrier(const XcdBarrier& b) {
    asm volatile("s_waitcnt vmcnt(0)" ::: "memory");
    __syncthreads();
    if (threadIdx.x == 0) {
        unsigned* bar = b.bar;
        __builtin_amdgcn_s_waitcnt(0);
        unsigned nloc = b.st[0], nx = b.st[1];
        if (nloc == 0u) { xcd_barrier_complete(bar, b.x, nloc, nx); b.st[0] = nloc; b.st[1] = nx; }
        const unsigned old = xb_add(&bar[XB_XSUB(b.x)], 1u);
        const unsigned gen = old / nloc;
        if (old + 1u == (gen + 1u) * nloc) {
            __builtin_amdgcn_fence(__ATOMIC_RELEASE, "agent");
            asm volatile("s_waitcnt vmcnt(0)" ::: "memory");
            const unsigned og = xb_add(&bar[XB_TOP], 1u);
            const unsigned tg = og / nx;
            if (og + 1u == (tg + 1u) * nx) xb_add(&bar[XB_TOPGEN], 1u);
            else XB_SPIN(xb_ld(&bar[XB_TOPGEN]) == tg, bar);
            __builtin_amdgcn_fence(__ATOMIC_ACQUIRE, "agent");
            xb_add(&bar[XB_XGEN(b.x)], 1u);
            asm volatile("s_waitcnt vmcnt(0)" ::: "memory");
        } else {
            XB_SPIN(xb_ld(&bar[XB_XGEN(b.x)]) == gen, bar);
            __builtin_amdgcn_fence(__ATOMIC_ACQUIRE, "agent");
            asm volatile("s_waitcnt vmcnt(0)" ::: "memory");
        }
    }
    __syncthreads();
}

#define XL_SUB(j) (3456 + 64 * (j))
#define XL_GEN(j) (4480 + 64 * (j))
__device__ __forceinline__ void xcd_local_barrier(unsigned* bar, unsigned x, unsigned nloc) {
    asm volatile("s_waitcnt vmcnt(0)" ::: "memory");
    __syncthreads();
    if (threadIdx.x == 0) {
        const unsigned old = xb_add(&bar[XL_SUB(x)], 1u); const unsigned gen = old / nloc;
        if (old + 1u == (gen + 1u) * nloc) xb_add(&bar[XL_GEN(x)], 1u);
        else XB_SPIN(xb_ld(&bar[XL_GEN(x)]) == gen, bar);
        __builtin_amdgcn_fence(__ATOMIC_ACQUIRE, "agent");
        asm volatile("s_waitcnt vmcnt(0)" ::: "memory");
    }
    __syncthreads();
}
#ifndef REP_PRO
#define REP_PRO 1
#define REP_SYNC 1
#define REP_GEMM 1
#define REP_PREP 1
#define REP_SCAN 1
#define REP_OUT 1
#define REP_NA 1
#endif
#define LAUNDER_TID int t_ = threadIdx.x; asm volatile("" : "+v"(t_)); const int tid = t_, lane = t_ & 63, wave = __builtin_amdgcn_readfirstlane(t_ >> 6); (void)tid; (void)lane; (void)wave;
#define GSYNC() do { for (int r_ = 0; r_ < REP_SYNC; ++r_) xcd_barrier(xbar); } while (0)
#define LSYNC() do { for (int r_ = 0; r_ < REP_SYNC; ++r_) { if (xl) xcd_local_barrier(xbar.bar, xbar.x, (unsigned)(G >> 3)); else xcd_barrier(xbar); } } while (0)
__global__ void __launch_bounds__(NWAVES * 64, 2) fwd_megakernel(Args A) {
    extern __shared__ __attribute__((aligned(16))) unsigned char lds[];
    cg::grid_group grid = cg::this_grid();
    const int G = gridDim.x, bx = blockIdx.x;
    LAS unsigned char* ldsg = (LAS unsigned char*)lds;
    unsigned char* ws = WSP(); unsigned char* R = ws + WS_R;
    bf16* XB = (bf16*)(ws + WS_XB); float* SSQ = (float*)(ws + WS_SSQ); float* X = OUTP();
    bf16* H = (bf16*)(R + R_H); bf16* MIX = (bf16*)(R + R_MIX);

    if (threadIdx.x < 16) ((volatile LAS unsigned*)(ldsg + (LDS_BYTES - 128)))[threadIdx.x] = 0u;
    __syncthreads();
    volatile LAS unsigned* ldsw = (volatile LAS unsigned*)(ldsg + (LDS_BYTES - 128));
    XcdBarrier xbar; xbar.bar = (unsigned*)ws; xbar.x = xb_xcc_id(); xbar.st = ldsw;
    if (threadIdx.x == 0) ldsw[4] = xb_add(&xbar.bar[XB_XCNT(xbar.x)], 1u);
    for (int rep = 0; rep < REP_PRO; ++rep) { LAUNDER_TID prologue(A, lds, wave, lane); }
    if (G > (1 << 20)) grid.sync();
    xcd_barrier(xbar);
    if (threadIdx.x == 0) {
        bool ok = (G % 8 == 0);
        for (unsigned j = 0; j < 16; ++j) { const unsigned cn = xb_ld(&xbar.bar[XB_XCNT(j)]); ok = ok && (cn == (j < 8 ? (unsigned)(G / 8) : 0u)); }
        ldsw[5] = ok ? (xbar.x + 8u * ldsw[4]) : (unsigned)bx; ldsw[6] = ok ? 1u : 0u;
    }
    __syncthreads();
    const int vcu = __builtin_amdgcn_readfirstlane((int)ldsw[5]);
    const bool xl = __builtin_amdgcn_readfirstlane((int)ldsw[6]) != 0;
    const int xq = vcu & 7, rk = vcu >> 3, nl = G >> 3;

#pragma unroll 1
    for (int l = 0; l < 2; ++l) {
        unsigned char* wb = ws + WS_W + (size_t)l * WL;
        for (int rep = 0; rep < REP_GEMM; ++rep) {
            pg8::Gemm gm{XB, (const bf16*)(wb + OW_GU1), M, 2 * DFF, DM}; pg8::StaticOrder S; S.init(M, 2 * DFF, G, vcu);
            EpiSwiGLU E{H, SSQ};
            pg8::gemm_phase<EpiSwiGLU, pg8::StaticOrder, true, true>(ldsg, gm, S, E);
        }
        LSYNC();
        for (int rep = 0; rep < REP_GEMM; ++rep) {
            pg8::Gemm gm{H, (const bf16*)(wb + OW_D1), M, DM, DFF}; pg8::StaticOrder S; S.init(M, DM, G, vcu);
            EpiResid E{(l == 0 && rep == 0) ? INP(0) : (const float*)nullptr, XB, SSQ, rep == 0 ? 0.5f : 0.f};
            pg8::gemm_phase<EpiResid, pg8::StaticOrder, true, true>(ldsg, gm, S, E);
        }
        GSYNC();
        for (int rep = 0; rep < REP_GEMM; ++rep) {
            pg8::Gemm gm{XB, (const bf16*)(wb + OW_INA), M, 2304, DM}; pg8::StaticOrder S; S.init(M, 2304, G, vcu);
            EpiProj E{(bf16*)(R + R_QKNA), (bf16*)(R + R_GQK), (bf16*)(R + R_GR), (bf16*)(R + R_CODES), SSQ};
            pg8::gemm_phase<EpiProj, pg8::StaticOrder, true, true>(ldsg, gm, S, E);
            pg8::Gemm gv{(const bf16*)(wb + OW_INB), XB, 1024, M, DM}; pg8::StaticOrder S2; S2.init(1024, M, G, vcu);
            EpiVT E2{(bf16*)(R + R_VT), SSQ};
            pg8::gemm_phase<EpiVT, pg8::StaticOrder, true, true>(ldsg, gv, S2, E2);
        }
        LSYNC();
        for (int rep = 0; rep < REP_PREP; ++rep) { LAUNDER_TID int ph_ = -1; for (int k = xl ? rk : vcu; k < (xl ? 256 : 2048); k += (xl ? nl : G)) { const int it = xl ? ((((xq << 2) | (k >> 6)) << 6) | (k & 63)) : k; const int h_ = (it >> 6) & 3; gla_prep_item(A, l, lds, it, tid, h_ != ph_); ph_ = h_; } }
        LSYNC();
        for (int rep = 0; rep < REP_SCAN; ++rep) { LAUNDER_TID for (int k = xl ? rk : vcu; k < (xl ? 32 : 256); k += (xl ? nl : G)) gla_scan_item_lds(lds, xl ? ((((k >> 4) * 32 + xq * 4 + ((k >> 2) & 3)) << 2) | (k & 3)) : k, tid, wave, lane); }
        GSYNC();
        for (int rep = 0; rep < REP_OUT; ++rep) { LAUNDER_TID gla_out_phase(l, lds, tid, wave, lane, xl, xq, xl ? rk : vcu, xl ? 128 : 1024, xl ? nl : G); }
        for (int rep = 0; rep < REP_NA; ++rep) { LAUNDER_TID na_stage_rpb2(l, (float*)lds + 512, tid); if (G % 8 == 0) { for (int li = vcu >> 3; li < 64; li += (G >> 3)) na_strip(A, l, (float*)lds, (const float*)lds + 512, ((vcu & 7) << 6) | li, wave, lane); } else { for (int it = vcu; it < 512; it += G) na_strip(A, l, (float*)lds, (const float*)lds + 512, it, wave, lane); } }
        GSYNC();
        for (int rep = 0; rep < REP_GEMM; ++rep) {
            pg8::Gemm gm{MIX, (const bf16*)(wb + OW_OUT), M, DM, DM}; pg8::StaticOrder S; S.init(M, DM, G, vcu);
            EpiResid E{nullptr, XB, SSQ, rep == 0 ? 1.0f : 0.f};
            pg8::gemm_phase<EpiResid, pg8::StaticOrder, true, true>(ldsg, gm, S, E);
        }
        LSYNC();
        for (int rep = 0; rep < REP_GEMM; ++rep) {
            pg8::Gemm gm{XB, (const bf16*)(wb + OW_GU2), M, 2 * DFF, DM}; pg8::StaticOrder S; S.init(M, 2 * DFF, G, vcu);
            EpiSwiGLU E{H, SSQ};
            pg8::gemm_phase<EpiSwiGLU, pg8::StaticOrder, true, true>(ldsg, gm, S, E);
        }
        LSYNC();
        for (int rep = 0; rep < REP_GEMM; ++rep) {
            pg8::Gemm gm{H, (const bf16*)(wb + OW_D2), M, DM, DFF}; pg8::StaticOrder S; S.init(M, DM, G, vcu);
            EpiResid E{nullptr, XB, SSQ, rep == 0 ? 0.5f : 0.f};
            pg8::gemm_phase<EpiResid, pg8::StaticOrder, true, true>(ldsg, gm, S, E);
        }
        LSYNC();
    }
    {
        LAUNDER_TID
        const float* gn = INP(19);
        const int gw = vcu * NWAVES + wave, NGW = G * NWAVES;
        for (int m = xl ? xq * 4096 + rk * NWAVES + wave : gw; m < (xl ? (xq + 1) * 4096 : M); m += (xl ? nl * NWAVES : NGW)) {
            float s = lane < 16 ? SSQ[(size_t)m * 16 + lane] : 0.f; s = wave_sum(s);
            const float rstd = rsqrtf(s * (1.0f / DM) + EPS);
            f32x4* xr = (f32x4*)(X + (size_t)m * DM) + lane; const f32x4* gr = (const f32x4*)gn + lane; const u32x2* xb = (const u32x2*)(XB + (size_t)m * DM) + lane;
#pragma unroll
            for (int j = 0; j < 4; ++j) { const u32x2 bb = xb[64 * j]; const f32x4 v = {bflo(bb.x), bfhi(bb.x), bflo(bb.y), bfhi(bb.y)}; xr[64 * j] = v * rstd * gr[64 * j]; }
        }
    }
}

extern "C" void kernel_launch(void* const* d_in, const int* in_sizes, int n_in, void* d_out, int out_size, void* d_ws, size_t ws_size, hipStream_t stream) {
    static int grid = 0;
    if (grid == 0) {
        if (n_in != 20 || out_size != M * DM || ws_size < WS_END) { fprintf(stderr, "kernel_launch: unexpected shapes / workspace (n_in %d out %d ws %zu need %zu)\n", n_in, out_size, ws_size, (size_t)WS_END); grid = -1; return; }
        int dev = 0, cus = 0, per_cu = 0;
        hipGetDevice(&dev); hipDeviceGetAttribute(&cus, hipDeviceAttributeMultiprocessorCount, dev);
        hipFuncSetAttribute((const void*)fwd_megakernel, hipFuncAttributeMaxDynamicSharedMemorySize, LDS_BYTES);
        hipOccupancyMaxActiveBlocksPerMultiprocessor(&per_cu, (const void*)fwd_megakernel, NWAVES * 64, LDS_BYTES);
        if (per_cu < 1) per_cu = 1;
        grid = cus * per_cu;
        (void)hipGetLastError();
    }
    if (grid < 0) return;
    Args a{};
    for (int i = 0; i < 20; ++i) a.in[i] = (const float*)d_in[i];
    a.out = (float*)d_out; a.ws = (unsigned char*)d_ws;
    if (hipMemsetAsync(d_ws, 0, 32768, stream) != hipSuccess) { fprintf(stderr, "memset failed\n"); return; }
    void* args[] = {&a};
    hipError_t e = hipLaunchCooperativeKernel((const void*)fwd_megakernel, dim3(grid), dim3(NWAVES * 64), args, LDS_BYTES, stream);
    if (e != hipSuccess) fprintf(stderr, "cooperative launch failed: %s (grid %d)\n", hipGetErrorString(e), grid);
}
```

```cpp
#include <hip/hip_runtime.h>
#include <cstdio>
#include <cstdint>
namespace pg8 {
#define PG8_LAS __attribute__((address_space(3)))
typedef unsigned short bf16_t;
typedef short bf16x8 __attribute__((ext_vector_type(8)));
typedef float f32x4 __attribute__((ext_vector_type(4)));
typedef unsigned u32x4 __attribute__((ext_vector_type(4)));
constexpr int BM = 256, BK = 64, HALF = 128, HTB = HALF * BK * 2  , STAGE_BYTES = 8 * HTB, NXCD = 8, WGM = 8;

__host__ __device__ __forceinline__ int lds_byte(int r, int c) { const int st = (r >> 4) * 2 + (c >> 5), rr = r & 15, cc = c & 31, ob = rr * 64 + cc * 2; return st * 1024 + (ob ^ (((ob >> 9) & 1) << 5)); }
__host__ __device__ __forceinline__ void stage_rc(int b, int& R, int& C) { const int st = b / 1024, sb = b % 1024, swz = sb ^ (((sb >> 9) & 1) << 5); R = (st >> 1) * 16 + swz / 64; C = (st & 1) * 32 + (swz % 64) / 2; }
__host__ __device__ __forceinline__ int perm32(int rho) { const int n = rho >> 4, i = rho & 15; return 8 * (i >> 2) + 4 * n + (i & 3); }

struct Unit { int pm, pn; };
struct Gemm { const bf16_t* A; const bf16_t* Bt; int M, N, K; };

struct StaticOrder {
    int nM, nN, nwg, G, c;
    __host__ __device__ void init(int M, int N, int G_, int c_) { nM = M / BM; nN = N / BM; nwg = nM * nN; G = G_; c = c_; }
    __host__ __device__ bool next(int i, Unit& u) const {
        const long L = (long)i * G + c; if (L >= nwg) return false;
        int wgid = (int)L; { const int q = nwg / NXCD, r = nwg % NXCD, xcd = wgid % NXCD, off = wgid / NXCD; wgid = (xcd < r ? xcd * (q + 1) : r * (q + 1) + (xcd - r) * q) + off; }
        const int nig = WGM * nN, gid = wgid / nig, fm = gid * WGM, gsz = (nM - fm) < WGM ? (nM - fm) : WGM;
        u.pm = fm + ((wgid % nig) % gsz); u.pn = (wgid % nig) / gsz; return true;
    }
    __device__ __forceinline__ void a_ready(const Unit&) const {}
    __device__ __forceinline__ void done(const Unit&) const {}
};

typedef __bf16 bf16x2_cv_t __attribute__((ext_vector_type(2)));
typedef float f32x2_cv_t __attribute__((ext_vector_type(2)));
__device__ __forceinline__ unsigned cvt_pk_bf16(float lo, float hi) { const f32x2_cv_t v = {lo, hi}; const bf16x2_cv_t b = __builtin_convertvector(v, bf16x2_cv_t); return __builtin_bit_cast(unsigned, b); }
typedef float f32x2 __attribute__((ext_vector_type(2)));
template <class Epi, class Sched, bool ALIGN_EPI = false, bool SP2 = false>
__device__ __forceinline__ void gemm_phase(PG8_LAS unsigned char* lds, const Gemm g, const Sched& S, const Epi& E) {
    int tid_ = threadIdx.x; asm volatile("" : "+v"(tid_));
    const int tid = tid_, wid = __builtin_amdgcn_readfirstlane(tid >> 6), lane = tid & 63, wr = wid >> 2, wc = wid & 3, fr = lane & 15, fq = lane >> 4;
    const int K = g.K, nt = K / BK;
    unsigned voffA[2], voffB[2];
#pragma unroll
    for (int i = 0; i < 2; ++i) { int R, C; stage_rc(tid * 16 + i * 8192, R, C); const int Rb = Epi::PERM ? ((R & ~31) + perm32(R & 31)) : R;
        voffA[i] = (unsigned)(R * K + C) * 2u; voffB[i] = (unsigned)(Rb * K + C) * 2u; }
    const size_t kstep = (size_t)(BK * 2);
    const size_t hstep = (size_t)HALF * K * 2;
    const size_t tstep = 2 * hstep;
    const unsigned ldsw = (unsigned)wid * 1024u;
    const int aoff = lds_byte(wr * 64 + fr, fq * 8), boff = lds_byte(wc * 32 + fr, fq * 8);
#define PG8_SA(b, h) (((b) * 2 + (h)) * HTB)
#define PG8_SB(b, h) ((4 + (b) * 2 + (h)) * HTB)
#define PG8_STAGE(bufoff, gbase, voff) do { _Pragma("unroll") for (int _i = 0; _i < 2; ++_i) \
        __builtin_amdgcn_global_load_lds((const unsigned*)((const char*)(gbase) + (voff)[_i]), (PG8_LAS unsigned*)(lds + (bufoff) + ldsw + _i * 8192), 16, 0, 0); } while (0)
#define PG8_LDA(dst, b, h) do { _Pragma("unroll") for (int m = 0; m < 4; ++m) _Pragma("unroll") for (int k = 0; k < 2; ++k) dst[m][k] = *(const PG8_LAS bf16x8*)(lds + PG8_SA(b, h) + aoff + m * 2048 + k * 1024); } while (0)
#define PG8_LDB(dst, b, h) do { _Pragma("unroll") for (int n = 0; n < 2; ++n) _Pragma("unroll") for (int k = 0; k < 2; ++k) dst[n][k] = *(const PG8_LAS bf16x8*)(lds + PG8_SB(b, h) + boff + n * 2048 + k * 1024); } while (0)
#define PG8_MMA(ai, bj, At, Bt) do { __builtin_amdgcn_s_setprio(1); _Pragma("unroll") for (int m = 0; m < 4; ++m) _Pragma("unroll") for (int n = 0; n < 2; ++n) _Pragma("unroll") for (int k = 0; k < 2; ++k) \
        acc[ai][bj][m][n] = __builtin_amdgcn_mfma_f32_16x16x32_bf16(Bt[n][k], At[m][k], acc[ai][bj][m][n], 0, 0, 0); __builtin_amdgcn_s_setprio(0); } while (0)
#define PG8_WAIT_V(n) asm volatile("s_waitcnt vmcnt(" #n ")" ::: "memory")
#define PG8_WAIT_L(n) asm volatile("s_waitcnt lgkmcnt(" #n ")" ::: "memory")
#define PG8_BAR __builtin_amdgcn_s_barrier()
#define PG8_SCHED __builtin_amdgcn_sched_barrier(0)
    Unit cur, nxt; int ui = 0;
    if (!S.next(0, cur)) return;
    f32x4 acc[2][2][4][2];
#pragma unroll
    for (int a = 0; a < 2; ++a)
#pragma unroll
        for (int b = 0; b < 2; ++b)
#pragma unroll
            for (int m = 0; m < 4; ++m)
#pragma unroll
                for (int n = 0; n < 2; ++n) acc[a][b][m][n] = (f32x4){0.f, 0.f, 0.f, 0.f};
    bf16x8 At[4][2], B0[2][2], B1[2][2];
    const char* cA = (const char*)g.A + (size_t)cur.pm * tstep; const char* cB = (const char*)g.Bt + (size_t)cur.pn * tstep;
    S.a_ready(cur);
    if constexpr (SP2) {
        PG8_STAGE(PG8_SB(0, 0), cB, voffB); PG8_STAGE(PG8_SB(0, 1), cB + hstep, voffB); PG8_STAGE(PG8_SA(0, 0), cA, voffA); PG8_STAGE(PG8_SA(0, 1), cA + hstep, voffA);
        if (wr == 1) PG8_BAR;
        PG8_WAIT_V(2); PG8_BAR;
        PG8_STAGE(PG8_SB(1, 0), cB + kstep, voffB); PG8_STAGE(PG8_SA(1, 0), cA + kstep, voffA); PG8_STAGE(PG8_SB(1, 1), cB + hstep + kstep, voffB);
        PG8_WAIT_V(6); PG8_BAR;
    } else {
        PG8_STAGE(PG8_SB(0, 0), cB, voffB); PG8_STAGE(PG8_SA(0, 0), cA, voffA); PG8_STAGE(PG8_SB(0, 1), cB + hstep, voffB); PG8_STAGE(PG8_SA(0, 1), cA + hstep, voffA);
        if (wr == 1) PG8_BAR;
        PG8_WAIT_V(4); PG8_BAR;
        PG8_STAGE(PG8_SB(1, 0), cB + kstep, voffB); PG8_STAGE(PG8_SA(1, 0), cA + kstep, voffA); PG8_STAGE(PG8_SB(1, 1), cB + hstep + kstep, voffB);
        PG8_WAIT_V(6); PG8_BAR;
    }
    for (;;) {
        const bool has_next = S.next(ui + 1, nxt);
        const char* nA = has_next ? (const char*)g.A + (size_t)nxt.pm * tstep : cA; const char* nB = has_next ? (const char*)g.Bt + (size_t)nxt.pn * tstep : cB;
        for (int t = 0; t < nt; t += 2) {
            const bool last = (t == nt - 2);
            const char* a1 = cA + (size_t)(t + 1) * kstep;
            const char* a2 = last ? nA : cA + (size_t)(t + 2) * kstep; const char* b2 = last ? nB : cB + (size_t)(t + 2) * kstep;
            const char* a3 = a2 + kstep; const char* b3 = b2 + kstep;
            if (last && has_next) S.a_ready(nxt);
            if constexpr (SP2) {
            PG8_LDB(B0, 0, 0); PG8_LDB(B1, 0, 1); PG8_SCHED; PG8_LDA(At, 0, 0); PG8_STAGE(PG8_SA(1, 1), a1 + hstep, voffA);
            PG8_WAIT_V(8); PG8_WAIT_L(0); PG8_BAR; PG8_MMA(0, 0, At, B0); PG8_MMA(0, 1, At, B1); PG8_BAR; PG8_SCHED;
            PG8_LDA(At, 0, 1); PG8_STAGE(PG8_SB(0, 0), b2, voffB); PG8_STAGE(PG8_SB(0, 1), b2 + hstep, voffB); PG8_STAGE(PG8_SA(0, 0), a2, voffA);
            PG8_WAIT_V(8); PG8_WAIT_L(0); PG8_BAR; PG8_MMA(1, 0, At, B0); PG8_MMA(1, 1, At, B1); PG8_BAR; PG8_SCHED;
            PG8_LDB(B0, 1, 0); PG8_LDB(B1, 1, 1); PG8_SCHED; PG8_LDA(At, 1, 0); PG8_STAGE(PG8_SA(0, 1), a2 + hstep, voffA);
            PG8_WAIT_V(8); PG8_WAIT_L(0); PG8_BAR; PG8_MMA(0, 0, At, B0); PG8_MMA(0, 1, At, B1); PG8_BAR; PG8_SCHED;
            PG8_LDA(At, 1, 1); PG8_STAGE(PG8_SB(1, 0), b3, voffB); PG8_STAGE(PG8_SB(1, 1), b3 + hstep, voffB); PG8_STAGE(PG8_SA(1, 0), a3, voffA);
            PG8_WAIT_V(8); PG8_WAIT_L(0); PG8_BAR; PG8_MMA(1, 0, At, B0); PG8_MMA(1, 1, At, B1); PG8_BAR; PG8_SCHED;
            } else {
            PG8_LDB(B0, 0, 0); PG8_SCHED; PG8_LDA(At, 0, 0); PG8_STAGE(PG8_SA(1, 1), a1 + hstep, voffA);
            PG8_WAIT_L(8); PG8_BAR; PG8_WAIT_L(0); PG8_MMA(0, 0, At, B0); PG8_BAR; PG8_SCHED;
            PG8_LDB(B1, 0, 1); PG8_STAGE(PG8_SB(0, 0), b2, voffB);
            PG8_BAR; PG8_WAIT_L(0); PG8_MMA(0, 1, At, B1); PG8_BAR;
            PG8_LDA(At, 0, 1); PG8_STAGE(PG8_SA(0, 0), a2, voffA);
            PG8_BAR; PG8_WAIT_L(0); PG8_MMA(1, 0, At, B0); PG8_BAR; PG8_SCHED;
            PG8_STAGE(PG8_SB(0, 1), b2 + hstep, voffB);
            PG8_WAIT_V(6); PG8_BAR; PG8_MMA(1, 1, At, B1); PG8_BAR;
            PG8_LDB(B0, 1, 0); PG8_SCHED; PG8_LDA(At, 1, 0); PG8_STAGE(PG8_SA(0, 1), a2 + hstep, voffA);
            PG8_WAIT_L(8); PG8_BAR; PG8_WAIT_L(0); PG8_MMA(0, 0, At, B0); PG8_BAR; PG8_SCHED;
            PG8_LDB(B1, 1, 1); PG8_STAGE(PG8_SB(1, 0), b3, voffB);
            PG8_BAR; PG8_WAIT_L(0); PG8_MMA(0, 1, At, B1); PG8_BAR;
            PG8_LDA(At, 1, 1); PG8_STAGE(PG8_SA(1, 0), a3, voffA);
            PG8_BAR; PG8_WAIT_L(0); PG8_MMA(1, 0, At, B0); PG8_BAR; PG8_SCHED;
            PG8_STAGE(PG8_SB(1, 1), b3 + hstep, voffB);
            PG8_WAIT_V(6); PG8_BAR; PG8_MMA(1, 1, At, B1); PG8_BAR;
            }
        }
        if constexpr (ALIGN_EPI) { if (wr == 0) PG8_BAR; }
        if constexpr (!Epi::AFTER_DRAIN) { E(acc, cur, wr, wc, fr, fq); S.done(cur); }
        if (!has_next) break;
#pragma unroll
        for (int a = 0; a < 2; ++a)
#pragma unroll
            for (int b = 0; b < 2; ++b)
#pragma unroll
                for (int m = 0; m < 4; ++m)
#pragma unroll
                    for (int n = 0; n < 2; ++n) acc[a][b][m][n] = (f32x4){0.f, 0.f, 0.f, 0.f};
        cur = nxt; cA = nA; cB = nB; ++ui;
        if constexpr (ALIGN_EPI) { if (wr == 1) PG8_BAR; }
    }
    PG8_WAIT_V(0);
    if constexpr (!ALIGN_EPI) { if (wr == 0) PG8_BAR; }
    PG8_BAR;
    if constexpr (Epi::AFTER_DRAIN) { E.fused(acc, cur, wr, wc, fr, fq, lds, wid, lane); S.done(cur); }
#undef PG8_SA
#undef PG8_SB
#undef PG8_STAGE
#undef PG8_LDA
#undef PG8_LDB
#undef PG8_MMA
#undef PG8_WAIT_V
#undef PG8_WAIT_L
#undef PG8_BAR
#undef PG8_SCHED
}
}
#include <hip/hip_cooperative_groups.h>
namespace cg = cooperative_groups;
#define DI __device__ __forceinline__
typedef unsigned short bf16;
typedef float f32x4 __attribute__((ext_vector_type(4)));
typedef short bf16x8 __attribute__((ext_vector_type(8)));
typedef unsigned u32x4 __attribute__((ext_vector_type(4)));
typedef unsigned u32x2 __attribute__((ext_vector_type(2)));
#define LAS __attribute__((address_space(3)))

constexpr int M = 32768, DM = 1024, DFF = 2816, SEQ = 4096;
constexpr float EPS = 1e-6f;
constexpr size_t HM = 512u * 1024u;
constexpr size_t WS_W = 2 * HM, WL = 83 * HM;
constexpr size_t OW_GU1 = 0, OW_D1 = 22 * HM, OW_INA = 33 * HM, OW_INB = 42 * HM, OW_OUT = 46 * HM, OW_GU2 = 50 * HM, OW_D2 = 72 * HM;
constexpr size_t WS_XB = WS_W + 2 * WL, WS_SSQ = WS_XB + 128 * HM, WS_R = WS_SSQ + 4 * HM;
constexpr size_t R_QKNA = 0, R_VT = 128 * HM, R_GR = 256 * HM, R_GP = 320 * HM, R_SBEF = 448 * HM, R_GQK = 576 * HM, R_KT = 640 * HM, R_CODES = 704 * HM, R_DEC = 708 * HM, R_END = 710 * HM;
constexpr size_t R_MIX = 576 * HM, R_H = 0;
constexpr size_t WS_END = WS_R + R_END;
constexpr int LDS_BYTES = 147456;
constexpr int NWAVES = 8;

DI unsigned pk2(float lo, float hi) { return pg8::cvt_pk_bf16(lo, hi); }
DI float bflo(unsigned w) { return __uint_as_float(w << 16); }
DI float bfhi(unsigned w) { return __uint_as_float(w & 0xffff0000u); }
DI bf16x8 ld16(const bf16* p) { return *(const bf16x8*)p; }
DI bf16x8 ld8x2(const bf16* p0, const bf16* p1) { const u32x2 a = *(const u32x2*)p0, b = *(const u32x2*)p1; u32x4 v; v.x = a.x; v.y = a.y; v.z = b.x; v.w = b.y; return __builtin_bit_cast(bf16x8, v); }
DI f32x4 mfma16(bf16x8 a, bf16x8 b, f32x4 c) { return __builtin_amdgcn_mfma_f32_16x16x32_bf16(a, b, c, 0, 0, 0); }
DI bf16x8 pack8(f32x4 a, f32x4 b) { u32x4 v; v.x = pk2(a[0], a[1]); v.y = pk2(a[2], a[3]); v.z = pk2(b[0], b[1]); v.w = pk2(b[2], b[3]); return __builtin_bit_cast(bf16x8, v); }
DI float silu_f(float x) { return x * __builtin_amdgcn_rcpf(1.0f + __expf(-x)); }
DI float wave_sum(float v) {
#pragma unroll
    for (int o = 1; o < 64; o <<= 1) v += __shfl_xor(v, o);
    return v;
}

DI void row_rstd(const float* ssq, int row0, int fq, float (&rs)[2][4]) {
#pragma unroll
    for (int ai = 0; ai < 2; ++ai)
#pragma unroll
        for (int m = 0; m < 4; ++m) {
            const f32x4 v = *(const f32x4*)(ssq + (size_t)(row0 + ai * 128 + m * 16) * 16 + 4 * fq);
            float s = (v[0] + v[1]) + (v[2] + v[3]);
            s += __shfl_xor(s, 16); s += __shfl_xor(s, 32);
            rs[ai][m] = rsqrtf(s * (1.0f / DM) + EPS);
        }
}
struct EpiSwiGLU {
    static constexpr bool PERM = true, AFTER_DRAIN = false;
    bf16* H; const float* ssq;
    DI void operator()(const f32x4 (&acc)[2][2][4][2], const pg8::Unit& u, int wr, int wc, int fr, int fq) const {
        const int row0 = u.pm * 256 + wr * 64 + fr, col0 = u.pn * 128 + wc * 32 + 8 * fq;
        float rs[2][4]; row_rstd(ssq, row0, fq, rs);
#pragma unroll
        for (int ai = 0; ai < 2; ++ai)
#pragma unroll
            for (int m = 0; m < 4; ++m) {
                typedef float f32x2 __attribute__((ext_vector_type(2)));
                const float r = rs[ai][m]; const float r2s = r * r, rls = r * -1.44269504f; const f32x2 r2 = {r2s, r2s}, rl = {rls, rls};
                unsigned hw[4];
#pragma unroll
                for (int q = 0; q < 4; ++q) {
                    const f32x4 gq = acc[ai][0][m][q >> 1], uq = acc[ai][1][m][q >> 1];
                    const f32x2 g2 = {gq[2 * (q & 1)], gq[2 * (q & 1) + 1]}, u2 = {uq[2 * (q & 1)], uq[2 * (q & 1) + 1]};
                    const f32x2 t = g2 * rl; f32x2 e; e.x = __builtin_amdgcn_exp2f(t.x); e.y = __builtin_amdgcn_exp2f(t.y);
                    const f32x2 d = e + 1.0f; f32x2 rc; rc.x = __builtin_amdgcn_rcpf(d.x); rc.y = __builtin_amdgcn_rcpf(d.y);
                    const f32x2 hv = ((g2 * u2) * r2) * rc;
                    hw[q] = pk2(hv.x, hv.y);
                }
                u32x4 w; w.x = hw[0]; w.y = hw[1]; w.z = hw[2]; w.w = hw[3];
                *(u32x4*)(H + (size_t)(row0 + ai * 128 + m * 16) * DFF + col0) = w;
            }
    }
};
struct EpiResid {
    static constexpr bool PERM = true, AFTER_DRAIN = false;
    const float* base32; bf16* XB; float* ssq; float alpha;
    DI void operator()(const f32x4 (&acc)[2][2][4][2], const pg8::Unit& u, int wr, int wc, int fr, int fq) const {
        const int row0 = u.pm * 256 + wr * 64 + fr, col0 = u.pn * 256 + wc * 32 + 8 * fq;
#pragma unroll
        for (int ai = 0; ai < 2; ++ai)
#pragma unroll
            for (int m = 0; m < 4; ++m) {
                const int row = row0 + ai * 128 + m * 16; float ss = 0.f;
#pragma unroll
                for (int bj = 0; bj < 2; ++bj) {
                    const size_t off = (size_t)row * DM + col0 + bj * 128;
                    f32x4 b0, b1;
                    if (base32) { b0 = *(const f32x4*)(base32 + off); b1 = *(const f32x4*)(base32 + off + 4); }
                    else { const u32x4 bb = *(const u32x4*)(XB + off); b0 = (f32x4){bflo(bb.x), bfhi(bb.x), bflo(bb.y), bfhi(bb.y)}; b1 = (f32x4){bflo(bb.z), bfhi(bb.z), bflo(bb.w), bfhi(bb.w)}; }
                    const f32x4 v0 = b0 + acc[ai][bj][m][0] * alpha, v1 = b1 + acc[ai][bj][m][1] * alpha;
                    ss += ((v0[0] * v0[0] + v0[1] * v0[1]) + (v0[2] * v0[2] + v0[3] * v0[3])) + ((v1[0] * v1[0] + v1[1] * v1[1]) + (v1[2] * v1[2] + v1[3] * v1[3]));
                    u32x4 w; w.x = pk2(v0[0], v0[1]); w.y = pk2(v0[2], v0[3]); w.z = pk2(v1[0], v1[1]); w.w = pk2(v1[2], v1[3]);
                    *(u32x4*)(XB + off) = w;
                }
                ss += __shfl_xor(ss, 16); ss += __shfl_xor(ss, 32);
                if (fq == 0) ssq[(size_t)row * 16 + u.pn * 4 + wc] = ss;
                asm volatile("" ::: "memory");
            }
    }
};
struct EpiProj {
    static constexpr bool PERM = true, AFTER_DRAIN = false;
    bf16* QKNA; bf16* GQK; bf16* GR; bf16* CODES; const float* ssq;
    DI void operator()(const f32x4 (&acc)[2][2][4][2], const pg8::Unit& u, int wr, int wc, int fr, int fq) const {
        const int row0 = u.pm * 256 + wr * 64 + fr; const int pn = u.pn;
        float rs[2][4]; row_rstd(ssq, row0, fq, rs);
        bf16* dst; int ld, cb;
        if (pn < 4) { dst = QKNA; ld = 1024; cb = 256 * pn; } else if (pn < 6) { dst = GQK; ld = 512; cb = 256 * (pn - 4); } else if (pn < 8) { dst = GR; ld = 512; cb = 256 * (pn - 6); } else { dst = CODES; ld = 32; cb = 0; }
        const int col0 = cb + wc * 32 + 8 * fq;
#pragma unroll
        for (int ai = 0; ai < 2; ++ai)
#pragma unroll
            for (int m = 0; m < 4; ++m) {
                const float r = rs[ai][m];
#pragma unroll
                for (int bj = 0; bj < 2; ++bj) {
                    const f32x4 a = acc[ai][bj][m][0] * r, b = acc[ai][bj][m][1] * r;
                    u32x4 w; w.x = pk2(a[0], a[1]); w.y = pk2(a[2], a[3]); w.z = pk2(b[0], b[1]); w.w = pk2(b[2], b[3]);
                    if (pn < 8 || (bj == 0 && wc == 0)) *(u32x4*)(dst + (size_t)(row0 + ai * 128 + m * 16) * ld + col0 + bj * 128) = w;
                }
            }
    }
};
struct EpiVT {
    static constexpr bool PERM = true, AFTER_DRAIN = false;
    bf16* VT; const float* ssq;
    DI void operator()(const f32x4 (&acc)[2][2][4][2], const pg8::Unit& u, int wr, int wc, int fr, int fq) const {
        const int row0 = u.pm * 256 + wr * 64 + fr, tok0 = u.pn * 256 + wc * 32 + 8 * fq;
#pragma unroll
        for (int bj = 0; bj < 2; ++bj) {
            float rs[8];
#pragma unroll
            for (int j = 0; j < 8; ++j) {
                float s = ssq[(size_t)(tok0 + bj * 128 + j) * 16 + fr];
                s += __shfl_xor(s, 1); s += __shfl_xor(s, 2); s += __shfl_xor(s, 4); s += __shfl_xor(s, 8);
                rs[j] = rsqrtf(s * (1.0f / DM) + EPS);
            }
#pragma unroll
            for (int ai = 0; ai < 2; ++ai)
#pragma unroll
                for (int m = 0; m < 4; ++m) {
                    const f32x4 a = acc[ai][bj][m][0], b = acc[ai][bj][m][1];
                    u32x4 w; w.x = pk2(a[0] * rs[0], a[1] * rs[1]); w.y = pk2(a[2] * rs[2], a[3] * rs[3]); w.z = pk2(b[0] * rs[4], b[1] * rs[5]); w.w = pk2(b[2] * rs[6], b[3] * rs[7]);
                    *(u32x4*)(VT + ((size_t)((tok0 + bj * 128) >> 3) * 1024 + (row0 + ai * 128 + m * 16)) * 8) = w;
                }
        }
    }
};

DI void conv_item(const float* W, int K, int N, int kb, int n0, bf16* dst  , const float* gain, float* scr, int lane) {
    const int k0 = 64 * kb;
#pragma unroll
    for (int i = 0; i < 8; ++i) {
        const int kk = 8 * i + (lane >> 3), cc = 4 * (lane & 7);
        f32x4 v = *(const f32x4*)(W + (size_t)(k0 + kk) * N + n0 + cc); if (gain) v = v * gain[k0 + kk];
        scr[kk * 33 + cc] = v[0]; scr[kk * 33 + cc + 1] = v[1]; scr[kk * 33 + cc + 2] = v[2]; scr[kk * 33 + cc + 3] = v[3];
    }
    asm volatile("s_waitcnt lgkmcnt(0)" ::: "memory");
    const int c = lane & 7;
#pragma unroll
    for (int j = 0; j < 4; ++j) { const int n = (lane >> 3) + 8 * j; const float* s = scr + (8 * c) * 33 + n;
        u32x4 o; o.x = pk2(s[0 * 33], s[1 * 33]); o.y = pk2(s[2 * 33], s[3 * 33]); o.z = pk2(s[4 * 33], s[5 * 33]); o.w = pk2(s[6 * 33], s[7 * 33]);
        *(u32x4*)(dst + (size_t)n * K + k0 + 8 * c) = o; }
    asm volatile("s_waitcnt lgkmcnt(0)" ::: "memory");
}
struct Args { const float* in[20]; float* out; unsigned char* ws; };
#define INP(i) ((const float*)karg(8 * (i)))
#define WSP() ((unsigned char*)karg(168))
#define OUTP() ((float*)karg(160))
typedef const char __attribute__((address_space(4)))* kaptr_t;
DI const void* karg(int off) { asm volatile("" : "+s"(off)); kaptr_t ka = (kaptr_t)__builtin_amdgcn_kernarg_segment_ptr(); return *(const void* const __attribute__((address_space(4)))*)(ka + off); }
struct KA { DI const float* inp(int i) const { return (const float*)karg(8 * i); } };

DI void prologue(const Args& A, unsigned char* lds, int wave, int lane) {
    float* scr = (float*)(lds + wave * 16384);
    const int gw = blockIdx.x * NWAVES + wave, NGW = gridDim.x * NWAVES;
    constexpr int I_GU = 16 * 88, I_D = 44 * 32, I_IN = 16 * 97, I_OUT = 16 * 32, PER_L = 6 * I_GU + I_IN + I_OUT;
    static_assert(I_GU == I_D, "");
    for (int it = gw; it < 2 * PER_L; it += NGW) {
        const int l = it / PER_L; int r = it % PER_L;
        unsigned char* wb = WSP() + WS_W + (size_t)l * WL;
        const int seg = r < 6 * I_GU ? r / I_GU : (r < 6 * I_GU + I_IN ? 6 : 7);
        if (seg < 6) {
            r -= seg * I_GU;
            const int ffn = seg / 3, kind = seg % 3;
            if (kind < 2) {
                const float* W = INP((ffn ? 16 : 2) + kind) + (size_t)l * DM * DFF; const float* gn = INP(ffn ? 15 : 1) + l * DM;
                const int kb = r / 88, nb = r % 88, n0 = 32 * nb;
                bf16* dst = (bf16*)(wb + (ffn ? OW_GU2 : OW_GU1)) + (size_t)((n0 >> 7) * 256 + kind * 128 + (n0 & 127)) * DM;
                conv_item(W, DM, DFF, kb, n0, dst, gn, scr, lane);
            } else {
                const float* W = INP(ffn ? 18 : 4) + (size_t)l * DM * DFF;
                const int kb = r / 32, nb = r % 32, n0 = 32 * nb;
                bf16* dst = (bf16*)(wb + (ffn ? OW_D2 : OW_D1)) + (size_t)n0 * DFF;
                conv_item(W, DFF, DM, kb, n0, dst, nullptr, scr, lane);
            }
        } else if (seg == 6) {
            r -= 6 * I_GU;
            const float* W = INP(6) + (size_t)l * DM * 3104; const float* gn = INP(5) + l * DM;
            const int kb = r / 97, nb = r % 97, n0 = 32 * nb;
            bf16* wa = (bf16*)(wb + OW_INA); bf16* wv = (bf16*)(wb + OW_INB); bf16* dst;
            if (n0 < 1024) dst = wa + (size_t)n0 * DM;
            else if (n0 < 1536) dst = wv + (size_t)(n0 - 1024) * DM;
            else if (n0 < 2048) dst = wa + (size_t)(n0 - 512) * DM;
            else if (n0 < 2560) dst = wv + (size_t)(n0 - 1536) * DM;
            else if (n0 < 3072) dst = wa + (size_t)(n0 - 1024) * DM;
            else dst = wa + (size_t)2048 * DM;
            conv_item(W, DM, 3104, kb, n0, dst, gn, scr, lane);
        } else {
            r -= 6 * I_GU + I_IN;
            const float* W = INP(14) + (size_t)l * DM * DM;
            const int kb = r / 32, nb = r % 32, n0 = 32 * nb;
            conv_item(W, DM, DM, kb, n0, (bf16*)(wb + OW_OUT) + (size_t)n0 * DM, nullptr, scr, lane);
        }
    }
    const float* x = INP(0); bf16* XB = (bf16*)(WSP() + WS_XB); float* ssq = (float*)(WSP() + WS_SSQ);
    for (int m = gw; m < M; m += NGW) {
        const f32x4* xr = (const f32x4*)(x + (size_t)m * DM) + lane; f32x4 v[4]; float s = 0.f;
#pragma unroll
        for (int j = 0; j < 4; ++j) { v[j] = xr[64 * j]; s += (v[j][0] * v[j][0] + v[j][1] * v[j][1]) + (v[j][2] * v[j][2] + v[j][3] * v[j][3]); }
        s = wave_sum(s);
        u32x2* o = (u32x2*)(XB + (size_t)m * DM) + lane;
#pragma unroll
        for (int j = 0; j < 4; ++j) { u32x2 w; w.x = pk2(v[j][0], v[j][1]); w.y = pk2(v[j][2], v[j][3]); o[64 * j] = w; }
        if (lane < 16) ssq[(size_t)m * 16 + lane] = lane == 0 ? s : 0.f;
    }
}
#define SCHED_FENCE() __builtin_amdgcn_sched_barrier(0)
DI float log_sigmoid_f(float z) { return fminf(z, 0.f) - __logf(1.0f + __expf(-fabsf(z))); }
DI void gla_prep_item(const Args& A, int l, unsigned char* ldsb, int item, int tid, bool stage) {
    float* gl = (float*)ldsb; float* tot = gl + 2 * 64 * 65; float* wg = tot + 512; float* bg = wg + 2048; bf16* T = (bf16*)(bg + 128);
    unsigned char* R = WSP() + WS_R;
    const bf16* CODES = (const bf16*)(R + R_CODES); const bf16* GQK = (const bf16*)(R + R_GQK);
    bf16* GP = (bf16*)(R + R_GP); bf16* KT = (bf16*)(R + R_KT); float* DEC = (float*)(R + R_DEC);
    const int c = item & 63, bh = item >> 6, h = bh & 3, b = bh >> 2;
    const size_t tok0 = (size_t)b * SEQ + c * 64;
    const int t = tid >> 3, dg = tid & 7;
    const u32x4* cp = (const u32x4*)(CODES + (tok0 + t) * 32);
    const u32x4 cq0 = cp[0], cq1 = cp[1], cq2 = cp[2], cq3 = cp[3];
    const u32x4 qv = *(const u32x4*)(GQK + (tok0 + t) * 512 + h * 64 + 8 * dg), kv = *(const u32x4*)(GQK + (tok0 + t) * 512 + 256 + h * 64 + 8 * dg);
    if (stage) {
        const int idx = tid * 4, dir = idx >> 10, r = (idx >> 6) & 15, d = idx & 63;
        const float* w = (dir ? INP(11) : INP(9)) + (size_t)l * 16 * 256 + r * 256 + h * 64 + d;
        *(f32x4*)(wg + idx) = *(const f32x4*)w;
        if (tid < 128) { const int dr = tid >> 6, dd = tid & 63; bg[tid] = (dr ? INP(12) : INP(10))[l * 256 + h * 64 + dd]; }
        __syncthreads();
    }
    {
        float cf[32];
#pragma unroll
        for (int j = 0; j < 4; ++j) { const u32x4 v = j == 0 ? cq0 : (j == 1 ? cq1 : (j == 2 ? cq2 : cq3)); cf[8 * j + 0] = bflo(v.x); cf[8 * j + 1] = bfhi(v.x); cf[8 * j + 2] = bflo(v.y); cf[8 * j + 3] = bfhi(v.y); cf[8 * j + 4] = bflo(v.z); cf[8 * j + 5] = bfhi(v.z); cf[8 * j + 6] = bflo(v.w); cf[8 * j + 7] = bfhi(v.w); }
#pragma unroll
        for (int dir = 0; dir < 2; ++dir) {
            float z[8];
#pragma unroll
            for (int dd = 0; dd < 8; ++dd) z[dd] = bg[dir * 64 + 8 * dg + dd];
#pragma unroll
            for (int r = 0; r < 16; ++r) {
                const f32x4 w0 = *(const f32x4*)(wg + dir * 1024 + r * 64 + 8 * dg), w1 = *(const f32x4*)(wg + dir * 1024 + r * 64 + 8 * dg + 4);
                const float cv = cf[dir * 16 + r];
                z[0] += cv * w0[0]; z[1] += cv * w0[1]; z[2] += cv * w0[2]; z[3] += cv * w0[3]; z[4] += cv * w1[0]; z[5] += cv * w1[1]; z[6] += cv * w1[2]; z[7] += cv * w1[3];
            }
#pragma unroll
            for (int dd = 0; dd < 8; ++dd) gl[(dir * 64 + t) * 65 + 8 * dg + dd] = log_sigmoid_f(z[dd]) * (1.0f / 16.0f);
        }
    }
    __syncthreads();
    {
        const int dir = tid >> 8, seg = (tid >> 6) & 3, d = tid & 63;
        float* gp = gl + (dir * 64 + 16 * seg) * 65 + d; float v[16];
#pragma unroll
        for (int tt = 0; tt < 16; ++tt) v[tt] = gp[tt * 65];
        if (dir == 0) {
#pragma unroll
            for (int tt = 1; tt < 16; ++tt) v[tt] += v[tt - 1];
        } else {
#pragma unroll
            for (int tt = 14; tt >= 0; --tt) v[tt] += v[tt + 1];
        }
        tot[(dir * 4 + seg) * 64 + d] = dir == 0 ? v[15] : v[0];
        __syncthreads();
        float off = 0.f;
        if (dir == 0) { for (int s2 = 0; s2 < 4; ++s2) if (s2 < seg) off += tot[s2 * 64 + d]; }
        else { for (int s2 = 0; s2 < 4; ++s2) if (s2 > seg) off += tot[(4 + s2) * 64 + d]; }
#pragma unroll
        for (int tt = 0; tt < 16; ++tt) gp[tt * 65] = v[tt] + off;
    }
    __syncthreads();
    {
        float q[8], k[8];
        q[0] = bflo(qv.x); q[1] = bfhi(qv.x); q[2] = bflo(qv.y); q[3] = bfhi(qv.y); q[4] = bflo(qv.z); q[5] = bfhi(qv.z); q[6] = bflo(qv.w); q[7] = bfhi(qv.w);
        k[0] = bflo(kv.x); k[1] = bfhi(kv.x); k[2] = bflo(kv.y); k[3] = bfhi(kv.y); k[4] = bflo(kv.z); k[5] = bfhi(kv.z); k[6] = bflo(kv.w); k[7] = bfhi(kv.w);
        float qf[8], kf[8], qb[8], kb[8];
#pragma unroll
        for (int dd = 0; dd < 8; ++dd) {
            const int d = 8 * dg + dd;
            const float bf = gl[t * 65 + d], bb = gl[(64 + t) * 65 + d], bfl = gl[63 * 65 + d], bb0 = gl[64 * 65 + d];
            qf[dd] = q[dd] * 0.125f * __expf(bf); kf[dd] = k[dd] * __expf(-bf);
            qb[dd] = q[dd] * 0.125f * __expf(bb); kb[dd] = k[dd] * __expf(-bb);
            T[d * 72 + t] = (bf16)(pk2(k[dd] * __expf(bfl - bf), 0.f) & 0xffffu);
            T[(64 + d) * 72 + t] = (bf16)(pk2(k[dd] * __expf(bb0 - bb), 0.f) & 0xffffu);
        }
        const size_t go = (tok0 + t) * 256 + h * 64 + 8 * dg; const size_t AS = (size_t)M * 256;
        u32x4 w;
        w.x = pk2(qf[0], qf[1]); w.y = pk2(qf[2], qf[3]); w.z = pk2(qf[4], qf[5]); w.w = pk2(qf[6], qf[7]); *(u32x4*)(GP + go) = w;
        w.x = pk2(kf[0], kf[1]); w.y = pk2(kf[2], kf[3]); w.z = pk2(kf[4], kf[5]); w.w = pk2(kf[6], kf[7]); *(u32x4*)(GP + AS + go) = w;
        w.x = pk2(qb[0], qb[1]); w.y = pk2(qb[2], qb[3]); w.z = pk2(qb[4], qb[5]); w.w = pk2(qb[6], qb[7]); *(u32x4*)(GP + 2 * AS + go) = w;
        w.x = pk2(kb[0], kb[1]); w.y = pk2(kb[2], kb[3]); w.z = pk2(kb[4], kb[5]); w.w = pk2(kb[6], kb[7]); *(u32x4*)(GP + 3 * AS + go) = w;
        if (tid < 128) { const int dir = tid >> 6, d = tid & 63; DEC[((size_t)(dir * 32 + bh) * 64 + c) * 64 + d] = __expf(dir ? gl[64 * 65 + d] : gl[63 * 65 + d]); }
    }
    __syncthreads();
#pragma unroll
    for (int i = 0; i < 2; ++i) {
        const int u = tid + 512 * i, dir = u >> 9, d = (u >> 3) & 63, j = u & 7;
        *(u32x4*)(KT + ((size_t)((tok0 >> 3) + j) * 512 + dir * 256 + h * 64 + d) * 8) = *(const u32x4*)(T + (dir * 64 + d) * 72 + 8 * j);
    }
    __syncthreads();
}

DI void gla_scan_item(const Args& A, int item, int wave, int lane) {
    unsigned char* R = WSP() + WS_R;
    const bf16* VT = (const bf16*)(R + R_VT); const bf16* KT = (const bf16*)(R + R_KT); const float* DEC = (const float*)(R + R_DEC); bf16* SBEF = (bf16*)(R + R_SBEF);
    const int es = item & 3, chain = item >> 2, dir = chain >> 5, bh = chain & 31, h = bh & 3, b = bh >> 2;
    const int c = lane & 15, g = lane >> 4, ebl = wave >> 2, db = wave & 3, e0 = 32 * es + 16 * ebl;
    const bf16* kp = KT + ((size_t)(b * 512 + g) * 512 + dir * 256 + h * 64 + 16 * db + c) * 8;
    const bf16* vp = VT + ((size_t)(b * 512 + g) * 1024 + 512 + h * 128 + e0 + c) * 8;
    const float* dp = DEC + (size_t)chain * 64 * 64 + 16 * db + 4 * g;
    bf16* sp = SBEF + ((size_t)chain * 64 * 128 + e0 + c) * 64 + 16 * db + 4 * g;
    f32x4 S = {0.f, 0.f, 0.f, 0.f};
#define SC_CH(n) (dir ? 63 - (n) : (n))
#define SC_LOAD(k, n) do { const int c_ = SC_CH((n) < 63 ? (n) : 63); a0##k = ld16(kp + (size_t)c_ * 32768); a1##k = ld16(kp + (size_t)c_ * 32768 + 16384); b0##k = ld16(vp + (size_t)c_ * 65536); b1##k = ld16(vp + (size_t)c_ * 65536 + 32768); dc##k = *(const f32x4*)(dp + c_ * 64); } while (0)
#define SC_STEP(k, n) do { u32x2 w_; w_.x = pk2(S[0], S[1]); w_.y = pk2(S[2], S[3]); *(u32x2*)(sp + (size_t)SC_CH(n) * 128 * 64) = w_; S = S * dc##k; S = mfma16(a0##k, b0##k, S); S = mfma16(a1##k, b1##k, S); } while (0)
    bf16x8 a00, a10, b00, b10, a01, a11, b01, b11, a02, a12, b02, b12, a03, a13, b03, b13; f32x4 dc0, dc1, dc2, dc3;
    SC_LOAD(0, 0); SC_LOAD(1, 1); SC_LOAD(2, 2); SC_LOAD(3, 3);
#pragma unroll 1
    for (int n = 0; n < 64; n += 4) {
        SC_STEP(0, n); SC_LOAD(0, n + 4);
        SC_STEP(1, n + 1); SC_LOAD(1, n + 5);
        SC_STEP(2, n + 2); SC_LOAD(2, n + 6);
        SC_STEP(3, n + 3); SC_LOAD(3, n + 7);
    }
#undef SC_CH
#undef SC_LOAD
#undef SC_STEP
}

constexpr int SC_STEP_B = 12544, SC_BATCH_B = 4 * SC_STEP_B;
struct ScStage { u32x4 k[4]; u32x4 x[4]; };
DI void sc_gload(ScStage& st, int item, int batch, int tid) {
    unsigned char* R = WSP() + WS_R;
    const bf16* VT = (const bf16*)(R + R_VT); const bf16* KT = (const bf16*)(R + R_KT); const float* DEC = (const float*)(R + R_DEC);
    const int es = item & 3, chain = item >> 2, dir = chain >> 5, bh = chain & 31, h = bh & 3, b = bh >> 2;
#pragma unroll
    for (int s4 = 0; s4 < 4; ++s4) {
        const int n = 4 * batch + s4, cc = dir ? 63 - n : n;
        st.k[s4] = *(const u32x4*)(KT + ((size_t)(b * 512 + cc * 8 + (tid >> 6)) * 512 + dir * 256 + h * 64 + (tid & 63)) * 8);
        if (tid < 256) st.x[s4] = *(const u32x4*)(VT + ((size_t)(b * 512 + cc * 8 + (tid >> 5)) * 1024 + 512 + h * 128 + 32 * es + (tid & 31)) * 8);
        else if (tid < 272) st.x[s4] = *(const u32x4*)(DEC + ((size_t)chain * 64 + cc) * 64 + (tid - 256) * 4);
    }
}
DI void sc_lwrite(const ScStage& st, unsigned char* buf, int tid) {
#pragma unroll
    for (int s4 = 0; s4 < 4; ++s4) {
        *(u32x4*)(buf + s4 * SC_STEP_B + tid * 16) = st.k[s4];
        if (tid < 256) *(u32x4*)(buf + s4 * SC_STEP_B + 8192 + tid * 16) = st.x[s4];
        else if (tid < 272) *(u32x4*)(buf + s4 * SC_STEP_B + 12288 + (tid - 256) * 16) = st.x[s4];
    }
}
DI void gla_scan_item_lds(unsigned char* ldsb, int item, int tid, int wave, int lane) {
    unsigned char* R = WSP() + WS_R; bf16* SBEF = (bf16*)(R + R_SBEF);
    const int es = item & 3, chain = item >> 2, dir = chain >> 5;
    const int c = lane & 15, g = lane >> 4, ebl = wave >> 2, db = wave & 3, e0 = 32 * es + 16 * ebl;
    bf16* sp = SBEF + ((size_t)chain * 64 * 128 + e0 + c) * 64 + 16 * db + 4 * g;
    const int ao = g * 1024 + (16 * db + c) * 16, bo = 8192 + g * 512 + (16 * ebl + c) * 16, dco = 12288 + (16 * db + 4 * g) * 4;
    f32x4 S = {0.f, 0.f, 0.f, 0.f};
    ScStage st; sc_gload(st, item, 0, tid); sc_lwrite(st, ldsb, tid); sc_gload(st, item, 1, tid);
    __syncthreads();
#pragma unroll 1
    for (int m = 0; m < 16; ++m) {
        const unsigned char* buf = ldsb + (m & 1) * SC_BATCH_B;
#pragma unroll
        for (int s4 = 0; s4 < 4; ++s4) {
            const int n = 4 * m + s4, cc = dir ? 63 - n : n; const unsigned char* sb = buf + s4 * SC_STEP_B;
            u32x2 w_; w_.x = pk2(S[0], S[1]); w_.y = pk2(S[2], S[3]); *(u32x2*)(sp + (size_t)cc * 128 * 64) = w_;
            const f32x4 dc = *(const f32x4*)(sb + dco);
            S = S * dc;
            S = mfma16(*(const bf16x8*)(sb + ao), *(const bf16x8*)(sb + bo), S);
            S = mfma16(*(const bf16x8*)(sb + ao + 4096), *(const bf16x8*)(sb + bo + 2048), S);
        }
        if (m < 15) sc_lwrite(st, ldsb + ((m + 1) & 1) * SC_BATCH_B, tid);
        if (m < 14) sc_gload(st, item, m + 2, tid);
        __syncthreads();
    }
}

DI void gla_out_item(const Args& A, int l, int item, int tb, int lane) {
    unsigned char* R = WSP() + WS_R;
    const bf16* VT = (const bf16*)(R + R_VT); const bf16* GP = (const bf16*)(R + R_GP); const bf16* SBEF = (const bf16*)(R + R_SBEF); const bf16* GR = (const bf16*)(R + R_GR); bf16* MIX = (bf16*)(R + R_MIX);
    const size_t AS = (size_t)M * 256;
    const int ck = item & 63, bh = item >> 6, h = bh & 3, b = bh >> 2, c = lane & 15, g = lane >> 4;
    const size_t tok0 = (size_t)b * SEQ + ck * 64;
    const size_t qo = (tok0 + 16 * tb + c) * 256 + h * 64 + 8 * g;
    const bf16x8 qf0 = ld16(GP + qo), qf1 = ld16(GP + qo + 32), qb0 = ld16(GP + 2 * AS + qo), qb1 = ld16(GP + 2 * AS + qo + 32);
    bf16x8 kfr[8], kbr[8];
#pragma unroll
    for (int i = 0; i < 8; ++i) {
        const size_t ko = (tok0 + 16 * (i >> 1) + c) * 256 + h * 64 + 8 * g + 32 * (i & 1);
        kfr[i] = ld16(GP + AS + ko); kbr[i] = ld16(GP + 3 * AS + ko);
    }
    const bf16* sf = SBEF + ((size_t)(bh * 64 + ck) * 128 + c) * 64 + 8 * g;
    const bf16* sbk = SBEF + ((size_t)((32 + bh) * 64 + ck) * 128 + c) * 64 + 8 * g;
    const bf16* vt = VT + ((size_t)((tok0 >> 3) + (g >> 1)) * 1024 + 512 + h * 128 + c) * 8 + 4 * (g & 1);
    u32x2 vv[2][8]; bf16x8 sv[2][8];
#define GO_LOAD(buf, eb0) do { _Pragma("unroll") for (int e_ = 0; e_ < 2; ++e_) { const bf16* v_ = vt + 128 * ((eb0) + e_); \
        vv[buf][4 * e_ + 0] = *(const u32x2*)(v_); vv[buf][4 * e_ + 1] = *(const u32x2*)(v_ + 16384); vv[buf][4 * e_ + 2] = *(const u32x2*)(v_ + 32768); vv[buf][4 * e_ + 3] = *(const u32x2*)(v_ + 49152); \
        sv[buf][4 * e_ + 0] = ld16(sf + ((eb0) + e_) * 1024); sv[buf][4 * e_ + 1] = ld16(sf + ((eb0) + e_) * 1024 + 32); sv[buf][4 * e_ + 2] = ld16(sbk + ((eb0) + e_) * 1024); sv[buf][4 * e_ + 3] = ld16(sbk + ((eb0) + e_) * 1024 + 32); } } while (0)
    GO_LOAD(0, 0);
    SCHED_FENCE();
    f32x4 at[4];
#pragma unroll
    for (int sb = 0; sb < 4; ++sb) {
        f32x4 f = {0.f, 0.f, 0.f, 0.f}, bk = {0.f, 0.f, 0.f, 0.f};
        f = mfma16(kfr[2 * sb], qf0, f); f = mfma16(kfr[2 * sb + 1], qf1, f);
        bk = mfma16(kbr[2 * sb], qb0, bk); bk = mfma16(kbr[2 * sb + 1], qb1, bk);
#pragma unroll
        for (int i = 0; i < 4; ++i) at[sb][i] = (16 * sb + 4 * g + i <= 16 * tb + c) ? f[i] : bk[i];
    }
    const bf16x8 p0 = pack8(at[0], at[1]), p1 = pack8(at[2], at[3]);
    SCHED_FENCE();
    f32x4 o[8]; float ss = 0.f;
#pragma unroll
    for (int bp = 0; bp < 4; ++bp) {
        if (bp < 3) GO_LOAD((bp + 1) & 1, 2 * bp + 2);
        SCHED_FENCE();
#pragma unroll
        for (int e = 0; e < 2; ++e) {
            f32x4 acc = {0.f, 0.f, 0.f, 0.f};
            const u32x2 v0 = vv[bp & 1][4 * e], v1 = vv[bp & 1][4 * e + 1], v2 = vv[bp & 1][4 * e + 2], v3 = vv[bp & 1][4 * e + 3];
            u32x4 a0; a0.x = v0.x; a0.y = v0.y; a0.z = v1.x; a0.w = v1.y; u32x4 a1; a1.x = v2.x; a1.y = v2.y; a1.z = v3.x; a1.w = v3.y;
            acc = mfma16(__builtin_bit_cast(bf16x8, a0), p0, acc); acc = mfma16(__builtin_bit_cast(bf16x8, a1), p1, acc);
            acc = mfma16(sv[bp & 1][4 * e], qf0, acc); acc = mfma16(sv[bp & 1][4 * e + 1], qf1, acc);
            acc = mfma16(sv[bp & 1][4 * e + 2], qb0, acc); acc = mfma16(sv[bp & 1][4 * e + 3], qb1, acc);
            o[2 * bp + e] = acc; ss += (acc[0] * acc[0] + acc[1] * acc[1]) + (acc[2] * acc[2] + acc[3] * acc[3]);
        }
        SCHED_FENCE();
    }
#undef GO_LOAD
    ss += __shfl_xor(ss, 16); ss += __shfl_xor(ss, 32);
    const float rstd = rsqrtf(ss * (1.0f / 128.0f) + EPS);
    const float* gain = INP(13) + l * 128 + 4 * g;
    const size_t tok = tok0 + 16 * tb + c;
#pragma unroll
    for (int eb = 0; eb < 8; ++eb) {
        const f32x4 gn = *(const f32x4*)(gain + 16 * eb);
        const u32x2 gr = *(const u32x2*)(GR + tok * 512 + h * 128 + 16 * eb + 4 * g);
        const float r0 = bflo(gr.x), r1 = bfhi(gr.x), r2 = bflo(gr.y), r3 = bfhi(gr.y);
        u32x2 w; w.x = pk2(o[eb][0] * rstd * gn[0] * silu_f(r0), o[eb][1] * rstd * gn[1] * silu_f(r1)); w.y = pk2(o[eb][2] * rstd * gn[2] * silu_f(r2), o[eb][3] * rstd * gn[3] * silu_f(r3));
        *(u32x2*)(MIX + tok * 1024 + 512 + h * 128 + 16 * eb + 4 * g) = w;
    }
}

constexpr int GO_KF = 0, GO_KB = 9216, GO_VT = 18432, GO_SF = 34816, GO_SB = 53248, GO_ITEM = 71680;
struct GoStage { u32x4 r[16]; bf16x8 q[4]; };
DI void go_gload(GoStage& st, int item, int t256, int tb, int lane) {
    unsigned char* R = WSP() + WS_R;
    const bf16* VT = (const bf16*)(R + R_VT); const bf16* GP = (const bf16*)(R + R_GP); const bf16* SBEF = (const bf16*)(R + R_SBEF);
    const size_t AS = (size_t)M * 256;
    const int ck = item & 63, bh = item >> 6, h = bh & 3, b = bh >> 2;
    const size_t tok0 = (size_t)b * SEQ + ck * 64;
#pragma unroll
    for (int j = 0; j < 16; ++j) {
        const int q = t256 + 256 * (j & 3);
        const bf16* src;
        if (j < 2)       { const int qq = t256 + 256 * j;       src = GP + AS + (tok0 + (qq >> 3)) * 256 + h * 64 + (qq & 7) * 8; }
        else if (j < 4)  { const int qq = t256 + 256 * (j - 2); src = GP + 3 * AS + (tok0 + (qq >> 3)) * 256 + h * 64 + (qq & 7) * 8; }
        else if (j < 8)  { src = VT + ((size_t)((tok0 >> 3) + (q >> 7)) * 1024 + 512 + h * 128 + (q & 127)) * 8; }
        else if (j < 12) { src = SBEF + (size_t)(bh * 64 + ck) * 8192 + q * 8; }
        else             { src = SBEF + (size_t)((32 + bh) * 64 + ck) * 8192 + q * 8; }
        st.r[j] = *(const u32x4*)src;
    }
    const size_t qo = (tok0 + 16 * tb + (lane & 15)) * 256 + h * 64 + 8 * (lane >> 4);
    st.q[0] = ld16(GP + qo); st.q[1] = ld16(GP + qo + 32); st.q[2] = ld16(GP + 2 * AS + qo); st.q[3] = ld16(GP + 2 * AS + qo + 32);
}
DI void go_lwrite(const GoStage& st, unsigned char* base, int t256) {
#pragma unroll
    for (int j = 0; j < 16; ++j) {
        const int q = t256 + 256 * (j & 3); unsigned char* dst;
        if (j < 2)       { const int qq = t256 + 256 * j;       dst = base + GO_KF + (qq >> 3) * 144 + (qq & 7) * 16; }
        else if (j < 4)  { const int qq = t256 + 256 * (j - 2); dst = base + GO_KB + (qq >> 3) * 144 + (qq & 7) * 16; }
        else if (j < 8)  { dst = base + GO_VT + q * 16; }
        else if (j < 12) { dst = base + GO_SF + (q >> 3) * 144 + (q & 7) * 16; }
        else             { dst = base + GO_SB + (q >> 3) * 144 + (q & 7) * 16; }
        *(u32x4*)dst = st.r[j];
    }
}
DI void go_compute(int l, const unsigned char* base, const bf16x8 (&qq)[4], int item, int tb, int lane) {
    unsigned char* R = WSP() + WS_R;
    const bf16* GR = (const bf16*)(R + R_GR); bf16* MIX = (bf16*)(R + R_MIX);
    const int ck = item & 63, bh = item >> 6, h = bh & 3, b = bh >> 2, c = lane & 15, g = lane >> 4;
    const size_t tok0 = (size_t)b * SEQ + ck * 64;
    const bf16x8 qf0 = qq[0], qf1 = qq[1], qb0 = qq[2], qb1 = qq[3];
    f32x4 at[4];
#pragma unroll
    for (int sb = 0; sb < 4; ++sb) {
        const unsigned char* kf = base + GO_KF + (16 * sb + c) * 144 + g * 16; const unsigned char* kb = base + GO_KB + (16 * sb + c) * 144 + g * 16;
        f32x4 f = {0.f, 0.f, 0.f, 0.f}, bk = {0.f, 0.f, 0.f, 0.f};
        f = mfma16(*(const bf16x8*)kf, qf0, f); f = mfma16(*(const bf16x8*)(kf + 64), qf1, f);
        bk = mfma16(*(const bf16x8*)kb, qb0, bk); bk = mfma16(*(const bf16x8*)(kb + 64), qb1, bk);
#pragma unroll
        for (int i = 0; i < 4; ++i) at[sb][i] = (16 * sb + 4 * g + i <= 16 * tb + c) ? f[i] : bk[i];
    }
    const bf16x8 p0 = pack8(at[0], at[1]), p1 = pack8(at[2], at[3]);
    f32x4 o[8]; float ss = 0.f;
#pragma unroll
    for (int eb = 0; eb < 8; ++eb) {
        const unsigned char* vp = base + GO_VT + (g >> 1) * 2048 + (16 * eb + c) * 16 + (g & 1) * 8;
        const u32x2 v0 = *(const u32x2*)vp, v1 = *(const u32x2*)(vp + 4096), v2 = *(const u32x2*)(vp + 8192), v3 = *(const u32x2*)(vp + 12288);
        u32x4 a0; a0.x = v0.x; a0.y = v0.y; a0.z = v1.x; a0.w = v1.y; u32x4 a1; a1.x = v2.x; a1.y = v2.y; a1.z = v3.x; a1.w = v3.y;
        const unsigned char* sfp = base + GO_SF + (16 * eb + c) * 144 + g * 16; const unsigned char* sbp = base + GO_SB + (16 * eb + c) * 144 + g * 16;
        f32x4 acc = {0.f, 0.f, 0.f, 0.f};
        acc = mfma16(__builtin_bit_cast(bf16x8, a0), p0, acc); acc = mfma16(__builtin_bit_cast(bf16x8, a1), p1, acc);
        acc = mfma16(*(const bf16x8*)sfp, qf0, acc); acc = mfma16(*(const bf16x8*)(sfp + 64), qf1, acc);
        acc = mfma16(*(const bf16x8*)sbp, qb0, acc); acc = mfma16(*(const bf16x8*)(sbp + 64), qb1, acc);
        o[eb] = acc; ss += (acc[0] * acc[0] + acc[1] * acc[1]) + (acc[2] * acc[2] + acc[3] * acc[3]);
    }
    ss += __shfl_xor(ss, 16); ss += __shfl_xor(ss, 32);
    const float rstd = rsqrtf(ss * (1.0f / 128.0f) + EPS);
    const float* gain = INP(13) + l * 128 + 4 * g;
    const size_t tok = tok0 + 16 * tb + c;
#pragma unroll
    for (int eb = 0; eb < 8; ++eb) {
        const f32x4 gn = *(const f32x4*)(gain + 16 * eb);
        const u32x2 gr = *(const u32x2*)(GR + tok * 512 + h * 128 + 16 * eb + 4 * g);
        const float r0 = bflo(gr.x), r1 = bfhi(gr.x), r2 = bflo(gr.y), r3 = bfhi(gr.y);
        u32x2 w; w.x = pk2(o[eb][0] * rstd * gn[0] * silu_f(r0), o[eb][1] * rstd * gn[1] * silu_f(r1)); w.y = pk2(o[eb][2] * rstd * gn[2] * silu_f(r2), o[eb][3] * rstd * gn[3] * silu_f(r3));
        *(u32x2*)(MIX + tok * 1024 + 512 + h * 128 + 16 * eb + 4 * g) = w;
    }
}
DI int go_item(bool xl, int xq, int k, int half) { const int idx = 2 * k + half; return xl ? ((((xq << 2) | (idx >> 6)) << 6) | (idx & 63)) : idx; }
DI void gla_out_phase(int l, unsigned char* ldsb, int tid, int wave, int lane, bool xl, int xq, int k0, int kend, int kstep) {
    const int half = wave >> 2, tb = wave & 3, t256 = tid & 255;
    unsigned char* base = ldsb + half * GO_ITEM;
    if (k0 >= kend) return;
    GoStage st; go_gload(st, go_item(xl, xq, k0, half), t256, tb, lane);
    for (int k = k0; k < kend; k += kstep) {
        go_lwrite(st, base, t256);
        bf16x8 qq[4] = {st.q[0], st.q[1], st.q[2], st.q[3]};
        __syncthreads();
        if (k + kstep < kend) go_gload(st, go_item(xl, xq, k + kstep, half), t256, tb, lane);
        SCHED_FENCE();
        go_compute(l, base, qq, go_item(xl, xq, k, half), tb, lane);
        __syncthreads();
    }
}

DI void na_stage_rpb(int l, float* rpbs, int tid) {
    const float* rpb = INP(7) + (size_t)l * 8 * 465;
    for (int i = tid; i < 8 * 465; i += NWAVES * 64) rpbs[i] = rpb[i];
    __syncthreads();
}
DI void na_item(const Args& A, int l, float* nss, const float* rpbs, int item, int h, int lane) {
    unsigned char* R = WSP() + WS_R;
    const bf16* QK = (const bf16*)(R + R_QKNA); const bf16* VT = (const bf16*)(R + R_VT); bf16* MIX = (bf16*)(R + R_MIX);
    const float* rpb = rpbs + h * 465;
    const int c = lane & 15, g = lane >> 4;
    const int j = item & 3, r = (item >> 2) & 63, b = item >> 8;
    const int rs = min(max(r - 4, 0), 56), c0 = min(max(16 * j - 8, 0), 32);
    const size_t tokq = (size_t)b * SEQ + r * 64 + 16 * j + c;
    const bf16x8 q0 = ld16(QK + tokq * 1024 + h * 64 + 8 * g), q1 = ld16(QK + tokq * 1024 + h * 64 + 32 + 8 * g);
    const bf16* kbase = QK + ((size_t)b * SEQ + rs * 64 + c0 + c) * 1024 + 512 + h * 64 + 8 * g;
    const bf16* vbase = VT + ((size_t)((b * SEQ + rs * 64 + c0 + 4 * g) >> 3) * 1024 + h * 64 + c) * 8 + 4 * (g & 1);
    f32x4 st[8][2];
    bf16x8 kf[2][16];
#pragma unroll
    for (int bb = 0; bb < 2; ++bb)
#pragma unroll
        for (int i = 0; i < 16; ++i) kf[bb][i] = ld16(kbase + (size_t)(4 * bb + (i >> 2)) * 65536 + ((i >> 1) & 1) * 16384 + (i & 1) * 32);
    SCHED_FENCE();
    u32x2 vf[2][16];
#pragma unroll
    for (int bb = 0; bb < 2; ++bb) {
#pragma unroll
        for (int t = 0; t < 8; ++t) {
            f32x4 s = {0.f, 0.f, 0.f, 0.f}; s = mfma16(kf[bb][2 * t], q0, s); s = mfma16(kf[bb][2 * t + 1], q1, s); st[4 * bb + (t >> 1)][t & 1] = s;
        }
        SCHED_FENCE();
        if (bb == 0) {
#pragma unroll
            for (int i = 0; i < 16; ++i) vf[0][i] = *(const u32x2*)(vbase + (size_t)(i >> 3) * 65536 + 128 * ((i >> 1) & 3) + (i & 1) * 16384);
            SCHED_FENCE();
        }
    }
    const int qc = 16 * j + c, cs = min(max(qc - 8, 0), 48);
    float mx = -3.0e38f;
#pragma unroll
    for (int w = 0; w < 8; ++w) {
        const float* rp = rpb + (rs + w - r + 7) * 31;
#pragma unroll
        for (int hf = 0; hf < 2; ++hf)
#pragma unroll
            for (int i = 0; i < 4; ++i) {
                const int kc = c0 + 16 * hf + 4 * g + i; const bool valid = (kc >= cs) && (kc < cs + 16);
                const int dc = min(max(kc - qc + 15, 0), 30);
                const float bv = rp[dc];
                const float s = valid ? st[w][hf][i] * 0.125f + bv : -1.0e30f;
                st[w][hf][i] = s; mx = fmaxf(mx, s);
            }
    }
    mx = fmaxf(mx, __shfl_xor(mx, 16)); mx = fmaxf(mx, __shfl_xor(mx, 32));
    float sum = 0.f;
#pragma unroll
    for (int w = 0; w < 8; ++w)
#pragma unroll
        for (int hf = 0; hf < 2; ++hf)
#pragma unroll
            for (int i = 0; i < 4; ++i) { const float p = __expf(st[w][hf][i] - mx); st[w][hf][i] = p; sum += p; }
    sum += __shfl_xor(sum, 16); sum += __shfl_xor(sum, 32);
    f32x4 o[4];
#pragma unroll
    for (int db = 0; db < 4; ++db) o[db] = (f32x4){0.f, 0.f, 0.f, 0.f};
#pragma unroll
    for (int wp = 0; wp < 4; ++wp) {
        if (wp < 3) {
#pragma unroll
            for (int i = 0; i < 16; ++i) vf[(wp + 1) & 1][i] = *(const u32x2*)(vbase + (size_t)(2 * wp + 2 + (i >> 3)) * 65536 + 128 * ((i >> 1) & 3) + (i & 1) * 16384);
        }
        SCHED_FENCE();
#pragma unroll
        for (int ww = 0; ww < 2; ++ww) {
            const bf16x8 p = pack8(st[2 * wp + ww][0], st[2 * wp + ww][1]);
#pragma unroll
            for (int db = 0; db < 4; ++db) {
                const u32x2 lo = vf[wp & 1][8 * ww + 2 * db], hi = vf[wp & 1][8 * ww + 2 * db + 1];
                u32x4 v; v.x = lo.x; v.y = lo.y; v.z = hi.x; v.w = hi.y;
                o[db] = mfma16(__builtin_bit_cast(bf16x8, v), p, o[db]);
            }
        }
        SCHED_FENCE();
    }
    const float inv = 1.0f / sum; float ss = 0.f;
#pragma unroll
    for (int db = 0; db < 4; ++db) { o[db] = o[db] * inv; ss += (o[db][0] * o[db][0] + o[db][1] * o[db][1]) + (o[db][2] * o[db][2] + o[db][3] * o[db][3]); }
    ss += __shfl_xor(ss, 16); ss += __shfl_xor(ss, 32);
    if (g == 0) nss[h * 16 + c] = ss;
    __syncthreads();
    float tot = 0.f;
#pragma unroll
    for (int hh = 0; hh < 8; ++hh) tot += nss[hh * 16 + c];
    const float rstd = rsqrtf(tot * (1.0f / 512.0f) + EPS);
    const float* gain = INP(8) + l * 512 + h * 64 + 4 * g;
#pragma unroll
    for (int db = 0; db < 4; ++db) {
        const f32x4 gn = *(const f32x4*)(gain + 16 * db);
        u32x2 w; w.x = pk2(o[db][0] * rstd * gn[0], o[db][1] * rstd * gn[1]); w.y = pk2(o[db][2] * rstd * gn[2], o[db][3] * rstd * gn[3]);
        *(u32x2*)(MIX + tokq * 1024 + h * 64 + 16 * db + 4 * g) = w;
    }
    __syncthreads();
}

struct NaKV { bf16x8 k[4]; u32x2 v[8]; };
DI NaKV na_load_kv(const bf16* kbase, const bf16* vbase, int krel) {
    NaKV f;
#pragma unroll
    for (int i = 0; i < 4; ++i) f.k[i] = ld16(kbase + (size_t)krel * 65536 + (i >> 1) * 16384 + (i & 1) * 32);
#pragma unroll
    for (int i = 0; i < 8; ++i) f.v[i] = *(const u32x2*)(vbase + (size_t)krel * 65536 + 128 * (i >> 1) + (i & 1) * 16384);
    return f;
}
DI void na_pair(const NaKV& f, bf16x8 q0, bf16x8 q1, const float* rp  , const int (&dcv)[8], unsigned vmask, float& m, float& l, f32x4 (&o)[4]) {
    f32x4 s0 = {0.f, 0.f, 0.f, 0.f}, s1 = {0.f, 0.f, 0.f, 0.f};
    s0 = mfma16(f.k[0], q0, s0); s0 = mfma16(f.k[1], q1, s0);
    s1 = mfma16(f.k[2], q0, s1); s1 = mfma16(f.k[3], q1, s1);
    float sv[8]; float mx = -1.0e30f;
#pragma unroll
    for (int e = 0; e < 8; ++e) {
        const float raw = e < 4 ? s0[e] : s1[e - 4];
        const float bv = rp[dcv[e]];
        sv[e] = ((vmask >> e) & 1u) ? raw * 0.125f + bv : -1.0e30f;
        mx = fmaxf(mx, sv[e]);
    }
    mx = fmaxf(mx, __shfl_xor(mx, 16)); mx = fmaxf(mx, __shfl_xor(mx, 32));
    const float mn = fmaxf(m, mx), alpha = __expf(m - mn); m = mn;
    float ps = 0.f; f32x4 p0, p1;
#pragma unroll
    for (int e = 0; e < 4; ++e) { p0[e] = __expf(sv[e] - mn); p1[e] = __expf(sv[4 + e] - mn); ps += p0[e] + p1[e]; }
    l = l * alpha + ps;
    const bf16x8 p = pack8(p0, p1);
#pragma unroll
    for (int db = 0; db < 4; ++db) {
        u32x4 v; v.x = f.v[2 * db].x; v.y = f.v[2 * db].y; v.z = f.v[2 * db + 1].x; v.w = f.v[2 * db + 1].y;
        o[db] = mfma16(__builtin_bit_cast(bf16x8, v), p, o[db] * alpha);
    }
}
DI void na_stage_rpb2(int l, float* rpbs, int tid) {
    const float* rpb = INP(7) + (size_t)l * 8 * 465;
    for (int i = tid; i < 8 * 15 * 32; i += NWAVES * 64) { const int col = i & 31, hr = i >> 5; rpbs[i] = col < 31 ? rpb[hr * 31 + col] * 1.44269504f : -1.0e30f; }
    __syncthreads();
}
DI void na_pair2(const NaKV& f, bf16x8 q0, bf16x8 q1, const float* rp  , const int (&dcv)[8], float& m, float& l, f32x4 (&o)[4]) {
    f32x4 s0 = {0.f, 0.f, 0.f, 0.f}, s1 = {0.f, 0.f, 0.f, 0.f};
    s0 = mfma16(f.k[0], q0, s0); s0 = mfma16(f.k[1], q1, s0);
    s1 = mfma16(f.k[2], q0, s1); s1 = mfma16(f.k[3], q1, s1);
    float sv[8];
#pragma unroll
    for (int e = 0; e < 8; ++e) sv[e] = (e < 4 ? s0[e] : s1[e - 4]) * (0.125f * 1.44269504f) + rp[dcv[e]];
    float mx = fmaxf(fmaxf(sv[0], sv[1]), fmaxf(sv[2], sv[3])); mx = fmaxf(mx, fmaxf(fmaxf(sv[4], sv[5]), fmaxf(sv[6], sv[7])));
    mx = fmaxf(mx, __shfl_xor(mx, 16)); mx = fmaxf(mx, __shfl_xor(mx, 32));
    const float mn = fmaxf(m, mx), alpha = __builtin_amdgcn_exp2f(m - mn); m = mn;
    float ps = 0.f; f32x4 p0, p1;
#pragma unroll
    for (int e = 0; e < 4; ++e) { p0[e] = __builtin_amdgcn_exp2f(sv[e] - mn); p1[e] = __builtin_amdgcn_exp2f(sv[4 + e] - mn); ps += p0[e] + p1[e]; }
    l = l * alpha + ps;
    const bf16x8 p = pack8(p0, p1);
#pragma unroll
    for (int db = 0; db < 4; ++db) {
        u32x4 v; v.x = f.v[2 * db].x; v.y = f.v[2 * db].y; v.z = f.v[2 * db + 1].x; v.w = f.v[2 * db + 1].y;
        o[db] = mfma16(__builtin_bit_cast(bf16x8, v), p, o[db] * alpha);
    }
}
DI void na_strip(const Args& A, int l, float* nss, const float* rpbs, int item, int h, int lane) {
    unsigned char* R = WSP() + WS_R;
    const bf16* QK = (const bf16*)(R + R_QKNA); const bf16* VT = (const bf16*)(R + R_VT); bf16* MIX = (bf16*)(R + R_MIX);
    const float* rpb = rpbs + h * 480;
    const int c = lane & 15, g = lane >> 4;
    const int j = item & 3, r0 = ((item >> 2) & 15) * 4, b = item >> 6;
    const int c0 = min(max(16 * j - 8, 0), 32);
    const int kmin = min(max(r0 - 4, 0), 56), kmax = min(max(r0 + 3 - 4, 0), 56) + 7, nrows = kmax - kmin + 1;
    const int qc = 16 * j + c, cs = min(max(qc - 8, 0), 48);
    int dcv[8];
#pragma unroll
    for (int e = 0; e < 8; ++e) { const int kc = c0 + 16 * (e >> 2) + 4 * g + (e & 3); dcv[e] = (kc >= cs && kc < cs + 16) ? min(max(kc - qc + 15, 0), 30) : 31; }
    bf16x8 q0[4], q1[4];
#pragma unroll
    for (int i = 0; i < 4; ++i) { const bf16* qp = QK + ((size_t)b * SEQ + (r0 + i) * 64 + 16 * j + c) * 1024 + h * 64 + 8 * g; q0[i] = ld16(qp); q1[i] = ld16(qp + 32); }
    const bf16* kbase = QK + ((size_t)b * SEQ + kmin * 64 + c0 + c) * 1024 + 512 + h * 64 + 8 * g;
    const bf16* vbase = VT + ((size_t)((b * SEQ + kmin * 64 + c0 + 4 * g) >> 3) * 1024 + h * 64 + c) * 8 + 4 * (g & 1);
    float m[4], ls[4]; f32x4 o[4][4];
#pragma unroll
    for (int i = 0; i < 4; ++i) { m[i] = -1.0e30f; ls[i] = 0.f;
#pragma unroll
        for (int db = 0; db < 4; ++db) o[i][db] = (f32x4){0.f, 0.f, 0.f, 0.f}; }
    int rs[4];
#pragma unroll
    for (int i = 0; i < 4; ++i) rs[i] = min(max(r0 + i - 4, 0), 56);
#define NA_ROW(F, KR) do { _Pragma("unroll") for (int i_ = 0; i_ < 4; ++i_) { if ((KR) >= rs[i_] && (KR) <= rs[i_] + 7) na_pair2(F, q0[i_], q1[i_], rpb + ((KR) - (r0 + i_) + 7) * 32, dcv, m[i_], ls[i_], o[i_]); } } while (0)
    NaKV fa = na_load_kv(kbase, vbase, 0), fb;
#pragma unroll 1
    for (int t = 0; t < nrows; t += 2) {
        fb = na_load_kv(kbase, vbase, min(t + 1, nrows - 1));
        SCHED_FENCE();
        NA_ROW(fa, kmin + t);
        SCHED_FENCE();
        fa = na_load_kv(kbase, vbase, min(t + 2, nrows - 1));
        SCHED_FENCE();
        if (t + 1 < nrows) NA_ROW(fb, kmin + t + 1);
        SCHED_FENCE();
    }
#undef NA_ROW
    float ssv[4];
#pragma unroll
    for (int i = 0; i < 4; ++i) {
        float lt = ls[i]; lt += __shfl_xor(lt, 16); lt += __shfl_xor(lt, 32);
        const float inv = 1.0f / lt; float ss = 0.f;
#pragma unroll
        for (int db = 0; db < 4; ++db) { o[i][db] = o[i][db] * inv; ss += (o[i][db][0] * o[i][db][0] + o[i][db][1] * o[i][db][1]) + (o[i][db][2] * o[i][db][2] + o[i][db][3] * o[i][db][3]); }
        ss += __shfl_xor(ss, 16); ss += __shfl_xor(ss, 32);
        ssv[i] = ss;
        if (g == 0) nss[(i * 8 + h) * 16 + c] = ss;
    }
    __syncthreads();
    const float* gain = INP(8) + l * 512 + h * 64 + 4 * g;
#pragma unroll
    for (int i = 0; i < 4; ++i) {
        float tot = 0.f;
#pragma unroll
        for (int hh = 0; hh < 8; ++hh) tot += nss[(i * 8 + hh) * 16 + c];
        const float rstd = rsqrtf(tot * (1.0f / 512.0f) + EPS);
        const size_t tokq = (size_t)b * SEQ + (r0 + i) * 64 + 16 * j + c;
#pragma unroll
        for (int db = 0; db < 4; ++db) {
            const f32x4 gn = *(const f32x4*)(gain + 16 * db);
            u32x2 w; w.x = pk2(o[i][db][0] * rstd * gn[0], o[i][db][1] * rstd * gn[1]); w.y = pk2(o[i][db][2] * rstd * gn[2], o[i][db][3] * rstd * gn[3]);
            *(u32x2*)(MIX + tokq * 1024 + h * 64 + 16 * db + 4 * g) = w;
        }
    }
    (void)ssv;
    __syncthreads();
}

#define XB_TMO      128
#define XB_XCNT(j)  (256  + 64 * (j))
#define XB_XSUB(j)  (1280 + 64 * (j))
#define XB_XGEN(j)  (2304 + 64 * (j))
#define XB_TOP      3328
#define XB_TOPGEN   3392
#define XCD_BAR_WORDS 3456
#define XB_SPIN_CAP (1u << 18)

__device__ __forceinline__ unsigned xb_ld(unsigned* p)              { return __hip_atomic_load(p, __ATOMIC_RELAXED, __HIP_MEMORY_SCOPE_AGENT); }
__device__ __forceinline__ unsigned xb_add(unsigned* p, unsigned v) { return __hip_atomic_fetch_add(p, v, __ATOMIC_RELAXED, __HIP_MEMORY_SCOPE_AGENT); }
__device__ __forceinline__ unsigned xb_xcc_id() { return (unsigned)__builtin_amdgcn_s_getreg((3 << 11) | 20) & 0xFu; }
#define XB_SPIN(cond, bar) do { unsigned _sp = 0; while (cond) { __builtin_amdgcn_s_sleep(1); \
    if ((++_sp & 255u) == 0u) { if (xb_ld(&(bar)[XB_TMO])) break; if (_sp > XB_SPIN_CAP) { atomicAdd(&(bar)[XB_TMO], 1u); break; } } } } while (0)

struct XcdBarrier {
    unsigned* bar; unsigned x;
    volatile LAS unsigned* st;
};

__device__ __forceinline__ XcdBarrier xcd_barrier_post(unsigned* bar, volatile LAS unsigned* st) {
    XcdBarrier b; b.bar = bar; b.x = xb_xcc_id(); b.st = st;
    if (threadIdx.x == 0) (void)xb_add(&bar[XB_XCNT(b.x)], 1u);
    return b;
}
__device__ __forceinline__ void xcd_barrier_complete(unsigned* bar, unsigned x, unsigned& nloc, unsigned& nx) {
    const unsigned G = gridDim.x * gridDim.y * gridDim.z;
    unsigned sum, cnt, mine, sp = 0u;
    for (;;) {
        sum = 0u; cnt = 0u; mine = 0u;
#pragma unroll
        for (unsigned j = 0; j < 16; ++j) { const unsigned c = xb_ld(&bar[XB_XCNT(j)]); sum += c; cnt += (c > 0u) ? 1u : 0u; mine = (j == x) ? c : mine; }
        if (sum == G) break;
        __builtin_amdgcn_s_sleep(1);
        if ((++sp & 255u) == 0u) { if (xb_ld(&bar[XB_TMO])) break; if (sp > XB_SPIN_CAP) { atomicAdd(&bar[XB_TMO], 1u); break; } }
    }
    nloc = mine > 0u ? mine : 1u; nx = cnt > 0u ? cnt : 1u;
}

__device__ __forceinline__ void xcd_barrier(const XcdBarrier& b) {
    asm volatile("s_waitcnt vmcnt(0)" ::: "memory");
    __syncthreads();
    if (threadIdx.x == 0) {
        unsigned* bar = b.bar;
        __builtin_amdgcn_s_waitcnt(0);
        unsigned nloc = b.st[0], nx = b.st[1];
        if (nloc == 0u) { xcd_barrier_complete(bar, b.x, nloc, nx); b.st[0] = nloc; b.st[1] = nx; }
        const unsigned old = xb_add(&bar[XB_XSUB(b.x)], 1u);
        const unsigned gen = old / nloc;
        if (old + 1u == (gen + 1u) * nloc) {
            __builtin_amdgcn_fence(__ATOMIC_RELEASE, "agent");
            asm volatile("s_waitcnt vmcnt(0)" ::: "memory");
            const unsigned og = xb_add(&bar[XB_TOP], 1u);
            const unsigned tg = og / nx;
            if (og + 1u == (tg + 1u) * nx) xb_add(&bar[XB_TOPGEN], 1u);
            else XB_SPIN(xb_ld(&bar[XB_TOPGEN]) == tg, bar);
            __builtin_amdgcn_fence(__ATOMIC_ACQUIRE, "agent");
            xb_add(&bar[XB_XGEN(b.x)], 1u);
            asm volatile("s_waitcnt vmcnt(0)" ::: "memory");
        } else {
            XB_SPIN(xb_ld(&bar[XB_XGEN(b.x)]) == gen, bar);
            __builtin_amdgcn_fence(__ATOMIC_ACQUIRE, "agent");
            asm volatile("s_waitcnt vmcnt(0)" ::: "memory");
        }
    }
    __syncthreads();
}

#define XL_SUB(j) (3456 + 64 * (j))
#define XL_GEN(j) (4480 + 64 * (j))
__device__ __forceinline__ void xcd_local_barrier(unsigned* bar, unsigned x, unsigned nloc) {
    asm volatile("s_waitcnt vmcnt(0)" ::: "memory");
    __syncthreads();
    if (threadIdx.x == 0) {
        const unsigned old = xb_add(&bar[XL_SUB(x)], 1u); const unsigned gen = old / nloc;
        if (old + 1u == (gen + 1u) * nloc) xb_add(&bar[XL_GEN(x)], 1u);
        else XB_SPIN(xb_ld(&bar[XL_GEN(x)]) == gen, bar);
        __builtin_amdgcn_fence(__ATOMIC_ACQUIRE, "agent");
        asm volatile("s_waitcnt vmcnt(0)" ::: "memory");
    }
    __syncthreads();
}
#ifndef REP_PRO
#define REP_PRO 1
#define REP_SYNC 1
#define REP_GEMM 1
#define REP_PREP 1
#define REP_SCAN 1
#define REP_OUT 1
#define REP_NA 1
#endif
#define LAUNDER_TID int t_ = threadIdx.x; asm volatile("" : "+v"(t_)); const int tid = t_, lane = t_ & 63, wave = __builtin_amdgcn_readfirstlane(t_ >> 6); (void)tid; (void)lane; (void)wave;
#define GSYNC() do { for (int r_ = 0; r_ < REP_SYNC; ++r_) xcd_barrier(xbar); } while (0)
#define LSYNC() do { for (int r_ = 0; r_ < REP_SYNC; ++r_) { if (xl) xcd_local_barrier(xbar.bar, xbar.x, (unsigned)(G >> 3)); else xcd_barrier(xbar); } } while (0)
__global__ void __launch_bounds__(NWAVES * 64, 2) fwd_megakernel(Args A) {
    extern __shared__ __attribute__((aligned(16))) unsigned char lds[];
    cg::grid_group grid = cg::this_grid();
    const int G = gridDim.x, bx = blockIdx.x;
    LAS unsigned char* ldsg = (LAS unsigned char*)lds;
    unsigned char* ws = WSP(); unsigned char* R = ws + WS_R;
    bf16* XB = (bf16*)(ws + WS_XB); float* SSQ = (float*)(ws + WS_SSQ); float* X = OUTP();
    bf16* H = (bf16*)(R + R_H); bf16* MIX = (bf16*)(R + R_MIX);

    if (threadIdx.x < 16) ((volatile LAS unsigned*)(ldsg + (LDS_BYTES - 128)))[threadIdx.x] = 0u;
    __syncthreads();
    volatile LAS unsigned* ldsw = (volatile LAS unsigned*)(ldsg + (LDS_BYTES - 128));
    XcdBarrier xbar; xbar.bar = (unsigned*)ws; xbar.x = xb_xcc_id(); xbar.st = ldsw;
    if (threadIdx.x == 0) ldsw[4] = xb_add(&xbar.bar[XB_XCNT(xbar.x)], 1u);
    for (int rep = 0; rep < REP_PRO; ++rep) { LAUNDER_TID prologue(A, lds, wave, lane); }
    if (G > (1 << 20)) grid.sync();
    xcd_barrier(xbar);
    if (threadIdx.x == 0) {
        bool ok = (G % 8 == 0);
        for (unsigned j = 0; j < 16; ++j) { const unsigned cn = xb_ld(&xbar.bar[XB_XCNT(j)]); ok = ok && (cn == (j < 8 ? (unsigned)(G / 8) : 0u)); }
        ldsw[5] = ok ? (xbar.x + 8u * ldsw[4]) : (unsigned)bx; ldsw[6] = ok ? 1u : 0u;
    }
    __syncthreads();
    const int vcu = __builtin_amdgcn_readfirstlane((int)ldsw[5]);
    const bool xl = __builtin_amdgcn_readfirstlane((int)ldsw[6]) != 0;
    const int xq = vcu & 7, rk = vcu >> 3, nl = G >> 3;

#pragma unroll 1
    for (int l = 0; l < 2; ++l) {
        unsigned char* wb = ws + WS_W + (size_t)l * WL;
        for (int rep = 0; rep < REP_GEMM; ++rep) {
            pg8::Gemm gm{XB, (const bf16*)(wb + OW_GU1), M, 2 * DFF, DM}; pg8::StaticOrder S; S.init(M, 2 * DFF, G, vcu);
            EpiSwiGLU E{H, SSQ};
            pg8::gemm_phase<EpiSwiGLU, pg8::StaticOrder, true, true>(ldsg, gm, S, E);
        }
        LSYNC();
        for (int rep = 0; rep < REP_GEMM; ++rep) {
            pg8::Gemm gm{H, (const bf16*)(wb + OW_D1), M, DM, DFF}; pg8::StaticOrder S; S.init(M, DM, G, vcu);
            EpiResid E{(l == 0 && rep == 0) ? INP(0) : (const float*)nullptr, XB, SSQ, rep == 0 ? 0.5f : 0.f};
            pg8::gemm_phase<EpiResid, pg8::StaticOrder, true, true>(ldsg, gm, S, E);
        }
        GSYNC();
        for (int rep = 0; rep < REP_GEMM; ++rep) {
            pg8::Gemm gm{XB, (const bf16*)(wb + OW_INA), M, 2304, DM}; pg8::StaticOrder S; S.init(M, 2304, G, vcu);
            EpiProj E{(bf16*)(R + R_QKNA), (bf16*)(R + R_GQK), (bf16*)(R + R_GR), (bf16*)(R + R_CODES), SSQ};
            pg8::gemm_phase<EpiProj, pg8::StaticOrder, true, true>(ldsg, gm, S, E);
            pg8::Gemm gv{(const bf16*)(wb + OW_INB), XB, 1024, M, DM}; pg8::StaticOrder S2; S2.init(1024, M, G, vcu);
            EpiVT E2{(bf16*)(R + R_VT), SSQ};
            pg8::gemm_phase<EpiVT, pg8::StaticOrder, true, true>(ldsg, gv, S2, E2);
        }
        LSYNC();
        for (int rep = 0; rep < REP_PREP; ++rep) { LAUNDER_TID int ph_ = -1; for (int k = xl ? rk : vcu; k < (xl ? 256 : 2048); k += (xl ? nl : G)) { const int li = (xl && nl == 32) ? (((rk >> 3) << 6) | ((rk & 7) + 8 * ((k - rk) >> 5))) : k;     const int it = xl ? ((((xq << 2) | (li >> 6)) << 6) | (li & 63)) : k; const int h_ = (it >> 6) & 3; gla_prep_item(A, l, lds, it, tid, h_ != ph_); ph_ = h_; } }
        LSYNC();
        for (int rep = 0; rep < REP_SCAN; ++rep) { LAUNDER_TID for (int k = xl ? rk : vcu; k < (xl ? 32 : 256); k += (xl ? nl : G)) gla_scan_item_lds(lds, xl ? ((((k >> 4) * 32 + xq * 4 + ((k >> 2) & 3)) << 2) | (k & 3)) : k, tid, wave, lane); }
        GSYNC();
        for (int rep = 0; rep < REP_OUT; ++rep) { LAUNDER_TID gla_out_phase(l, lds, tid, wave, lane, xl, xq, xl ? rk : vcu, xl ? 128 : 1024, xl ? nl : G); }
        for (int rep = 0; rep < REP_NA; ++rep) { LAUNDER_TID na_stage_rpb2(l, (float*)lds + 512, tid); if (G % 8 == 0) { for (int li = vcu >> 3; li < 64; li += (G >> 3)) na_strip(A, l, (float*)lds, (const float*)lds + 512, ((vcu & 7) << 6) | li, wave, lane); } else { for (int it = vcu; it < 512; it += G) na_strip(A, l, (float*)lds, (const float*)lds + 512, it, wave, lane); } }
        GSYNC();
        for (int rep = 0; rep < REP_GEMM; ++rep) {
            pg8::Gemm gm{MIX, (const bf16*)(wb + OW_OUT), M, DM, DM}; pg8::StaticOrder S; S.init(M, DM, G, vcu);
            EpiResid E{nullptr, XB, SSQ, rep == 0 ? 1.0f : 0.f};
            pg8::gemm_phase<EpiResid, pg8::StaticOrder, true, true>(ldsg, gm, S, E);
        }
        LSYNC();
        for (int rep = 0; rep < REP_GEMM; ++rep) {
            pg8::Gemm gm{XB, (const bf16*)(wb + OW_GU2), M, 2 * DFF, DM}; pg8::StaticOrder S; S.init(M, 2 * DFF, G, vcu);
            EpiSwiGLU E{H, SSQ};
            pg8::gemm_phase<EpiSwiGLU, pg8::StaticOrder, true, true>(ldsg, gm, S, E);
        }
        LSYNC();
        for (int rep = 0; rep < REP_GEMM; ++rep) {
            pg8::Gemm gm{H, (const bf16*)(wb + OW_D2), M, DM, DFF}; pg8::StaticOrder S; S.init(M, DM, G, vcu);
            EpiResid E{nullptr, XB, SSQ, rep == 0 ? 0.5f : 0.f};
            pg8::gemm_phase<EpiResid, pg8::StaticOrder, true, true>(ldsg, gm, S, E);
        }
        LSYNC();
    }
    {
        LAUNDER_TID
        const float* gn = INP(19);
        const int gw = vcu * NWAVES + wave, NGW = G * NWAVES;
        for (int m = xl ? xq * 4096 + rk * NWAVES + wave : gw; m < (xl ? (xq + 1) * 4096 : M); m += (xl ? nl * NWAVES : NGW)) {
            float s = lane < 16 ? SSQ[(size_t)m * 16 + lane] : 0.f; s = wave_sum(s);
            const float rstd = rsqrtf(s * (1.0f / DM) + EPS);
            f32x4* xr = (f32x4*)(X + (size_t)m * DM) + lane; const f32x4* gr = (const f32x4*)gn + lane; const u32x2* xb = (const u32x2*)(XB + (size_t)m * DM) + lane;
#pragma unroll
            for (int j = 0; j < 4; ++j) { const u32x2 bb = xb[64 * j]; const f32x4 v = {bflo(bb.x), bfhi(bb.x), bflo(bb.y), bfhi(bb.y)}; xr[64 * j] = v * rstd * gr[64 * j]; }
        }
    }
}

extern "C" void kernel_launch(void* const* d_in, const int* in_sizes, int n_in, void* d_out, int out_size, void* d_ws, size_t ws_size, hipStream_t stream) {
    static int grid = 0;
    if (grid == 0) {
        if (n_in != 20 || out_size != M * DM || ws_size < WS_END) { fprintf(stderr, "kernel_launch: unexpected shapes / workspace (n_in %d out %d ws %zu need %zu)\n", n_in, out_size, ws_size, (size_t)WS_END); grid = -1; return; }
        int dev = 0, cus = 0, per_cu = 0;
        hipGetDevice(&dev); hipDeviceGetAttribute(&cus, hipDeviceAttributeMultiprocessorCount, dev);
        hipFuncSetAttribute((const void*)fwd_megakernel, hipFuncAttributeMaxDynamicSharedMemorySize, LDS_BYTES);
        hipOccupancyMaxActiveBlocksPerMultiprocessor(&per_cu, (const void*)fwd_megakernel, NWAVES * 64, LDS_BYTES);
        if (per_cu < 1) per_cu = 1;
        grid = cus * per_cu;
        (void)hipGetLastError();
    }
    if (grid < 0) return;
    Args a{};
    for (int i = 0; i < 20; ++i) a.in[i] = (const float*)d_in[i];
    a.out = (float*)d_out; a.ws = (unsigned char*)d_ws;
    if (hipMemsetAsync(d_ws, 0, 32768, stream) != hipSuccess) { fprintf(stderr, "memset failed\n"); return; }
    void* args[] = {&a};
    hipError_t e = hipLaunchCooperativeKernel((const void*)fwd_megakernel, dim3(grid), dim3(NWAVES * 64), args, LDS_BYTES, stream);
    if (e != hipSuccess) fprintf(stderr, "cooperative launch failed: %s (grid %d)\n", hipGetErrorString(e), grid);
}
```
